# Optimizing an MI355X kernel written in HIP

```python
import jax, jax.numpy as jnp
from jax import lax
import numpy as np

D_MODEL = 1024
BATCH = 2
SEQ = 8192
DEPTH = 2
DEC_BATCH = 32
DEC_SEQ = 16
PAST_LEN = 2048

CHUNK = 64
Q_BLOCK = 128
D_MIX = D_MODEL
FOX_HEADS = 8
FOX_HEAD_DIM = 64
FOX_WIDTH = FOX_HEADS * FOX_HEAD_DIM
HGRN_HEADS = 4
HGRN_HEAD_DIM = 128
HGRN_WIDTH = HGRN_HEADS * HGRN_HEAD_DIM
D_IN_PROJ = 3 * FOX_WIDTH + FOX_HEADS + 4 * HGRN_WIDTH
D_FF = 2816
RMS_EPS = 1e-6
FOX_SCALE = FOX_HEAD_DIM ** -0.5

kernel_name = "hymba_fox_hgrn2_macaron_step"


def rms_norm(x, g):
    xf = x.astype(jnp.float32)
    y = xf * lax.rsqrt(jnp.mean(xf * xf, axis=-1, keepdims=True) + RMS_EPS)
    return (y * g.astype(jnp.float32)).astype(x.dtype)


def swiglu_ffn(x, wi, wo):
    a, b = jnp.split(x @ wi, 2, axis=-1)
    return (jax.nn.silu(a) * b) @ wo


def hgrn_lower_bounds(lb_param):
    cs = jnp.cumsum(jax.nn.softmax(lb_param.astype(jnp.float32), axis=0), axis=0)
    return cs - cs[0:1]


def project_mixers(h, w_in, b_f, lb):
    B, L, _ = h.shape
    F, H, W = FOX_WIDTH, FOX_HEADS, HGRN_WIDTH
    proj = h @ w_in
    q, k, v, fg, hq, hf, hi, hg = jnp.split(
        proj, [F, 2 * F, 3 * F, 3 * F + H, 3 * F + H + W, 3 * F + H + 2 * W, 3 * F + H + 3 * W], axis=-1)
    fox_heads = lambda t: t.reshape(B, L, FOX_HEADS, FOX_HEAD_DIM).transpose(0, 2, 1, 3)
    fox_logf = jax.nn.log_sigmoid(fg.astype(jnp.float32) + b_f.astype(jnp.float32)).transpose(0, 2, 1)
    z = hf.astype(jnp.float32)
    h_logf = jnp.logaddexp(jnp.log(lb), jnp.log1p(-lb) + jax.nn.log_sigmoid(z))
    h_k = (1.0 - lb) * jax.nn.sigmoid(-z)
    hs = lambda t: t.reshape(B, L, HGRN_HEADS, HGRN_HEAD_DIM)
    return (fox_heads(q), fox_heads(k), fox_heads(v), fox_logf,
            hs(jax.nn.silu(hq)), hs(h_logf), hs(h_k), hs(hi), hs(hg))


def fox_attend(q, c_q, q_pos, k, v, c_k):
    s = jnp.einsum('bhqd,bhkd->bhqk', q, k).astype(jnp.float32) * FOX_SCALE
    s = s + (c_q[..., :, None] - c_k[..., None, :])
    mask = jnp.arange(k.shape[2])[None, :] <= q_pos[:, None]
    p = jax.nn.softmax(jnp.where(mask, s, -jnp.inf), axis=-1)
    return jnp.einsum('bhqk,bhkd->bhqd', p.astype(v.dtype), v)


def fox_prompt(q, k, v, logf):
    B, H, L, HD = q.shape
    nb = L // Q_BLOCK
    c = jnp.cumsum(logf, axis=-1)
    qb = q.reshape(B, H, nb, Q_BLOCK, HD).transpose(2, 0, 1, 3, 4)
    cb = c.reshape(B, H, nb, Q_BLOCK).transpose(2, 0, 1, 3)
    pos = jnp.arange(L, dtype=jnp.int32).reshape(nb, Q_BLOCK)
    o = lax.map(lambda a: fox_attend(a[0], a[1], a[2], k, v, c), (qb, cb, pos))
    return o.transpose(1, 2, 0, 3, 4).reshape(B, H, L, HD)


def fox_sample(q, k, v, logf, ck, cv, clogf):
    P, T = ck.shape[2], q.shape[2]
    k_all = jnp.concatenate([ck.astype(k.dtype), k], axis=2)
    v_all = jnp.concatenate([cv.astype(v.dtype), v], axis=2)
    c_all = jnp.cumsum(jnp.concatenate([clogf.astype(jnp.float32), logf], axis=-1), axis=-1)
    pos = P + jnp.arange(T, dtype=jnp.int32)
    return fox_attend(q, c_all[..., P:], pos, k_all, v_all, c_all)


def hgrn2_chunked(q, logf, k, v, s0):
    B, L, H, DK = q.shape
    DV = v.shape[-1]
    C = min(CHUNK, L)
    n = L // C
    blocks = lambda t: t.astype(jnp.float32).reshape(B, n, C, H, t.shape[-1]).transpose(1, 0, 3, 2, 4)
    causal = jnp.tril(jnp.ones((C, C), dtype=bool))

    def step(S, inp):
        qc, lfc, kc, vc = inp
        b = jnp.cumsum(lfc, axis=2)
        diff = b[:, :, :, None, :] - b[:, :, None, :, :]
        decay = jnp.exp(jnp.where(causal[:, :, None], diff, -jnp.inf))
        scores = jnp.einsum('bhtd,bhsd,bhtsd->bhts', qc, kc, decay)
        o = jnp.einsum('bhts,bhsv->bhtv', scores, vc) + jnp.einsum('bhtd,bhdv->bhtv', qc * jnp.exp(b), S)
        b_last = b[:, :, -1]
        S_new = jnp.exp(b_last)[..., None] * S + jnp.einsum(
            'bhsd,bhsv->bhdv', kc * jnp.exp(b_last[:, :, None] - b), vc)
        return S_new, o

    S, o = lax.scan(step, s0.astype(jnp.float32), (blocks(q), blocks(logf), blocks(k), blocks(v)))
    return o.transpose(1, 0, 3, 2, 4).reshape(B, L, H, DV), S


def trunk_layer(x, l, p, lb, fox_fn, s0):
    B, L, _ = x.shape
    x = x + 0.5 * swiglu_ffn(rms_norm(x, p['norm_ffn1'][l]), p['ffn1_wi'][l], p['ffn1_wo'][l])
    h = rms_norm(x, p['norm_mix'][l])
    fq, fk, fv, flogf, hq, hlogf, hk, hv, hg = project_mixers(h, p['w_in'][l], p['b_fgate'][l], lb)
    fox_o = fox_fn(fq, fk, fv, flogf).transpose(0, 2, 1, 3).reshape(B, L, FOX_WIDTH)
    ho, S = hgrn2_chunked(hq, hlogf, hk, hv, s0)
    hgrn_o = (rms_norm(ho, p['hgrn_gnorm'][l]) * jax.nn.silu(hg.astype(jnp.float32))).reshape(B, L, HGRN_WIDTH)
    mix = jnp.concatenate([fox_o, hgrn_o.astype(x.dtype)], axis=-1)
    x = x + mix @ p['w_out'][l]
    x = x + 0.5 * swiglu_ffn(rms_norm(x, p['norm_ffn2'][l]), p['ffn2_wi'][l], p['ffn2_wo'][l])
    return x, fk, fv, flogf, S


def setup_inputs(seed: int = 0) -> dict:
    key = jax.random.key(seed)
    ks = jax.random.split(key, 20)
    nrm = lambda k, shape, scale: jax.random.normal(k, shape, jnp.float32) * scale
    gain = lambda k, shape: 1.0 + nrm(k, shape, 0.05)
    return {
        'x_prompt': nrm(ks[0], (BATCH, SEQ, D_MODEL), 1.0),
        'x_sample': nrm(ks[1], (DEC_BATCH, DEC_SEQ, D_MODEL), 1.0),
        'cache_k': nrm(ks[2], (DEPTH, DEC_BATCH, FOX_HEADS, PAST_LEN, FOX_HEAD_DIM), 1.0),
        'cache_v': nrm(ks[3], (DEPTH, DEC_BATCH, FOX_HEADS, PAST_LEN, FOX_HEAD_DIM), 1.0),
        'cache_logf': jax.nn.log_sigmoid(1.0 + nrm(ks[4], (DEPTH, DEC_BATCH, FOX_HEADS, PAST_LEN), 1.0)),
        'state_hgrn': nrm(ks[5], (DEPTH, DEC_BATCH, HGRN_HEADS, HGRN_HEAD_DIM, HGRN_HEAD_DIM), 0.5),
        'norm_ffn1': gain(ks[6], (DEPTH, D_MODEL)),
        'ffn1_wi': nrm(ks[7], (DEPTH, D_MODEL, 2 * D_FF), D_MODEL ** -0.5),
        'ffn1_wo': nrm(ks[8], (DEPTH, D_FF, D_MODEL), D_FF ** -0.5),
        'norm_mix': gain(ks[9], (DEPTH, D_MODEL)),
        'w_in': nrm(ks[10], (DEPTH, D_MODEL, D_IN_PROJ), D_MODEL ** -0.5),
        'b_fgate': 1.0 + nrm(ks[11], (DEPTH, FOX_HEADS), 0.1),
        'hgrn_lb': nrm(ks[12], (DEPTH, HGRN_WIDTH), 0.5),
        'hgrn_gnorm': gain(ks[13], (DEPTH, HGRN_HEAD_DIM)),
        'w_out': nrm(ks[14], (DEPTH, D_MIX, D_MODEL), D_MIX ** -0.5),
        'norm_ffn2': gain(ks[15], (DEPTH, D_MODEL)),
        'ffn2_wi': nrm(ks[16], (DEPTH, D_MODEL, 2 * D_FF), D_MODEL ** -0.5),
        'ffn2_wo': nrm(ks[17], (DEPTH, D_FF, D_MODEL), D_FF ** -0.5),
        'norm_final': gain(ks[18], (D_MODEL,)),
    }


def reference(x_prompt, x_sample, cache_k, cache_v, cache_logf, state_hgrn,
              norm_ffn1, ffn1_wi, ffn1_wo, norm_mix, w_in, b_fgate, hgrn_lb, hgrn_gnorm,
              w_out, norm_ffn2, ffn2_wi, ffn2_wo, norm_final):
    p = {'norm_ffn1': norm_ffn1, 'ffn1_wi': ffn1_wi, 'ffn1_wo': ffn1_wo, 'norm_mix': norm_mix,
         'w_in': w_in, 'b_fgate': b_fgate, 'hgrn_gnorm': hgrn_gnorm, 'w_out': w_out,
         'norm_ffn2': norm_ffn2, 'ffn2_wi': ffn2_wi, 'ffn2_wo': ffn2_wo}
    lbs = hgrn_lower_bounds(hgrn_lb)
    xp, xs = x_prompt, x_sample
    s0_prompt = jnp.zeros((x_prompt.shape[0], HGRN_HEADS, HGRN_HEAD_DIM, HGRN_HEAD_DIM), jnp.float32)
    kp_l, vp_l, lfp_l, sp_l, ks_l, vs_l, lfs_l, ss_l = [], [], [], [], [], [], [], []
    for l in range(DEPTH):
        xp, kp, vp, lfp, sp = trunk_layer(xp, l, p, lbs[l], fox_prompt, s0_prompt)
        fox_fn = lambda q, k, v, lf, l=l: fox_sample(q, k, v, lf, cache_k[l], cache_v[l], cache_logf[l])
        xs, kss, vss, lfs, ss = trunk_layer(xs, l, p, lbs[l], fox_fn, state_hgrn[l])
        kp_l.append(kp); vp_l.append(vp); lfp_l.append(lfp); sp_l.append(sp)
        ks_l.append(kss); vs_l.append(vss); lfs_l.append(lfs); ss_l.append(ss)
    y_prompt = rms_norm(xp, norm_final)
    y_sample = rms_norm(xs, norm_final)
    return (y_prompt, y_sample,
            jnp.stack(kp_l), jnp.stack(vp_l), jnp.stack(lfp_l), jnp.stack(sp_l),
            jnp.stack(ks_l), jnp.stack(vs_l), jnp.stack(lfs_l), jnp.stack(ss_l))
```

```cpp
#include <hip/hip_runtime.h>
#include <hip/hip_cooperative_groups.h>
#include <cstdio>
#include <cstdint>
namespace cg = cooperative_groups;

#ifndef DUP
#define DUP 0
#endif
#ifndef ONE_LAUNCH
#define ONE_LAUNCH 1
#endif

constexpr int DM = 1024, SEQ = 8192, NB = 2, DEC_B = 32, DEC_T = 16, PAST = 2048;
constexpr int MP = NB * SEQ, MS = DEC_B * DEC_T, MT = MP + MS;
constexpr int DFF = 2816, NIN_RAW = 3592, NIN = 3584;
constexpr int SKV = PAST + DEC_T;
constexpr float RMS_EPS = 1e-6f;
constexpr float LOG2E = 1.4426950408889634f;
constexpr float QSCALE = 0.125f * LOG2E;
constexpr size_t O_YP = 0, O_YS = 16777216, O_KP = 17301504, O_VP = 34078720, O_LFP = 50855936, O_HSP = 51118080,
                 O_KS = 51380224, O_VS = 51904512, O_LFS = 52428800, O_HSS = 52436992, O_END = 56631296;
constexpr size_t MiB = 1u << 20;
constexpr size_t WS_CTL = 0, WS_WFG = 1 * MiB, WS_LB = 1 * MiB + 65536, WS_KTN = 1 * MiB + 131072, WS_G = 2 * MiB, WS_CP = 3 * MiB, WS_CS = 4 * MiB;
constexpr size_t WS_W1T = 8 * MiB, WS_W2T = 52 * MiB, WS_WINT = 74 * MiB, WS_WOT = 88 * MiB;
constexpr size_t WS_X = 92 * MiB, WS_HN = 158 * MiB, WS_ACT = 192 * MiB, WS_QB = 284 * MiB, WS_KB = 301 * MiB, WS_VB = 318 * MiB;
constexpr size_t WS_HALL = 336 * MiB, WS_MIX = 468 * MiB, WS_US = 502 * MiB, WS_END = 566 * MiB;
constexpr size_t W1T_SZ = (size_t)2 * DFF * DM, W2T_SZ = (size_t)DM * DFF, WINT_SZ = (size_t)NIN * DM, WOT_SZ = (size_t)DM * DM;

#define LAS __attribute__((address_space(3)))
typedef unsigned short bf16;
typedef short bf16x8 __attribute__((ext_vector_type(8)));
typedef float f32x4 __attribute__((ext_vector_type(4)));
typedef float f32x2 __attribute__((ext_vector_type(2)));
typedef unsigned v4u __attribute__((ext_vector_type(4)));
typedef unsigned v2u __attribute__((ext_vector_type(2)));
typedef __bf16 bf16x2_t __attribute__((ext_vector_type(2)));
__device__ __forceinline__ unsigned pk2(float lo, float hi) { f32x2 v = {lo, hi}; bf16x2_t b = __builtin_convertvector(v, bf16x2_t); return __builtin_bit_cast(unsigned, b); }
__device__ __forceinline__ bf16 f2bf(float f) { return (bf16)(pk2(f, 0.f) & 0xffffu); }
__device__ __forceinline__ float bf2f(bf16 h) { return __builtin_bit_cast(float, (unsigned)h << 16); }
__device__ __forceinline__ float fast_exp2(float x) { return __builtin_amdgcn_exp2f(x); }
__device__ __forceinline__ float sigmoidf_(float x) { return 1.0f / (1.0f + __expf(-x)); }
__device__ __forceinline__ float siluf_(float x) { return x / (1.0f + __expf(-x)); }
__device__ __forceinline__ float log_sigmoidf_(float x) { return fminf(x, 0.f) - log1pf(expf(-fabsf(x))); }
#define LDS_WAIT() asm volatile("s_waitcnt lgkmcnt(0)" ::: "memory")

namespace pg8 {
#define PG8_LAS __attribute__((address_space(3)))
typedef unsigned short bf16_t;
typedef short bf16x8 __attribute__((ext_vector_type(8)));
typedef float f32x4 __attribute__((ext_vector_type(4)));
typedef unsigned u32x4 __attribute__((ext_vector_type(4)));
constexpr int BM = 256, BK = 64, HALF = 128, HTB = HALF * BK * 2  , STAGE_BYTES = 8 * HTB, NXCD = 8, WGM = 8;

__host__ __device__ __forceinline__ int lds_byte(int r, int c) { const int st = (r >> 4) * 2 + (c >> 5), rr = r & 15, cc = c & 31, ob = rr * 64 + cc * 2; return st * 1024 + (ob ^ (((ob >> 9) & 1) << 5)); }
__host__ __device__ __forceinline__ void stage_rc(int b, int& R, int& C) { const int st = b / 1024, sb = b % 1024, swz = sb ^ (((sb >> 9) & 1) << 5); R = (st >> 1) * 16 + swz / 64; C = (st & 1) * 32 + (swz % 64) / 2; }
__host__ __device__ __forceinline__ int perm32(int rho) { const int n = rho >> 4, i = rho & 15; return 8 * (i >> 2) + 4 * n + (i & 3); }

struct Unit { int pm, pn, k0, nt; };
struct Gemm { const bf16_t* A; const bf16_t* Bt; int M, N, K; };

struct StaticOrder {
    int nM, nN, nwg, G, c;
    __host__ __device__ __forceinline__ void init(int M, int N, int G_, int c_) { nM = M / BM; nN = N / BM; nwg = nM * nN; G = G_; c = c_; }
    __host__ __device__ __forceinline__ bool next(int i, Unit& u) const {
        u.pm = 0; u.pn = 0; u.k0 = 0; u.nt = 0;
        const long L = (long)i * G + c; if (L >= nwg) return false;
        int wgid = (int)L; { const int q = nwg / NXCD, r = nwg % NXCD, xcd = wgid % NXCD, off = wgid / NXCD; wgid = (xcd < r ? xcd * (q + 1) : r * (q + 1) + (xcd - r) * q) + off; }
        const int nig = WGM * nN, gid = wgid / nig, fm = gid * WGM, gsz = (nM - fm) < WGM ? (nM - fm) : WGM;
        u.pm = fm + ((wgid % nig) % gsz); u.pn = (wgid % nig) / gsz; u.k0 = 0; u.nt = 0; return true;
    }
    __device__ __forceinline__ void a_ready(const Unit&) const {}
    __device__ __forceinline__ void done(const Unit&) const {}
};

struct SplitOrder {
    StaticOrder base; int R, G, c, ntf;
    __host__ __device__ __forceinline__ void init(int Mprompt, int N, int G_, int c_, int ntf_) { base.init(Mprompt, N, G_, c_); G = G_; c = c_; ntf = ntf_; R = (base.nwg + G - 1) / G; }
    __host__ __device__ __forceinline__ bool next(int i, Unit& u) const {
        if (i < R) { if (base.next(i, u)) return true; }
        const int idle = R * G - base.nwg;
        const int j = (i < R) ? (c - (G - idle)) : ((i - R) * G + c + idle);
        if (i < R - 1 || j < 0 || j >= 32) return false;
        const int us = j >> 2, p = j & 3, bs = (ntf / 4) & ~1, rem2 = (ntf - 4 * bs) / 2;
        u.pm = base.nM + (us >> 2); u.pn = us & 3; u.nt = bs + (p < rem2 ? 2 : 0); u.k0 = p * bs + 2 * (p < rem2 ? p : rem2); return true;
    }
    __device__ __forceinline__ void a_ready(const Unit&) const {}
    __device__ __forceinline__ void done(const Unit&) const {}
};

struct EpiSwiglu {
    static constexpr bool PERM = true, AFTER_DRAIN = false;
    bf16_t* O;
    __device__ __forceinline__ void operator()(const f32x4 (&acc)[2][2][4][2], const Unit& u, int wr, int wc, int fr, int fq) const {
        const int row0 = u.pm * BM + wr * 64 + fr, col0 = u.pn * 128 + wc * 32 + 8 * fq;
#pragma unroll
        for (int ai = 0; ai < 2; ++ai)
#pragma unroll
            for (int m = 0; m < 4; ++m) {
                const f32x4 a0 = acc[ai][0][m][0], a1 = acc[ai][0][m][1], b0 = acc[ai][1][m][0], b1 = acc[ai][1][m][1];
                u32x4 w;
                w.x = ::pk2(::siluf_(a0[0]) * b0[0], ::siluf_(a0[1]) * b0[1]); w.y = ::pk2(::siluf_(a0[2]) * b0[2], ::siluf_(a0[3]) * b0[3]);
                w.z = ::pk2(::siluf_(a1[0]) * b1[0], ::siluf_(a1[1]) * b1[1]); w.w = ::pk2(::siluf_(a1[2]) * b1[2], ::siluf_(a1[3]) * b1[3]);
                *(u32x4*)(O + (size_t)(row0 + ai * HALF + m * 16) * ::DFF + col0) = w;
            }
    }
};
struct EpiRes {
    static constexpr bool PERM = false, AFTER_DRAIN = false;
    float* X; float scale;
    __device__ __forceinline__ void operator()(const f32x4 (&acc)[2][2][4][2], const Unit& u, int wr, int wc, int fr, int fq) const {
        const int row0 = u.pm * BM + wr * 64 + fr, col0 = u.pn * BM + wc * 32 + 4 * fq;
#pragma unroll
        for (int ai = 0; ai < 2; ++ai)
#pragma unroll
            for (int m = 0; m < 4; ++m) { float* rowp = X + (size_t)(row0 + ai * HALF + m * 16) * ::DM + col0;
#pragma unroll
                for (int bj = 0; bj < 2; ++bj)
#pragma unroll
                    for (int n = 0; n < 2; ++n) { float* p = rowp + bj * HALF + n * 16; const f32x4 v = acc[ai][bj][m][n] * scale;
                        if (u.nt) { __hip_atomic_fetch_add(p + 0, v[0], __ATOMIC_RELAXED, __HIP_MEMORY_SCOPE_AGENT); __hip_atomic_fetch_add(p + 1, v[1], __ATOMIC_RELAXED, __HIP_MEMORY_SCOPE_AGENT);
                                    __hip_atomic_fetch_add(p + 2, v[2], __ATOMIC_RELAXED, __HIP_MEMORY_SCOPE_AGENT); __hip_atomic_fetch_add(p + 3, v[3], __ATOMIC_RELAXED, __HIP_MEMORY_SCOPE_AGENT); }
                        else *(f32x4*)p = *(const f32x4*)p + v; } }
    }
};
struct EpiInProj {
    static constexpr bool PERM = true, AFTER_DRAIN = false;
    bf16_t *Q, *K, *V; float* H; float* out; int l;
    __device__ __forceinline__ void operator()(const f32x4 (&acc)[2][2][4][2], const Unit& u, int wr, int wc, int fr, int fq) const {
        const int seg = u.pn >> 1, cbase = (u.pn & 1) * 256 + wc * 32 + 8 * fq, row0 = u.pm * BM + wr * 64 + fr;
#pragma unroll
        for (int ai = 0; ai < 2; ++ai)
#pragma unroll
            for (int m = 0; m < 4; ++m) { const int row = row0 + ai * HALF + m * 16;
#pragma unroll
                for (int bj = 0; bj < 2; ++bj) { const int cs = cbase + bj * HALF; f32x4 v0 = acc[ai][bj][m][0], v1 = acc[ai][bj][m][1];
                    if (seg == 0) { v0 = v0 * ::QSCALE; v1 = v1 * ::QSCALE; u32x4 w; w.x = ::pk2(v0[0], v0[1]); w.y = ::pk2(v0[2], v0[3]); w.z = ::pk2(v1[0], v1[1]); w.w = ::pk2(v1[2], v1[3]);
                        *(u32x4*)(Q + (size_t)row * 512 + cs) = w; }
                    else if (seg <= 2) { u32x4 w; w.x = ::pk2(v0[0], v0[1]); w.y = ::pk2(v0[2], v0[3]); w.z = ::pk2(v1[0], v1[1]); w.w = ::pk2(v1[2], v1[3]);
                        *(u32x4*)((seg == 1 ? K : V) + (size_t)row * 512 + cs) = w;
                        const int head = cs >> 6, d = cs & 63; size_t o;
                        if (row < ::MP) { const int b = row >> 13, t = row & 8191; o = (seg == 1 ? ::O_KP : ::O_VP) + ((((size_t)l * 2 + b) * 8 + head) * 8192 + t) * 64 + d; }
                        else { const int rs = row - ::MP, b = rs >> 4, t = rs & 15; o = (seg == 1 ? ::O_KS : ::O_VS) + ((((size_t)l * 32 + b) * 8 + head) * 16 + t) * 64 + d; }
                        *(f32x4*)(out + o) = v0; *(f32x4*)(out + o + 4) = v1; }
                    else { float* hp = H + (size_t)row * 2048 + (seg - 3) * 512 + cs;
                        if (seg == 3) { v0 = (f32x4){::siluf_(v0[0]), ::siluf_(v0[1]), ::siluf_(v0[2]), ::siluf_(v0[3])}; v1 = (f32x4){::siluf_(v1[0]), ::siluf_(v1[1]), ::siluf_(v1[2]), ::siluf_(v1[3])}; }
                        *(f32x4*)hp = v0; *(f32x4*)(hp + 4) = v1; }
                } }
    }
};
template <class Epi, class Sched, bool ALIGN_EPI = false, bool SP2 = false>
__device__ __forceinline__ void gemm_phase(PG8_LAS unsigned char* lds, const Gemm g, const Sched& S, const Epi& E) {
    const int tid = threadIdx.x, wid = __builtin_amdgcn_readfirstlane(tid >> 6), lane = tid & 63, wr = wid >> 2, wc = wid & 3, fr = lane & 15, fq = lane >> 4;
    const int K = g.K, ntf = K / BK;
    unsigned voffA[2], voffB[2];
#pragma unroll
    for (int i = 0; i < 2; ++i) { int R, C; stage_rc(tid * 16 + i * 8192, R, C); const int Rb = Epi::PERM ? ((R & ~31) + perm32(R & 31)) : R;
        voffA[i] = (unsigned)(R * K + C) * 2u; voffB[i] = (unsigned)(Rb * K + C) * 2u; }
    const size_t kstep = (size_t)(BK * 2);
    const size_t hstep = (size_t)HALF * K * 2;
    const size_t tstep = 2 * hstep;
    const unsigned ldsw = (unsigned)wid * 1024u;
    const int aoff = lds_byte(wr * 64 + fr, fq * 8), boff = lds_byte(wc * 32 + fr, fq * 8);
#define PG8_SA(b, h) (((b) * 2 + (h)) * HTB)
#define PG8_SB(b, h) ((4 + (b) * 2 + (h)) * HTB)
#define PG8_STAGE(bufoff, gbase, voff) do { _Pragma("unroll") for (int _i = 0; _i < 2; ++_i) \
        __builtin_amdgcn_global_load_lds((const unsigned*)((const char*)(gbase) + (voff)[_i]), (PG8_LAS unsigned*)(lds + (bufoff) + ldsw + _i * 8192), 16, 0, 0); } while (0)
#define PG8_LDA(dst, b, h) do { _Pragma("unroll") for (int m = 0; m < 4; ++m) _Pragma("unroll") for (int k = 0; k < 2; ++k) dst[m][k] = *(const PG8_LAS bf16x8*)(lds + PG8_SA(b, h) + aoff + m * 2048 + k * 1024); } while (0)
#define PG8_LDB(dst, b, h) do { _Pragma("unroll") for (int n = 0; n < 2; ++n) _Pragma("unroll") for (int k = 0; k < 2; ++k) dst[n][k] = *(const PG8_LAS bf16x8*)(lds + PG8_SB(b, h) + boff + n * 2048 + k * 1024); } while (0)
#define PG8_MMA(ai, bj, At, Bt) do { __builtin_amdgcn_s_setprio(1); _Pragma("unroll") for (int m = 0; m < 4; ++m) _Pragma("unroll") for (int n = 0; n < 2; ++n) _Pragma("unroll") for (int k = 0; k < 2; ++k) \
        acc[ai][bj][m][n] = __builtin_amdgcn_mfma_f32_16x16x32_bf16(Bt[n][k], At[m][k], acc[ai][bj][m][n], 0, 0, 0); __builtin_amdgcn_s_setprio(0); } while (0)
#define PG8_WAIT_V(n) asm volatile("s_waitcnt vmcnt(" #n ")" ::: "memory")
#define PG8_WAIT_L(n) asm volatile("s_waitcnt lgkmcnt(" #n ")" ::: "memory")
#define PG8_BAR __builtin_amdgcn_s_barrier()
#define PG8_SCHED __builtin_amdgcn_sched_barrier(0)
    Unit cur{0, 0, 0, 0}, nxt{0, 0, 0, 0}; int ui = 0;
    if (!S.next(0, cur)) return;
    f32x4 acc[2][2][4][2];
#pragma unroll
    for (int a = 0; a < 2; ++a)
#pragma unroll
        for (int b = 0; b < 2; ++b)
#pragma unroll
            for (int m = 0; m < 4; ++m)
#pragma unroll
                for (int n = 0; n < 2; ++n) acc[a][b][m][n] = (f32x4){0.f, 0.f, 0.f, 0.f};
    bf16x8 At[4][2], B0[2][2], B1[2][2];
    const char* cA = (const char*)g.A + (size_t)cur.pm * tstep + (size_t)cur.k0 * kstep; const char* cB = (const char*)g.Bt + (size_t)cur.pn * tstep + (size_t)cur.k0 * kstep; int nt = cur.nt ? cur.nt : ntf;
    S.a_ready(cur);
    if constexpr (SP2) {
        PG8_STAGE(PG8_SB(0, 0), cB, voffB); PG8_STAGE(PG8_SB(0, 1), cB + hstep, voffB); PG8_STAGE(PG8_SA(0, 0), cA, voffA); PG8_STAGE(PG8_SA(0, 1), cA + hstep, voffA);
        if (wr == 1) PG8_BAR;
        PG8_WAIT_V(2); PG8_BAR;
        PG8_STAGE(PG8_SB(1, 0), cB + kstep, voffB); PG8_STAGE(PG8_SA(1, 0), cA + kstep, voffA); PG8_STAGE(PG8_SB(1, 1), cB + hstep + kstep, voffB);
        PG8_WAIT_V(6); PG8_BAR;
    } else {
        PG8_STAGE(PG8_SB(0, 0), cB, voffB); PG8_STAGE(PG8_SA(0, 0), cA, voffA); PG8_STAGE(PG8_SB(0, 1), cB + hstep, voffB); PG8_STAGE(PG8_SA(0, 1), cA + hstep, voffA);
        if (wr == 1) PG8_BAR;
        PG8_WAIT_V(4); PG8_BAR;
        PG8_STAGE(PG8_SB(1, 0), cB + kstep, voffB); PG8_STAGE(PG8_SA(1, 0), cA + kstep, voffA); PG8_STAGE(PG8_SB(1, 1), cB + hstep + kstep, voffB);
        PG8_WAIT_V(6); PG8_BAR;
    }
    for (;;) {
        const bool has_next = S.next(ui + 1, nxt);
        const char* nA = has_next ? (const char*)g.A + (size_t)nxt.pm * tstep + (size_t)nxt.k0 * kstep : cA; const char* nB = has_next ? (const char*)g.Bt + (size_t)nxt.pn * tstep + (size_t)nxt.k0 * kstep : cB;
        for (int t = 0; t < nt; t += 2) {
            const bool last = (t == nt - 2);
            const char* a1 = cA + (size_t)(t + 1) * kstep;
            const char* a2 = last ? nA : cA + (size_t)(t + 2) * kstep; const char* b2 = last ? nB : cB + (size_t)(t + 2) * kstep;
            const char* a3 = a2 + kstep; const char* b3 = b2 + kstep;
            if (last && has_next) S.a_ready(nxt);
            if constexpr (SP2) {
            PG8_LDB(B0, 0, 0); PG8_LDB(B1, 0, 1); PG8_SCHED; PG8_LDA(At, 0, 0); PG8_STAGE(PG8_SA(1, 1), a1 + hstep, voffA);
            PG8_WAIT_V(8); PG8_WAIT_L(0); PG8_BAR; PG8_MMA(0, 0, At, B0); PG8_MMA(0, 1, At, B1); PG8_BAR; PG8_SCHED;
            PG8_LDA(At, 0, 1); PG8_STAGE(PG8_SB(0, 0), b2, voffB); PG8_STAGE(PG8_SB(0, 1), b2 + hstep, voffB); PG8_STAGE(PG8_SA(0, 0), a2, voffA);
            PG8_WAIT_V(8); PG8_WAIT_L(0); PG8_BAR; PG8_MMA(1, 0, At, B0); PG8_MMA(1, 1, At, B1); PG8_BAR; PG8_SCHED;
            PG8_LDB(B0, 1, 0); PG8_LDB(B1, 1, 1); PG8_SCHED; PG8_LDA(At, 1, 0); PG8_STAGE(PG8_SA(0, 1), a2 + hstep, voffA);
            PG8_WAIT_V(8); PG8_WAIT_L(0); PG8_BAR; PG8_MMA(0, 0, At, B0); PG8_MMA(0, 1, At, B1); PG8_BAR; PG8_SCHED;
            PG8_LDA(At, 1, 1); PG8_STAGE(PG8_SB(1, 0), b3, voffB); PG8_STAGE(PG8_SB(1, 1), b3 + hstep, voffB); PG8_STAGE(PG8_SA(1, 0), a3, voffA);
            PG8_WAIT_V(8); PG8_WAIT_L(0); PG8_BAR; PG8_MMA(1, 0, At, B0); PG8_MMA(1, 1, At, B1); PG8_BAR; PG8_SCHED;
            } else {
            PG8_LDB(B0, 0, 0); PG8_SCHED; PG8_LDA(At, 0, 0); PG8_STAGE(PG8_SA(1, 1), a1 + hstep, voffA);
            PG8_WAIT_L(8); PG8_BAR; PG8_WAIT_L(0); PG8_MMA(0, 0, At, B0); PG8_BAR; PG8_SCHED;
            PG8_LDB(B1, 0, 1); PG8_STAGE(PG8_SB(0, 0), b2, voffB);
            PG8_BAR; PG8_WAIT_L(0); PG8_MMA(0, 1, At, B1); PG8_BAR;
            PG8_LDA(At, 0, 1); PG8_STAGE(PG8_SA(0, 0), a2, voffA);
            PG8_BAR; PG8_WAIT_L(0); PG8_MMA(1, 0, At, B0); PG8_BAR; PG8_SCHED;
            PG8_STAGE(PG8_SB(0, 1), b2 + hstep, voffB);
            PG8_WAIT_V(6); PG8_BAR; PG8_MMA(1, 1, At, B1); PG8_BAR;
            PG8_LDB(B0, 1, 0); PG8_SCHED; PG8_LDA(At, 1, 0); PG8_STAGE(PG8_SA(0, 1), a2 + hstep, voffA);
            PG8_WAIT_L(8); PG8_BAR; PG8_WAIT_L(0); PG8_MMA(0, 0, At, B0); PG8_BAR; PG8_SCHED;
            PG8_LDB(B1, 1, 1); PG8_STAGE(PG8_SB(1, 0), b3, voffB);
            PG8_BAR; PG8_WAIT_L(0); PG8_MMA(0, 1, At, B1); PG8_BAR;
            PG8_LDA(At, 1, 1); PG8_STAGE(PG8_SA(1, 0), a3, voffA);
            PG8_BAR; PG8_WAIT_L(0); PG8_MMA(1, 0, At, B0); PG8_BAR; PG8_SCHED;
            PG8_STAGE(PG8_SB(1, 1), b3 + hstep, voffB);
            PG8_WAIT_V(6); PG8_BAR; PG8_MMA(1, 1, At, B1); PG8_BAR;
            }
        }
        if constexpr (ALIGN_EPI) { if (wr == 0) PG8_BAR; }
        if constexpr (!Epi::AFTER_DRAIN) { E(acc, cur, wr, wc, fr, fq); S.done(cur); }
        if (!has_next) break;
#pragma unroll
        for (int a = 0; a < 2; ++a)
#pragma unroll
            for (int b = 0; b < 2; ++b)
#pragma unroll
                for (int m = 0; m < 4; ++m)
#pragma unroll
                    for (int n = 0; n < 2; ++n) acc[a][b][m][n] = (f32x4){0.f, 0.f, 0.f, 0.f};
        cur = nxt; cA = nA; cB = nB; ++ui; nt = cur.nt ? cur.nt : ntf;
        if constexpr (ALIGN_EPI) { if (wr == 1) PG8_BAR; }
    }
    PG8_WAIT_V(0);
    if constexpr (!ALIGN_EPI) { if (wr == 0) PG8_BAR; }
    PG8_BAR;
    if constexpr (Epi::AFTER_DRAIN) { E.fused(acc, cur, wr, wc, fr, fq, lds, wid, lane); S.done(cur); }
#undef PG8_SA
#undef PG8_SB
#undef PG8_STAGE
#undef PG8_LDA
#undef PG8_LDB
#undef PG8_MMA
#undef PG8_WAIT_V
#undef PG8_WAIT_L
#undef PG8_BAR
#undef PG8_SCHED
}
}

constexpr int NWAVES = 8, NTHR = 512;
constexpr int RING_BYTES = 131072, LDS_BYTES = 147456;
struct Params { const float* in[19]; float* out; unsigned char* ws; int ph_lo, ph_hi; };

struct Ctx {
    LAS unsigned char* lds;
    int tid, lane, wave, G, bid;
    const float* in[19]; float* out; unsigned char* ws;
};
#define CTX_GW(C) ((C).bid * NWAVES + (C).wave)
#define CTX_NGW(C) ((C).G * NWAVES)

__device__ __forceinline__ float wave_sum(float v) {
#pragma unroll
    for (int o = 1; o < 64; o <<= 1) v += __shfl_xor(v, o);
    return v;
}
__device__ __forceinline__ float wave_max(float v) {
#pragma unroll
    for (int o = 1; o < 64; o <<= 1) v = fmaxf(v, __shfl_xor(v, o));
    return v;
}
__device__ __forceinline__ f32x4 mfma16(bf16x8 a, bf16x8 b, f32x4 c) { return __builtin_amdgcn_mfma_f32_16x16x32_bf16(a, b, c, 0, 0, 0); }

__device__ __forceinline__ void transpose_item(const float* W, int K, int N, int srccol0, bf16* WT, int dstrow0, int k0, LAS float* scr, int lane) {
#pragma unroll 8
    for (int i = 0; i < 32; ++i) { const int kk = 2 * i + (lane >> 5); scr[kk * 33 + (lane & 31)] = W[(size_t)(k0 + kk) * N + srccol0 + (lane & 31)]; }
    LDS_WAIT();
    const int c = lane & 7;
#pragma unroll
    for (int j = 0; j < 4; ++j) { const int n = (lane >> 3) + 8 * j; const LAS float* s = scr + (8 * c) * 33 + n;
        v4u o; o.x = pk2(s[0 * 33], s[1 * 33]); o.y = pk2(s[2 * 33], s[3 * 33]); o.z = pk2(s[4 * 33], s[5 * 33]); o.w = pk2(s[6 * 33], s[7 * 33]);
        *(v4u*)(WT + (size_t)(dstrow0 + n) * K + k0 + 8 * c) = o; }
    LDS_WAIT();
}
__device__ __forceinline__ void phase_prologue(Ctx& C) {
    LAS float* scr = (LAS float*)(C.lds + C.wave * 16384);
    const int gw = CTX_GW(C), NGW = CTX_NGW(C);
    constexpr int I_UP = 16 * 176, I_DN = 44 * 32, I_IN = 16 * 112, I_OUT = 16 * 32, I_LAYER = 2 * I_UP + 2 * I_DN + I_IN + I_OUT;
    for (int it = gw; it < 2 * I_LAYER; it += NGW) {
        const int l = it / I_LAYER; int r = it % I_LAYER;
        int which;
        if (r < I_UP) which = 0; else if ((r -= I_UP) < I_DN) which = 1; else if ((r -= I_DN) < I_IN) which = 2; else if ((r -= I_IN) < I_OUT) which = 3; else if ((r -= I_OUT) < I_UP) which = 4; else { r -= I_UP; which = 5; }
        if (which == 0 || which == 4) {
            const int nb = r % 176, kb = r / 176, d0 = nb * 32, pn = d0 >> 8, w = d0 & 255;
            const int src = (w < 128) ? (128 * pn + w) : (DFF + 128 * pn + (w - 128));
            const float* W = C.in[which == 0 ? 7 : 16] + (size_t)l * DM * 2 * DFF;
            bf16* WT = (bf16*)(C.ws + WS_W1T) + (size_t)(l * 2 + (which == 4)) * W1T_SZ;
            transpose_item(W, DM, 2 * DFF, src, WT, d0, kb * 64, scr, C.lane);
        } else if (which == 1 || which == 5) {
            const int nb = r % 32, kb = r / 32;
            const float* W = C.in[which == 1 ? 8 : 17] + (size_t)l * DFF * DM;
            bf16* WT = (bf16*)(C.ws + WS_W2T) + (size_t)(l * 2 + (which == 5)) * W2T_SZ;
            transpose_item(W, DFF, DM, nb * 32, WT, nb * 32, kb * 64, scr, C.lane);
        } else if (which == 2) {
            const int nb = r % 112, kb = r / 112, d0 = nb * 32, src = d0 < 1536 ? d0 : d0 + 8;
            transpose_item(C.in[10] + (size_t)l * DM * NIN_RAW, DM, NIN_RAW, src, (bf16*)(C.ws + WS_WINT) + (size_t)l * WINT_SZ, d0, kb * 64, scr, C.lane);
        } else {
            const int nb = r % 32, kb = r / 32;
            transpose_item(C.in[14] + (size_t)l * DM * DM, DM, DM, nb * 32, (bf16*)(C.ws + WS_WOT) + (size_t)l * WOT_SZ, nb * 32, kb * 64, scr, C.lane);
        }
    }
    const int gt = C.bid * NTHR + C.tid, NGT = C.G * NTHR;
    float* WFG = (float*)(C.ws + WS_WFG);
    for (int i = gt; i < 2 * 8 * DM; i += NGT) { const int l = i >> 13, j = (i >> 10) & 7, k = i & 1023; WFG[i] = C.in[10][((size_t)l * DM + k) * NIN_RAW + 1536 + j]; }
    float* LB = (float*)(C.ws + WS_LB);
    for (int i = gt; i < 512; i += NGT) { const float p0 = C.in[12][i], p1 = C.in[12][512 + i], mx = fmaxf(p0, p1), e0 = expf(p0 - mx), e1 = expf(p1 - mx);
        LB[i] = 0.f; LB[512 + i] = e1 / (e0 + e1); }
    f32x4* X4 = (f32x4*)(C.ws + WS_X); const f32x4* xp = (const f32x4*)C.in[0]; const f32x4* xs = (const f32x4*)C.in[1];
    for (int i = gt; i < MP * DM / 4; i += NGT) X4[i] = xp[i];
    for (int i = gt; i < MS * DM / 4; i += NGT) X4[MP * DM / 4 + i] = xs[i];
}

template <int MODE> __device__ __forceinline__ void phase_rms(Ctx& C, const float* g, int l) {
    const int gw = CTX_GW(C), NGW = CTX_NGW(C), lane = C.lane;
    const float* X = (const float*)(C.ws + WS_X); bf16* HN = (bf16*)(C.ws + WS_HN);
    f32x4 gv[4];
#pragma unroll
    for (int j = 0; j < 4; ++j) gv[j] = ((const f32x4*)g)[lane + 64 * j];
    for (int row = gw; row < MT; row += NGW) {
        const f32x4* xr = (const f32x4*)(X + (size_t)row * DM) + lane;
        f32x4 v[4]; float s = 0.f;
#pragma unroll
        for (int j = 0; j < 4; ++j) { v[j] = xr[64 * j]; s += (v[j].x * v[j].x + v[j].y * v[j].y) + (v[j].z * v[j].z + v[j].w * v[j].w); }
        const float rstd = 1.0f / sqrtf(wave_sum(s) * (1.0f / DM) + RMS_EPS);
#pragma unroll
        for (int j = 0; j < 4; ++j) v[j] = v[j] * rstd * gv[j];
        if (MODE == 2) {
            float* o = C.out + (row < MP ? O_YP + (size_t)row * DM : O_YS + (size_t)(row - MP) * DM);
#pragma unroll
            for (int j = 0; j < 4; ++j) ((f32x4*)o)[lane + 64 * j] = v[j];
        } else {
            v2u* o8 = (v2u*)(HN + (size_t)row * DM) + lane;
#pragma unroll
            for (int j = 0; j < 4; ++j) { v2u w; w.x = pk2(v[j].x, v[j].y); w.y = pk2(v[j].z, v[j].w); o8[64 * j] = w; }
        }
        if (MODE == 1) {
            const float* WFG = (const float*)(C.ws + WS_WFG) + (size_t)l * 8 * DM;
            float fg[8];
#pragma unroll
            for (int jj = 0; jj < 8; ++jj) { float a = 0.f;
#pragma unroll
                for (int j = 0; j < 4; ++j) { const f32x4 w = ((const f32x4*)(WFG + jj * DM))[lane + 64 * j]; a += (v[j].x * w.x + v[j].y * w.y) + (v[j].z * w.z + v[j].w * w.w); }
                fg[jj] = wave_sum(a); }
            float mine = fg[0];
#pragma unroll
            for (int jj = 1; jj < 8; ++jj) mine = (lane == jj) ? fg[jj] : mine;
            if (lane < 8) { const float lf = log_sigmoidf_(mine + C.in[11][l * 8 + lane]);
                size_t o;
                if (row < MP) { const int b = row >> 13, t = row & 8191; o = O_LFP + (((size_t)l * 2 + b) * 8 + lane) * 8192 + t; }
                else { const int rs = row - MP, b = rs >> 4, t = rs & 15; o = O_LFS + (((size_t)l * 32 + b) * 8 + lane) * 16 + t; }
                C.out[o] = lf; }
        }
    }
}

constexpr int HL_LF = 0, HL_SEG = 32768, HL_QT = 34816, HL_KTL = HL_QT + 17408, HL_VT = HL_KTL + 17408, HL_ST = HL_VT + 18432, HL_AS = HL_ST + 34816, HL_KH = HL_AS + 9216, HL_END = HL_KH + 10240;
static_assert(HL_END <= LDS_BYTES - 1024, "HGRN LDS map");
constexpr int HP_Q = 136, HP_V = 72, HP_O = 132;

template <int CH> __device__ __forceinline__ void hgrn_decay_prefix(Ctx& C, const float* HALL, int row0, int h, const float* lb) {
    LAS float* LF = (LAS float*)(C.lds + HL_LF); LAS float* SEG = (LAS float*)(C.lds + HL_SEG);
    const int tid = C.tid;
    for (int idx = tid; idx < CH * 128; idx += NTHR) { const int s = idx >> 7, d = idx & 127;
        const float z = HALL[(size_t)(row0 + s) * 2048 + 512 + h * 128 + d], lbv = lb[d];
        LF[idx] = (lbv == 0.f) ? log_sigmoidf_(z) : logf(lbv + (1.f - lbv) * sigmoidf_(z)); }
    __syncthreads();
    const int seg = tid >> 7, d = tid & 127; constexpr int R = CH / 4;
    float run = 0.f;
#pragma unroll
    for (int i = 0; i < R; ++i) { run += LF[(seg * R + i) * 128 + d]; LF[(seg * R + i) * 128 + d] = run; }
    SEG[seg * 128 + d] = run;
    __syncthreads();
    float off = 0.f;
#pragma unroll
    for (int s2 = 0; s2 < 3; ++s2) if (s2 < seg) off += SEG[s2 * 128 + d];
#pragma unroll
    for (int i = 0; i < R; ++i) LF[(seg * R + i) * 128 + d] += off;
    __syncthreads();
}

__device__ __forceinline__ void hgrn_local_unit(Ctx& C, int unit, int l) {
    const int bh = unit >> 7, c = unit & 127, b = bh >> 2, h = bh & 3, row0 = b * SEQ + c * 64;
    const float* HALL = (const float*)(C.ws + WS_HALL); const float* lb = (const float*)(C.ws + WS_LB) + l * 512 + h * 128;
    hgrn_decay_prefix<64>(C, HALL, row0, h, lb);
    LAS float* LF = (LAS float*)(C.lds + HL_LF);
    LAS bf16* KT = (LAS bf16*)(C.lds + HL_QT); LAS bf16* VT = (LAS bf16*)(C.lds + HL_VT);
    const int tid = C.tid;
    for (int idx = tid; idx < 64 * 128; idx += NTHR) { const int s = idx >> 7, d = idx & 127;
        const float* hr = HALL + (size_t)(row0 + s) * 2048 + h * 128 + d;
        const float z = hr[512], v = hr[1024], k = (1.f - lb[d]) * sigmoidf_(-z);
        KT[d * HP_V + s] = f2bf(k * __expf(LF[63 * 128 + d] - LF[idx])); VT[d * HP_V + s] = f2bf(v); }
    if (tid < 128) ((float*)(C.ws + WS_G))[(size_t)unit * 128 + tid] = __expf(LF[63 * 128 + tid]);
    __syncthreads();
    const int lane = C.lane, w = C.wave, r16 = lane & 15, quad = lane >> 4;
    f32x4 acc[8];
#pragma unroll
    for (int nb = 0; nb < 8; ++nb) acc[nb] = (f32x4){0.f, 0.f, 0.f, 0.f};
#pragma unroll
    for (int ks = 0; ks < 2; ++ks) { const bf16x8 a = *(const LAS bf16x8*)(VT + (w * 16 + r16) * HP_V + ks * 32 + quad * 8);
#pragma unroll
        for (int nb = 0; nb < 8; ++nb) { const bf16x8 bb = *(const LAS bf16x8*)(KT + (nb * 16 + r16) * HP_V + ks * 32 + quad * 8); acc[nb] = mfma16(a, bb, acc[nb]); } }
    float* US = (float*)(C.ws + WS_US) + (size_t)unit * 16384;
#pragma unroll
    for (int nb = 0; nb < 8; ++nb)
#pragma unroll
        for (int j = 0; j < 4; ++j) US[(w * 16 + quad * 4 + j) * 128 + nb * 16 + r16] = acc[nb][j];
    __syncthreads();
}

__device__ __forceinline__ void hgrn_scan(Ctx& C, int l, bool dummy = false) {
    float* US = (float*)(C.ws + WS_US); const size_t doff = dummy ? (WS_END - WS_US) / 4 : 0; const float* Gg = (const float*)(C.ws + WS_G);
    for (int e = C.bid * NTHR + C.tid; e < 8 * 16384; e += C.G * NTHR) {
        const int bh = e >> 14, el = e & 16383, dk = el & 127, dv = el >> 7;
        float* p = US + (size_t)bh * 128 * 16384 + el; const float* gp = Gg + (size_t)bh * 128 * 128 + dk;
        float s = 0.f;
        for (int c0 = 0; c0 < 128; c0 += 8) { float u[8], g[8];
#pragma unroll
            for (int i = 0; i < 8; ++i) { u[i] = p[(size_t)(c0 + i) * 16384]; g[i] = gp[(c0 + i) * 128]; }
#pragma unroll
            for (int i = 0; i < 8; ++i) { p[(size_t)(c0 + i) * 16384 + doff] = s; s = g[i] * s + u[i]; } }
        if (!dummy) C.out[O_HSP + ((size_t)l * 8 + bh) * 16384 + dk * 128 + dv] = s;
    }
}

template <int CH> __device__ __forceinline__ void hgrn_out_unit(Ctx& C, int unit, int l) {
    int row0, h, bh; const float* Ssrc;
    if (CH == 64) { bh = unit >> 7; const int c = unit & 127, b = bh >> 2; h = bh & 3; row0 = b * SEQ + c * 64; Ssrc = (const float*)(C.ws + WS_US) + (size_t)unit * 16384; }
    else { bh = unit; const int b = unit >> 2; h = unit & 3; row0 = MP + b * 16; Ssrc = C.in[5] + ((size_t)l * 128 + unit) * 16384; }
    const float* HALL = (const float*)(C.ws + WS_HALL); const float* lb = (const float*)(C.ws + WS_LB) + l * 512 + h * 128;
    hgrn_decay_prefix<CH>(C, HALL, row0, h, lb);
    LAS float* LF = (LAS float*)(C.lds + HL_LF);
    LAS bf16* QT = (LAS bf16*)(C.lds + HL_QT); LAS bf16* KTL = (LAS bf16*)(C.lds + HL_KTL); LAS bf16* VT = (LAS bf16*)(C.lds + HL_VT);
    LAS bf16* ST = (LAS bf16*)(C.lds + HL_ST); LAS bf16* AS = (LAS bf16*)(C.lds + HL_AS);
    LAS bf16* KH = (LAS bf16*)(C.lds + HL_KH);
    LAS float* BL = (LAS float*)(C.lds + HL_SEG);
    const int tid = C.tid; constexpr int MID = CH / 2, SP = (CH < 32) ? 32 : CH;
    if (CH == 16) {
        for (int i = tid; i < 128 * 16; i += NTHR) { const int d = i >> 4, s = 16 + (i & 15); VT[d * HP_V + s] = 0; KH[d * 40 + s] = 0; if (d < 16) AS[d * HP_V + s] = 0; }
    }
    for (int idx = tid; idx < CH * 128; idx += NTHR) { const int s = idx >> 7, d = idx & 127;
        const float* hr = HALL + (size_t)(row0 + s) * 2048 + h * 128 + d;
        const float q = hr[0], z = hr[512], v = hr[1024], k = (1.f - lb[d]) * sigmoidf_(-z);
        const float bs = LF[idx], r = LF[MID * 128 + d];
        QT[s * HP_Q + d] = f2bf(q * __expf(fminf(bs - r, 80.f))); KTL[s * HP_Q + d] = f2bf(k * __expf(fminf(r - bs, 80.f))); VT[d * HP_V + s] = f2bf(v);
        if (CH == 16) { KH[d * 40 + s] = f2bf(k * __expf(LF[(CH - 1) * 128 + d] - bs)); if (s == CH - 1) BL[d] = bs; } }
    if (CH == 64) { for (int i = tid; i < 16384; i += NTHR) { const int dv = i >> 7, dk = i & 127; ST[dv * HP_Q + dk] = f2bf(Ssrc[i] * __expf(LF[MID * 128 + dk])); } }
    else { for (int i = tid; i < 16384; i += NTHR) { const int dk = i >> 7, dv = i & 127; ST[dv * HP_Q + dk] = f2bf(Ssrc[i] * __expf(LF[MID * 128 + dk])); } }
    __syncthreads();
    const int lane = C.lane, w = C.wave, r16 = lane & 15, quad = lane >> 4;
    { constexpr int NTB = CH / 16;
      for (int blk = w; blk < NTB * NTB; blk += NWAVES) { const int tb = blk / NTB, sb = blk % NTB;
        f32x4 a = (f32x4){0.f, 0.f, 0.f, 0.f};
        if (sb <= tb) {
#pragma unroll
            for (int ks = 0; ks < 4; ++ks) { const bf16x8 qa = *(const LAS bf16x8*)(QT + (tb * 16 + r16) * HP_Q + ks * 32 + quad * 8), kb = *(const LAS bf16x8*)(KTL + (sb * 16 + r16) * HP_Q + ks * 32 + quad * 8); a = mfma16(qa, kb, a); } }
#pragma unroll
        for (int j = 0; j < 4; ++j) { const int t = tb * 16 + quad * 4 + j, s = sb * 16 + r16; AS[t * HP_V + s] = f2bf(s <= t ? a[j] : 0.f); } } }
    __syncthreads();
    LAS float* OS = (LAS float*)(C.lds + HL_LF);
    { constexpr int NTB = CH / 16;
      for (int blk = w; blk < NTB * 8; blk += NWAVES) { const int tb = blk >> 3, db = blk & 7;
        f32x4 o = (f32x4){0.f, 0.f, 0.f, 0.f};
#pragma unroll
        for (int ks = 0; ks < SP / 32; ++ks) { const bf16x8 pa = *(const LAS bf16x8*)(AS + (tb * 16 + r16) * HP_V + ks * 32 + quad * 8), vb = *(const LAS bf16x8*)(VT + (db * 16 + r16) * HP_V + ks * 32 + quad * 8); o = mfma16(pa, vb, o); }
#pragma unroll
        for (int ks = 0; ks < 4; ++ks) { const bf16x8 qa = *(const LAS bf16x8*)(QT + (tb * 16 + r16) * HP_Q + ks * 32 + quad * 8), sb_ = *(const LAS bf16x8*)(ST + (db * 16 + r16) * HP_Q + ks * 32 + quad * 8); o = mfma16(qa, sb_, o); }
#pragma unroll
        for (int j = 0; j < 4; ++j) OS[(tb * 16 + quad * 4 + j) * HP_O + db * 16 + r16] = o[j]; } }
    if (CH == 16) {
        f32x4 acc[8];
        const bf16x8 a = *(const LAS bf16x8*)(KH + (w * 16 + r16) * 40 + quad * 8);
#pragma unroll
        for (int nb = 0; nb < 8; ++nb) { const bf16x8 vb = *(const LAS bf16x8*)(VT + (nb * 16 + r16) * HP_V + quad * 8); acc[nb] = mfma16(a, vb, (f32x4){0.f, 0.f, 0.f, 0.f}); }
        float* So = C.out + O_HSS + ((size_t)l * 128 + unit) * 16384;
#pragma unroll
        for (int j = 0; j < 4; ++j) { const int dk = w * 16 + quad * 4 + j; const float g = __expf(BL[dk]);
#pragma unroll
            for (int nb = 0; nb < 8; ++nb) { const int dv = nb * 16 + r16; So[dk * 128 + dv] = g * Ssrc[dk * 128 + dv] + acc[nb][j]; } }
    }
    __syncthreads();
    if (tid < CH * 8) { const int t = tid >> 3, part = tid & 7; const LAS float* orow = OS + t * HP_O + part * 16;
        float ov[16]; float ss = 0.f;
#pragma unroll
        for (int i = 0; i < 4; ++i) { const f32x4 x = *(const LAS f32x4*)(orow + 4 * i); ov[4 * i] = x.x; ov[4 * i + 1] = x.y; ov[4 * i + 2] = x.z; ov[4 * i + 3] = x.w; ss += (x.x * x.x + x.y * x.y) + (x.z * x.z + x.w * x.w); }
        ss += __shfl_xor(ss, 1); ss += __shfl_xor(ss, 2); ss += __shfl_xor(ss, 4);
        const float rstd = 1.0f / sqrtf(ss * (1.0f / 128.f) + RMS_EPS);
        const float* gn = C.in[13] + l * 128 + part * 16; const float* hg = HALL + (size_t)(row0 + t) * 2048 + 1536 + h * 128 + part * 16;
        bf16* mo = (bf16*)(C.ws + WS_MIX) + (size_t)(row0 + t) * DM + 512 + h * 128 + part * 16;
        v4u w0, w1; unsigned pk[8];
#pragma unroll
        for (int i = 0; i < 8; ++i) pk[i] = pk2(ov[2 * i] * rstd * gn[2 * i] * siluf_(hg[2 * i]), ov[2 * i + 1] * rstd * gn[2 * i + 1] * siluf_(hg[2 * i + 1]));
        w0.x = pk[0]; w0.y = pk[1]; w0.z = pk[2]; w0.w = pk[3]; w1.x = pk[4]; w1.y = pk[5]; w1.z = pk[6]; w1.w = pk[7];
        *(v4u*)mo = w0; *(v4u*)(mo + 8) = w1; }
    __syncthreads();
}

__device__ __forceinline__ float block_excl_scan(Ctx& C, float total, LAS float* sm) {
    float x = total;
#pragma unroll
    for (int o = 1; o < 64; o <<= 1) { const float y = __shfl_up(x, o); if (C.lane >= o) x += y; }
    if (C.lane == 63) sm[C.wave] = x;
    __syncthreads();
    float woff = 0.f;
#pragma unroll
    for (int w2 = 0; w2 < NWAVES; ++w2) if (w2 < C.wave) woff += sm[w2];
    __syncthreads();
    return woff + (x - total);
}
__device__ __forceinline__ void cumsum_unit(Ctx& C, int unit, int l) {
    LAS float* sm = (LAS float*)(C.lds);
    if (unit < 16) {
        const float* src = C.out + O_LFP + ((size_t)l * 16 + unit) * 8192 + C.tid * 16; float* dst = (float*)(C.ws + WS_CP) + (size_t)unit * 8192 + C.tid * 16;
        float v[16];
#pragma unroll
        for (int i = 0; i < 4; ++i) { const f32x4 x = ((const f32x4*)src)[i]; v[4 * i] = x.x; v[4 * i + 1] = x.y; v[4 * i + 2] = x.z; v[4 * i + 3] = x.w; }
#pragma unroll
        for (int i = 1; i < 16; ++i) v[i] += v[i - 1];
        const float off = block_excl_scan(C, v[15], sm);
#pragma unroll
        for (int i = 0; i < 4; ++i) ((f32x4*)dst)[i] = (f32x4){(v[4 * i] + off) * LOG2E, (v[4 * i + 1] + off) * LOG2E, (v[4 * i + 2] + off) * LOG2E, (v[4 * i + 3] + off) * LOG2E};
    } else {
        const int bh = unit - 16;
        const float* src = C.in[4] + ((size_t)l * 256 + bh) * PAST + C.tid * 4; float* dst = (float*)(C.ws + WS_CS) + (size_t)bh * SKV;
        f32x4 x = *(const f32x4*)src; x.y += x.x; x.z += x.y; x.w += x.z;
        const float off = block_excl_scan(C, x.w, sm);
        *(f32x4*)(dst + C.tid * 4) = (x + off) * LOG2E;
        if (C.tid == NTHR - 1) { float run = x.w + off; const float* nl = C.out + O_LFS + ((size_t)l * 256 + bh) * 16;
            for (int t = 0; t < 16; ++t) { run += nl[t]; dst[PAST + t] = run * LOG2E; } }
    }
}
__device__ __forceinline__ void ktn_task(Ctx& C, int task) {
    const int bh = task >> 7, tile = task & 127, b = bh >> 3, h = bh & 7, lane = C.lane;
    const bf16* Kb = (const bf16*)(C.ws + WS_KB) + ((size_t)b * SEQ + tile * 64) * 512 + h * 64;
    float mx = 0.f;
#pragma unroll
    for (int i = 0; i < 8; ++i) { const int key = i * 8 + (lane >> 3); const v4u w = *(const v4u*)(Kb + (size_t)key * 512 + (lane & 7) * 8);
        float s = 0.f; const unsigned ww[4] = {w.x, w.y, w.z, w.w};
#pragma unroll
        for (int e = 0; e < 4; ++e) { const float lo = __builtin_bit_cast(float, ww[e] << 16), hi = __builtin_bit_cast(float, ww[e] & 0xffff0000u); s += lo * lo + hi * hi; }
        s += __shfl_xor(s, 1); s += __shfl_xor(s, 2); s += __shfl_xor(s, 4);
        mx = fmaxf(mx, s); }
    mx = wave_max(mx);
    if (lane == 0) ((float*)(C.ws + WS_KTN))[task] = sqrtf(mx);
}

constexpr int AT_SLOT = 16384, AT_VT = 0, AT_P = 9216, AP = 72;
struct AttnState { bf16x8 qa[2]; float cq[4], m[4], l[4]; f32x4 o[4]; };
__device__ __forceinline__ bf16x8 kfrag_bf16(const bf16* p) { return *(const bf16x8*)p; }
__device__ __forceinline__ bf16x8 kfrag_f32(const float* p) { const f32x4 a = *(const f32x4*)p, b = *(const f32x4*)(p + 4); v4u w; w.x = pk2(a.x, a.y); w.y = pk2(a.z, a.w); w.z = pk2(b.x, b.y); w.w = pk2(b.z, b.w); return __builtin_bit_cast(bf16x8, w); }
template <bool F32> __device__ __forceinline__ void attn_tile(AttnState& S, const void* Ksrc, const void* Vsrc, int pitch, int nvalid, const float* ck, int diag, LAS bf16* VT, LAS bf16* PL, int lane) {
    const int col = lane & 15, quad = lane >> 4;
    if (F32) { const float* V = (const float*)Vsrc;
#pragma unroll 4
        for (int i = 0; i < 16; ++i) { const int key = i * 4 + (lane >> 4), dc = (lane & 15) * 4; f32x4 x = (f32x4){0.f, 0.f, 0.f, 0.f};
            if (key < nvalid) x = *(const f32x4*)(V + (size_t)key * pitch + dc);
            VT[(dc + 0) * AP + key] = f2bf(x.x); VT[(dc + 1) * AP + key] = f2bf(x.y); VT[(dc + 2) * AP + key] = f2bf(x.z); VT[(dc + 3) * AP + key] = f2bf(x.w); }
    } else { const bf16* V = (const bf16*)Vsrc;
#pragma unroll 4
        for (int i = 0; i < 8; ++i) { const int key = i * 8 + (lane >> 3), dc = (lane & 7) * 8; v4u w = (v4u){0u, 0u, 0u, 0u};
            if (key < nvalid) w = *(const v4u*)(V + (size_t)key * pitch + dc);
            VT[(dc + 0) * AP + key] = (bf16)(w.x & 0xffffu); VT[(dc + 1) * AP + key] = (bf16)(w.x >> 16); VT[(dc + 2) * AP + key] = (bf16)(w.y & 0xffffu); VT[(dc + 3) * AP + key] = (bf16)(w.y >> 16);
            VT[(dc + 4) * AP + key] = (bf16)(w.z & 0xffffu); VT[(dc + 5) * AP + key] = (bf16)(w.z >> 16); VT[(dc + 6) * AP + key] = (bf16)(w.w & 0xffffu); VT[(dc + 7) * AP + key] = (bf16)(w.w >> 16); }
    }
    f32x4 s[4];
#pragma unroll
    for (int nb = 0; nb < 4; ++nb) { const int key = nb * 16 + col, kc = key < nvalid ? key : (nvalid - 1);
        f32x4 a = (f32x4){0.f, 0.f, 0.f, 0.f};
#pragma unroll
        for (int ks = 0; ks < 2; ++ks) { const bf16x8 kb = F32 ? kfrag_f32((const float*)Ksrc + (size_t)kc * pitch + ks * 32 + quad * 8) : kfrag_bf16((const bf16*)Ksrc + (size_t)kc * pitch + ks * 32 + quad * 8);
            a = mfma16(S.qa[ks], kb, a); }
        const float ckv = ck[kc];
#pragma unroll
        for (int j = 0; j < 4; ++j) { const int r = quad * 4 + j; const bool ok = (key < nvalid) && (key <= r + diag); a[j] = ok ? (a[j] + (S.cq[j] - ckv)) : -INFINITY; }
        s[nb] = a; }
    float alpha[4];
#pragma unroll
    for (int j = 0; j < 4; ++j) { float mx = fmaxf(fmaxf(s[0][j], s[1][j]), fmaxf(s[2][j], s[3][j]));
        mx = fmaxf(mx, __shfl_xor(mx, 1)); mx = fmaxf(mx, __shfl_xor(mx, 2)); mx = fmaxf(mx, __shfl_xor(mx, 4)); mx = fmaxf(mx, __shfl_xor(mx, 8));
        const float mnew = fmaxf(S.m[j], mx), msafe = (mnew == -INFINITY) ? 0.f : mnew;
        alpha[j] = fast_exp2(S.m[j] - msafe); S.m[j] = mnew;
        float ps = 0.f;
#pragma unroll
        for (int nb = 0; nb < 4; ++nb) { const float p = fast_exp2(s[nb][j] - msafe); s[nb][j] = p; ps += p; }
        S.l[j] = S.l[j] * alpha[j] + ps; }
#pragma unroll
    for (int nb = 0; nb < 4; ++nb)
#pragma unroll
        for (int j = 0; j < 4; ++j) { PL[(quad * 4 + j) * AP + nb * 16 + col] = f2bf(s[nb][j]); S.o[nb][j] *= alpha[j]; }
    LDS_WAIT(); __builtin_amdgcn_wave_barrier(); asm volatile("" ::: "memory");
    bf16x8 pa[2];
#pragma unroll
    for (int ks = 0; ks < 2; ++ks) pa[ks] = *(const LAS bf16x8*)(PL + col * AP + ks * 32 + quad * 8);
#pragma unroll
    for (int nb = 0; nb < 4; ++nb)
#pragma unroll
        for (int ks = 0; ks < 2; ++ks) { const bf16x8 vb = *(const LAS bf16x8*)(VT + (nb * 16 + col) * AP + ks * 32 + quad * 8); S.o[nb] = mfma16(pa[ks], vb, S.o[nb]); }
    LDS_WAIT(); __builtin_amdgcn_wave_barrier(); asm volatile("" ::: "memory");
}
__device__ __forceinline__ void attn_init(AttnState& S, const bf16* Qrow0, const float* cq0, int lane) {
    const int col = lane & 15, quad = lane >> 4;
#pragma unroll
    for (int ks = 0; ks < 2; ++ks) S.qa[ks] = *(const bf16x8*)(Qrow0 + (size_t)col * 512 + ks * 32 + quad * 8);
#pragma unroll
    for (int j = 0; j < 4; ++j) { S.cq[j] = cq0[quad * 4 + j]; S.m[j] = -INFINITY; S.l[j] = 0.f; }
#pragma unroll
    for (int nb = 0; nb < 4; ++nb) S.o[nb] = (f32x4){0.f, 0.f, 0.f, 0.f};
}
__device__ __forceinline__ float attn_qmax(const AttnState& S) {
    float s = 0.f;
#pragma unroll
    for (int ks = 0; ks < 2; ++ks)
#pragma unroll
        for (int e = 0; e < 8; ++e) { const float x = bf2f((bf16)S.qa[ks][e]); s += x * x; }
    s += __shfl_xor(s, 16); s += __shfl_xor(s, 32);
    return sqrtf(wave_max(s));
}
__device__ __forceinline__ void attn_prompt_task(Ctx& C, int task) {
    const int bh = task >> 9, rb = task & 511, b = bh >> 3, h = bh & 7, lane = C.lane, i0 = rb * 16;
    const bf16* Qb = (const bf16*)(C.ws + WS_QB); const bf16* Kb = (const bf16*)(C.ws + WS_KB); const bf16* Vb = (const bf16*)(C.ws + WS_VB);
    const float* cp = (const float*)(C.ws + WS_CP) + (size_t)bh * SEQ;
    LAS bf16* VT = (LAS bf16*)(C.lds + C.wave * AT_SLOT + AT_VT); LAS bf16* PL = (LAS bf16*)(C.lds + C.wave * AT_SLOT + AT_P);
    AttnState S; attn_init(S, Qb + ((size_t)b * SEQ + i0) * 512 + h * 64, cp + i0, lane);
    const float* ktn = (const float*)(C.ws + WS_KTN) + bh * 128;
    const float kmax = wave_max(fmaxf(ktn[lane], ktn[lane + 64])), bound = 2.0f * attn_qmax(S) * kmax;
    const int jd = i0 >> 6; const float c0 = cp[i0];
    int jstart = jd;
    { const int t0 = lane, t1 = lane + 64;
      const bool n0 = (t0 < jd) && (c0 - cp[t0 * 64 + 63] + bound >= -151.5f), n1 = (t1 < jd) && (c0 - cp[(t1 < jd ? t1 : 0) * 64 + 63] + bound >= -151.5f);
      const unsigned long long m0 = __ballot(n0), m1 = __ballot(n1);
      if (m0) jstart = __builtin_ctzll(m0); else if (m1) jstart = 64 + __builtin_ctzll(m1); }
    for (int t = jstart; t <= jd; ++t) {
        const size_t krow = ((size_t)b * SEQ + t * 64) * 512 + h * 64;
        attn_tile<false>(S, Kb + krow, Vb + krow, 512, 64, cp + t * 64, (t == jd) ? (i0 - t * 64) : 64, VT, PL, lane);
    }
    const int col = lane & 15, quad = lane >> 4;
#pragma unroll
    for (int j = 0; j < 4; ++j) { float lt = S.l[j]; lt += __shfl_xor(lt, 1); lt += __shfl_xor(lt, 2); lt += __shfl_xor(lt, 4); lt += __shfl_xor(lt, 8); const float inv = 1.0f / lt;
#pragma unroll
        for (int nb = 0; nb < 4; ++nb) PL[(quad * 4 + j) * AP + nb * 16 + col] = f2bf(S.o[nb][j] * inv); }
    LDS_WAIT(); __builtin_amdgcn_wave_barrier(); asm volatile("" ::: "memory");
    bf16* mix = (bf16*)(C.ws + WS_MIX) + ((size_t)b * SEQ + i0) * DM + h * 64;
#pragma unroll
    for (int i = 0; i < 2; ++i) { const int r = i * 8 + (lane >> 3), ch = lane & 7; *(v4u*)(mix + (size_t)r * DM + ch * 8) = *(const LAS v4u*)(PL + r * AP + ch * 8); }
    LDS_WAIT(); __builtin_amdgcn_wave_barrier(); asm volatile("" ::: "memory");
}
constexpr int AB_K = 0, AB_V = 18432, AB_P = 36864, AB_CK = 55296, AB_RED = 55808;
__device__ __forceinline__ void attn_tile_lds(AttnState& S, const LAS bf16* KL, const LAS bf16* VT, const LAS float* CK, int diag, LAS bf16* PL, int lane) {
    const int col = lane & 15, quad = lane >> 4;
    f32x4 s[4];
#pragma unroll
    for (int nb = 0; nb < 4; ++nb) { const int key = nb * 16 + col;
        f32x4 a = (f32x4){0.f, 0.f, 0.f, 0.f};
#pragma unroll
        for (int ks = 0; ks < 2; ++ks) { const bf16x8 kb = *(const LAS bf16x8*)(KL + key * AP + ks * 32 + quad * 8); a = mfma16(S.qa[ks], kb, a); }
        const float ckv = CK[key];
#pragma unroll
        for (int j = 0; j < 4; ++j) { const int r = quad * 4 + j; a[j] = (key <= r + diag) ? (a[j] + (S.cq[j] - ckv)) : -INFINITY; }
        s[nb] = a; }
    float alpha[4];
#pragma unroll
    for (int j = 0; j < 4; ++j) { float mx = fmaxf(fmaxf(s[0][j], s[1][j]), fmaxf(s[2][j], s[3][j]));
        mx = fmaxf(mx, __shfl_xor(mx, 1)); mx = fmaxf(mx, __shfl_xor(mx, 2)); mx = fmaxf(mx, __shfl_xor(mx, 4)); mx = fmaxf(mx, __shfl_xor(mx, 8));
        const float mnew = fmaxf(S.m[j], mx), msafe = (mnew == -INFINITY) ? 0.f : mnew;
        alpha[j] = fast_exp2(S.m[j] - msafe); S.m[j] = mnew;
        float ps = 0.f;
#pragma unroll
        for (int nb = 0; nb < 4; ++nb) { const float p = fast_exp2(s[nb][j] - msafe); s[nb][j] = p; ps += p; }
        S.l[j] = S.l[j] * alpha[j] + ps; }
#pragma unroll
    for (int nb = 0; nb < 4; ++nb)
#pragma unroll
        for (int j = 0; j < 4; ++j) { PL[(quad * 4 + j) * AP + nb * 16 + col] = f2bf(s[nb][j]); S.o[nb][j] *= alpha[j]; }
    LDS_WAIT(); __builtin_amdgcn_wave_barrier(); asm volatile("" ::: "memory");
    bf16x8 pa[2];
#pragma unroll
    for (int ks = 0; ks < 2; ++ks) pa[ks] = *(const LAS bf16x8*)(PL + col * AP + ks * 32 + quad * 8);
#pragma unroll
    for (int nb = 0; nb < 4; ++nb)
#pragma unroll
        for (int ks = 0; ks < 2; ++ks) { const bf16x8 vb = *(const LAS bf16x8*)(VT + (nb * 16 + col) * AP + ks * 32 + quad * 8); S.o[nb] = mfma16(pa[ks], vb, S.o[nb]); }
    LDS_WAIT(); __builtin_amdgcn_wave_barrier(); asm volatile("" ::: "memory");
}
__device__ __forceinline__ void attn_prompt_unit(Ctx& C, int unit) {
    const int bh = unit >> 6, qb = 63 - (unit & 63), b = bh >> 3, h = bh & 7, lane = C.lane, w = C.wave, tid = C.tid, i0b = qb * 128, i0 = i0b + 16 * w;
    const bf16* Qb = (const bf16*)(C.ws + WS_QB); const bf16* Kb = (const bf16*)(C.ws + WS_KB) + (size_t)b * SEQ * 512 + h * 64; const bf16* Vb = (const bf16*)(C.ws + WS_VB) + (size_t)b * SEQ * 512 + h * 64;
    const float* cp = (const float*)(C.ws + WS_CP) + (size_t)bh * SEQ;
    LAS bf16* KL = (LAS bf16*)(C.lds + AB_K); LAS bf16* VT = (LAS bf16*)(C.lds + AB_V); LAS bf16* PL = (LAS bf16*)(C.lds + AB_P) + w * 16 * AP;
    LAS float* CK = (LAS float*)(C.lds + AB_CK); LAS float* RED = (LAS float*)(C.lds + AB_RED);
    AttnState S; attn_init(S, Qb + ((size_t)b * SEQ + i0) * 512 + h * 64, cp + i0, lane);
    { const float qm = attn_qmax(S); if (lane == 0) RED[w] = qm; }
    __syncthreads();
    float qmax = RED[0];
#pragma unroll
    for (int i = 1; i < NWAVES; ++i) qmax = fmaxf(qmax, RED[i]);
    const float* ktn = (const float*)(C.ws + WS_KTN) + bh * 128;
    const float kmax = wave_max(fmaxf(ktn[lane], ktn[lane + 64])), bound = 2.0f * qmax * kmax;
    const int jd0 = i0b >> 6, jlast = jd0 + 1; const float c0 = cp[i0b];
    int jstart = jd0;
    { const int t0 = lane, t1 = lane + 64;
      const bool n0 = (t0 < jd0) && (c0 - cp[t0 * 64 + 63] + bound >= -151.5f), n1 = (t1 < jd0) && (c0 - cp[(t1 < jd0 ? t1 : 0) * 64 + 63] + bound >= -151.5f);
      const unsigned long long m0 = __ballot(n0), m1 = __ballot(n1);
      if (m0) jstart = __builtin_ctzll(m0); else if (m1) jstart = 64 + __builtin_ctzll(m1); }
    const int skey = tid >> 3, sch = tid & 7;
    v4u kreg, vreg; float creg = 0.f;
#define AT_LOAD(t) do { kreg = *(const v4u*)(Kb + (size_t)((t) * 64 + skey) * 512 + sch * 8); vreg = *(const v4u*)(Vb + (size_t)((t) * 64 + lane) * 512 + w * 8); if (tid < 64) creg = cp[(t) * 64 + tid]; } while (0)
#define AT_STORE(bf) do { *(LAS v4u*)(KL + (bf) * 64 * AP + skey * AP + sch * 8) = kreg; LAS bf16* vt_ = VT + (bf) * 64 * AP + (w * 8) * AP + lane; \
        vt_[0 * AP] = (bf16)(vreg.x & 0xffffu); vt_[1 * AP] = (bf16)(vreg.x >> 16); vt_[2 * AP] = (bf16)(vreg.y & 0xffffu); vt_[3 * AP] = (bf16)(vreg.y >> 16); \
        vt_[4 * AP] = (bf16)(vreg.z & 0xffffu); vt_[5 * AP] = (bf16)(vreg.z >> 16); vt_[6 * AP] = (bf16)(vreg.w & 0xffffu); vt_[7 * AP] = (bf16)(vreg.w >> 16); \
        if (tid < 64) CK[(bf) * 64 + tid] = creg; } while (0)
    AT_LOAD(jstart); AT_STORE(0);
    __syncthreads();
    for (int t = jstart; t <= jlast; ++t) { const int bf = (t - jstart) & 1;
        if (t < jlast) AT_LOAD(t + 1);
        const int diag = i0 - 64 * t;
        if (diag >= 0) attn_tile_lds(S, KL + bf * 64 * AP, VT + bf * 64 * AP, CK + bf * 64, diag, PL, lane);
        if (t < jlast) AT_STORE(bf ^ 1);
        __syncthreads();
    }
#undef AT_LOAD
#undef AT_STORE
    const int col = lane & 15, quad = lane >> 4;
#pragma unroll
    for (int j = 0; j < 4; ++j) { float lt = S.l[j]; lt += __shfl_xor(lt, 1); lt += __shfl_xor(lt, 2); lt += __shfl_xor(lt, 4); lt += __shfl_xor(lt, 8); const float inv = 1.0f / lt;
#pragma unroll
        for (int nb = 0; nb < 4; ++nb) PL[(quad * 4 + j) * AP + nb * 16 + col] = f2bf(S.o[nb][j] * inv); }
    LDS_WAIT(); __builtin_amdgcn_wave_barrier(); asm volatile("" ::: "memory");
    bf16* mix = (bf16*)(C.ws + WS_MIX) + ((size_t)b * SEQ + i0) * DM + h * 64;
#pragma unroll
    for (int i = 0; i < 2; ++i) { const int r = i * 8 + (lane >> 3), ch = lane & 7; *(v4u*)(mix + (size_t)r * DM + ch * 8) = *(const LAS v4u*)(PL + r * AP + ch * 8); }
    LDS_WAIT(); __builtin_amdgcn_wave_barrier(); asm volatile("" ::: "memory");
}
__device__ __forceinline__ void attn_sample_unit(Ctx& C, int unit, int l) {
    const int b = unit >> 3, h = unit & 7, lane = C.lane, w = C.wave;
    const bf16* Qb = (const bf16*)(C.ws + WS_QB); const bf16* Kb = (const bf16*)(C.ws + WS_KB); const bf16* Vb = (const bf16*)(C.ws + WS_VB);
    const float* cs = (const float*)(C.ws + WS_CS) + (size_t)unit * SKV;
    LAS bf16* VT = (LAS bf16*)(C.lds + w * AT_SLOT + AT_VT); LAS bf16* PL = (LAS bf16*)(C.lds + w * AT_SLOT + AT_P);
    const size_t srow = ((size_t)MP + b * 16) * 512 + h * 64;
    AttnState S; attn_init(S, Qb + srow, cs + PAST, lane);
    const float* ck = C.in[2] + (((size_t)l * 32 + b) * 8 + h) * PAST * 64; const float* cv = C.in[3] + (((size_t)l * 32 + b) * 8 + h) * PAST * 64;
    for (int t = w; t < 32; t += NWAVES) attn_tile<true>(S, ck + (size_t)t * 64 * 64, cv + (size_t)t * 64 * 64, 64, 64, cs + t * 64, 64, VT, PL, lane);
    if (w == 0) attn_tile<false>(S, Kb + srow, Vb + srow, 512, 16, cs + PAST, 0, VT, PL, lane);
    const int col = lane & 15, quad = lane >> 4;
    LAS float* slot = (LAS float*)(C.lds + w * AT_SLOT);
#pragma unroll
    for (int j = 0; j < 4; ++j) { float lt = S.l[j]; lt += __shfl_xor(lt, 1); lt += __shfl_xor(lt, 2); lt += __shfl_xor(lt, 4); lt += __shfl_xor(lt, 8);
        if (col == 0) { slot[quad * 4 + j] = S.m[j]; slot[16 + quad * 4 + j] = lt; }
#pragma unroll
        for (int nb = 0; nb < 4; ++nb) slot[64 + (quad * 4 + j) * 64 + nb * 16 + col] = S.o[nb][j]; }
    __syncthreads();
    bf16* mix = (bf16*)(C.ws + WS_MIX) + ((size_t)MP + b * 16) * DM + h * 64;
    for (int e = C.tid; e < 16 * 64; e += NTHR) { const int r = e >> 6, d = e & 63;
        float M = -INFINITY;
#pragma unroll
        for (int w2 = 0; w2 < NWAVES; ++w2) M = fmaxf(M, ((const LAS float*)(C.lds + w2 * AT_SLOT))[r]);
        float num = 0.f, den = 0.f;
#pragma unroll
        for (int w2 = 0; w2 < NWAVES; ++w2) { const LAS float* sl = (const LAS float*)(C.lds + w2 * AT_SLOT); const float f = fast_exp2(sl[r] - M); num += f * sl[64 + r * 64 + d]; den += f * sl[16 + r]; }
        mix[(size_t)r * DM + d] = f2bf(num / den); }
    __syncthreads();
}

constexpr int LDSCTL_OFF = LDS_BYTES - 64, CW_BAR = 4096;
#define XB_TMO      128
#define XB_XCNT(j)  (256  + 64 * (j))
#define XB_XSUB(j)  (1280 + 64 * (j))
#define XB_XGEN(j)  (2304 + 64 * (j))
#define XB_TOP      3328
#define XB_TOPGEN   3392
#define XCD_BAR_WORDS 3456
#define XB_SPIN_CAP (1u << 18)

__device__ __forceinline__ unsigned xb_ld(unsigned* p)              { return __hip_atomic_load(p, __ATOMIC_RELAXED, __HIP_MEMORY_SCOPE_AGENT); }
__device__ __forceinline__ unsigned xb_add(unsigned* p, unsigned v) { return __hip_atomic_fetch_add(p, v, __ATOMIC_RELAXED, __HIP_MEMORY_SCOPE_AGENT); }
__device__ __forceinline__ unsigned xb_xcc_id() { return (unsigned)__builtin_amdgcn_s_getreg((3 << 11) | 20) & 0xFu; }
#define XB_SPIN(cond, bar) do { unsigned _sp = 0; while (cond) { __builtin_amdgcn_s_sleep(1); \
    if ((++_sp & 255u) == 0u) { if (xb_ld(&(bar)[XB_TMO])) break; if (_sp > XB_SPIN_CAP) { atomicAdd(&(bar)[XB_TMO], 1u); break; } } } } while (0)

struct XcdBarrier {
    unsigned* bar; unsigned x;
    volatile LAS unsigned* st;
};

__device__ __forceinline__ XcdBarrier xcd_barrier_post(unsigned* bar, volatile LAS unsigned* st) {
    XcdBarrier b; b.bar = bar; b.x = xb_xcc_id(); b.st = st;
    if (threadIdx.x == 0) (void)xb_add(&bar[XB_XCNT(b.x)], 1u);
    return b;
}
__device__ __forceinline__ void xcd_barrier_complete(unsigned* bar, unsigned x, unsigned& nloc, unsigned& nx) {
    const unsigned G = gridDim.x * gridDim.y * gridDim.z;
    unsigned sum, cnt, mine, sp = 0u;
    for (;;) {
        sum = 0u; cnt = 0u; mine = 0u;
#pragma unroll
        for (unsigned j = 0; j < 16; ++j) { const unsigned c = xb_ld(&bar[XB_XCNT(j)]); sum += c; cnt += (c > 0u) ? 1u : 0u; mine = (j == x) ? c : mine; }
        if (sum == G) break;
        __builtin_amdgcn_s_sleep(1);
        if ((++sp & 255u) == 0u) { if (xb_ld(&bar[XB_TMO])) break; if (sp > XB_SPIN_CAP) { atomicAdd(&bar[XB_TMO], 1u); break; } }
    }
    nloc = mine > 0u ? mine : 1u; nx = cnt > 0u ? cnt : 1u;
}

__device__ __forceinline__ void xcd_barrier(const XcdBarrier& b) {
    asm volatile("s_waitcnt vmcnt(0)" ::: "memory");
    __syncthreads();
    if (threadIdx.x == 0) {
        unsigned* bar = b.bar;
        __builtin_amdgcn_s_waitcnt(0);
        unsigned nloc = b.st[0], nx = b.st[1];
        if (nloc == 0u) { xcd_barrier_complete(bar, b.x, nloc, nx); b.st[0] = nloc; b.st[1] = nx; }
        const unsigned old = xb_add(&bar[XB_XSUB(b.x)], 1u);
        const unsigned gen = old / nloc;
        if (old + 1u == (gen + 1u) * nloc) {
            __builtin_amdgcn_fence(__ATOMIC_RELEASE, "agent");
            asm volatile("s_waitcnt vmcnt(0)" ::: "memory");
            const unsigned og = xb_add(&bar[XB_TOP], 1u);
            const unsigned tg = og / nx;
            if (og + 1u == (tg + 1u) * nx) xb_add(&bar[XB_TOPGEN], 1u);
            else XB_SPIN(xb_ld(&bar[XB_TOPGEN]) == tg, bar);
            __builtin_amdgcn_fence(__ATOMIC_ACQUIRE, "agent");
            xb_add(&bar[XB_XGEN(b.x)], 1u);
            asm volatile("s_waitcnt vmcnt(0)" ::: "memory");
        } else {
            XB_SPIN(xb_ld(&bar[XB_XGEN(b.x)]) == gen, bar);
            __builtin_amdgcn_fence(__ATOMIC_ACQUIRE, "agent");
            asm volatile("s_waitcnt vmcnt(0)" ::: "memory");
        }
    }
    __syncthreads();
}

template <int KIND, int L> __device__ __forceinline__ void gemm_up(Ctx& C) {
    pg8::Gemm g{(const bf16*)(C.ws + WS_HN), (const bf16*)(C.ws + WS_W1T) + (size_t)(L * 2 + KIND) * W1T_SZ, MT, 2 * DFF, DM}; pg8::StaticOrder S; S.init(MT, 2 * DFF, C.G, C.bid);
    pg8::EpiSwiglu E{(bf16*)(C.ws + WS_ACT)};
    pg8::gemm_phase<pg8::EpiSwiglu, pg8::StaticOrder, true, true>(C.lds, g, S, E);
}
template <int KIND, int L> __device__ __forceinline__ void gemm_res(Ctx& C, bool dummy = false) {
    pg8::Gemm g;
    if (KIND == 2) g = pg8::Gemm{(const bf16*)(C.ws + WS_MIX), (const bf16*)(C.ws + WS_WOT) + (size_t)L * WOT_SZ, MT, DM, DM};
    else g = pg8::Gemm{(const bf16*)(C.ws + WS_ACT), (const bf16*)(C.ws + WS_W2T) + (size_t)(L * 2 + KIND) * W2T_SZ, MT, DM, DFF};
    pg8::SplitOrder S; S.init(MP, DM, C.G, C.bid, (KIND == 2 ? DM : DFF) / 64);
    pg8::EpiRes E{(float*)(C.ws + (dummy ? WS_END : WS_X)), KIND == 2 ? 1.0f : 0.5f};
    pg8::gemm_phase<pg8::EpiRes, pg8::SplitOrder, true, true>(C.lds, g, S, E);
}
template <int L> __device__ __forceinline__ void gemm_inproj(Ctx& C) {
    pg8::Gemm g{(const bf16*)(C.ws + WS_HN), (const bf16*)(C.ws + WS_WINT) + (size_t)L * WINT_SZ, MT, NIN, DM}; pg8::StaticOrder S; S.init(MT, NIN, C.G, C.bid);
    pg8::EpiInProj E{(bf16*)(C.ws + WS_QB), (bf16*)(C.ws + WS_KB), (bf16*)(C.ws + WS_VB), (float*)(C.ws + WS_HALL), C.out, L};
    pg8::gemm_phase<pg8::EpiInProj, pg8::StaticOrder, true, true>(C.lds, g, S, E);
}
__device__ __forceinline__ void phase_prep(Ctx& C, int l) {
    for (int u = C.bid; u < 1024; u += C.G) hgrn_local_unit(C, u, l);
    for (int u = C.bid; u < 272; u += C.G) cumsum_unit(C, u, l);
    for (int t = CTX_GW(C); t < 2048; t += CTX_NGW(C)) ktn_task(C, t);
}
__device__ __forceinline__ void phase_attn(Ctx& C, int l, bool noscan = false) {
    for (int u = C.bid; u < 256; u += C.G) attn_sample_unit(C, u, l);
    if (!noscan) hgrn_scan(C, l);
    for (int u = C.bid; u < 1024; u += C.G) attn_prompt_unit(C, u);
}
__device__ __forceinline__ void phase_hout(Ctx& C, int l) {
    for (int u = C.bid; u < 1024; u += C.G) hgrn_out_unit<64>(C, u, l);
    for (int u = C.bid; u < 128; u += C.G) hgrn_out_unit<16>(C, u, l);
}
template <int L> __device__ __forceinline__ void layer_phases(Ctx& C, const XcdBarrier& bar, int lo, int hi) {
    constexpr int P = 1 + 12 * L;
#define IN(k) (lo <= (k) && (k) < hi)
#define SEAM(k) do { if (IN(k) && IN((k) + 1)) xcd_barrier(bar); } while (0)
#define DUPK(k) (L == 0 && ((DUP >> (k)) & 1))
    if (IN(P + 0)) { phase_rms<0>(C, C.in[6] + L * DM, L); if (DUPK(0)) { xcd_barrier(bar); phase_rms<0>(C, C.in[6] + L * DM, L); } }
    SEAM(P + 0);
    if (IN(P + 1)) { gemm_up<0, L>(C); if (DUPK(1)) { xcd_barrier(bar); gemm_up<0, L>(C); } }
    SEAM(P + 1);
    if (IN(P + 2)) { gemm_res<0, L>(C); if (DUPK(2)) { xcd_barrier(bar); gemm_res<0, L>(C, true); } }
    SEAM(P + 2);
    if (IN(P + 3)) { phase_rms<1>(C, C.in[9] + L * DM, L); if (DUPK(3)) { xcd_barrier(bar); phase_rms<1>(C, C.in[9] + L * DM, L); } }
    SEAM(P + 3);
    if (IN(P + 4)) { gemm_inproj<L>(C); if (DUPK(4)) { xcd_barrier(bar); gemm_inproj<L>(C); } }
    SEAM(P + 4);
    if (IN(P + 5)) { phase_prep(C, L); if (DUPK(5)) { xcd_barrier(bar); phase_prep(C, L); } }
    SEAM(P + 5);
    if (IN(P + 6)) { phase_attn(C, L); if (DUPK(6)) { xcd_barrier(bar); phase_attn(C, L, true); } if (DUPK(10)) { xcd_barrier(bar); hgrn_scan(C, L, true); } if (DUPK(11)) { xcd_barrier(bar); for (int u = C.bid; u < 256; u += C.G) attn_sample_unit(C, u, L); } }
    SEAM(P + 6);
    if (IN(P + 7)) { phase_hout(C, L); if (DUPK(7)) { xcd_barrier(bar); phase_hout(C, L); } }
    SEAM(P + 7);
    if (IN(P + 8)) { gemm_res<2, L>(C); if (DUPK(8)) { xcd_barrier(bar); gemm_res<2, L>(C, true); } }
    SEAM(P + 8);
    if (IN(P + 9)) { phase_rms<0>(C, C.in[15] + L * DM, L); if (DUPK(9)) { xcd_barrier(bar); phase_rms<0>(C, C.in[15] + L * DM, L); } }
    SEAM(P + 9);
    if (IN(P + 10)) gemm_up<1, L>(C);
    SEAM(P + 10);
    if (IN(P + 11)) gemm_res<1, L>(C);
    SEAM(P + 11);
#undef DUPK
#undef IN
#undef SEAM
}

__global__ void __launch_bounds__(NTHR, 2) fwd_megakernel(Params prm) {
    extern __shared__ __attribute__((aligned(16))) unsigned char lds_raw[];
    Ctx C;
    C.lds = (LAS unsigned char*)lds_raw; C.tid = threadIdx.x; C.lane = C.tid & 63; C.wave = __builtin_amdgcn_readfirstlane(C.tid >> 6); C.G = gridDim.x; C.bid = blockIdx.x;
#pragma unroll
    for (int i = 0; i < 19; ++i) C.in[i] = prm.in[i];
    C.out = prm.out; C.ws = prm.ws;
    cg::grid_group grid = cg::this_grid();
    volatile LAS unsigned* MISC = (volatile LAS unsigned*)(C.lds + LDSCTL_OFF);
    if (C.tid < 16) MISC[C.tid] = 0u;
    __syncthreads();
    XcdBarrier bar; bar.bar = (unsigned*)(C.ws + WS_CTL) + CW_BAR; bar.x = 0; bar.st = nullptr;
    if (ONE_LAUNCH) bar = xcd_barrier_post((unsigned*)(C.ws + WS_CTL) + CW_BAR, MISC + 8);
    const int lo = prm.ph_lo, hi = prm.ph_hi;
#define IN(k) (lo <= (k) && (k) < hi)
#define SEAM(k) do { if (IN(k) && IN((k) + 1)) grid.sync(); } while (0)
    if (IN(0)) { phase_prologue(C); if ((DUP >> 12) & 1) { grid.sync(); phase_prologue(C); } if ((DUP >> 13) & 1) { for (int i = 0; i < 16; ++i) xcd_barrier(bar); } } SEAM(0);
    layer_phases<0>(C, bar, lo, hi);
    layer_phases<1>(C, bar, lo, hi);
    if (IN(25)) phase_rms<2>(C, C.in[18], 0);
#undef IN
#undef SEAM
}

extern "C" void kernel_launch(void* const* d_in, const int* in_sizes, int n_in, void* d_out, int out_size, void* d_ws, size_t ws_size, hipStream_t stream) {
    static int grid = 0;
    if (grid == 0) {
        if (n_in != 19 || (size_t)out_size != O_END || ws_size < WS_END) { fprintf(stderr, "kernel_launch: unexpected problem (n_in %d out %d ws %zu)\n", n_in, out_size, ws_size); grid = -1; return; }
        int dev = 0, cus = 0, per_cu = 0;
        hipGetDevice(&dev); hipDeviceGetAttribute(&cus, hipDeviceAttributeMultiprocessorCount, dev);
        if (hipFuncSetAttribute((const void*)fwd_megakernel, hipFuncAttributeMaxDynamicSharedMemorySize, LDS_BYTES) != hipSuccess) { fprintf(stderr, "kernel_launch: hipFuncSetAttribute failed\n"); grid = -1; return; }
        if (hipOccupancyMaxActiveBlocksPerMultiprocessor(&per_cu, (const void*)fwd_megakernel, NTHR, LDS_BYTES) != hipSuccess || per_cu < 1) { fprintf(stderr, "kernel_launch: occupancy query says %d\n", per_cu); per_cu = 1; }
        (void)hipGetLastError();
        grid = cus * 1;
        if (grid <= 0) grid = 256;
    }
    if (grid < 0) return;
    Params p{};
    for (int i = 0; i < 19; ++i) p.in[i] = (const float*)d_in[i];
    p.out = (float*)d_out; p.ws = (unsigned char*)d_ws;
#if ONE_LAUNCH
    if (hipMemsetAsync((char*)d_ws + WS_CTL, 0, 65536, stream) != hipSuccess) { fprintf(stderr, "kernel_launch: memset of the barrier words failed\n"); return; }
    p.ph_lo = 0; p.ph_hi = 26;
    void* args[] = {&p};
    hipError_t e = hipLaunchCooperativeKernel((const void*)fwd_megakernel, dim3(grid), dim3(NTHR), args, LDS_BYTES, stream);
    if (e != hipSuccess) fprintf(stderr, "cooperative launch failed: %s (grid %d)\n", hipGetErrorString(e), grid);
#else
    for (int ph = 0; ph < 26; ++ph) { p.ph_lo = ph; p.ph_hi = ph + 1; hipLaunchKernelGGL(fwd_megakernel, dim3(grid), dim3(NTHR), LDS_BYTES, stream, p); }
#endif
}
```

```cpp
#include <hip/hip_runtime.h>
#include <hip/hip_cooperative_groups.h>
#include <cstdio>
#include <cstdint>
namespace cg = cooperative_groups;

#ifndef DUP
#define DUP 0
#endif
#ifndef ONE_LAUNCH
#define ONE_LAUNCH 1
#endif

constexpr int DM = 1024, SEQ = 8192, NB = 2, DEC_B = 32, DEC_T = 16, PAST = 2048;
constexpr int MP = NB * SEQ, MS = DEC_B * DEC_T, MT = MP + MS;
constexpr int DFF = 2816, NIN_RAW = 3592, NIN = 3584;
constexpr int SKV = PAST + DEC_T;
constexpr float RMS_EPS = 1e-6f;
constexpr float LOG2E = 1.4426950408889634f;
constexpr float QSCALE = 0.125f * LOG2E;
constexpr size_t O_YP = 0, O_YS = 16777216, O_KP = 17301504, O_VP = 34078720, O_LFP = 50855936, O_HSP = 51118080,
                 O_KS = 51380224, O_VS = 51904512, O_LFS = 52428800, O_HSS = 52436992, O_END = 56631296;
constexpr size_t MiB = 1u << 20;
constexpr size_t WS_CTL = 0, WS_WFG = 1 * MiB, WS_LB = 1 * MiB + 65536, WS_KTN = 1 * MiB + 131072, WS_G = 2 * MiB, WS_CP = 3 * MiB, WS_CS = 4 * MiB;
constexpr size_t WS_W1T = 8 * MiB, WS_W2T = 52 * MiB, WS_WINT = 74 * MiB, WS_WOT = 88 * MiB;
constexpr size_t WS_X = 92 * MiB, WS_HN = 158 * MiB, WS_ACT = 192 * MiB, WS_QB = 284 * MiB, WS_KB = 301 * MiB, WS_VB = 318 * MiB;
constexpr size_t WS_HALL = 336 * MiB, WS_MIX = 468 * MiB, WS_US = 502 * MiB, WS_END = 566 * MiB, WS_PART = 760 * MiB;
constexpr size_t W1T_SZ = (size_t)2 * DFF * DM, W2T_SZ = (size_t)DM * DFF, WINT_SZ = (size_t)NIN * DM, WOT_SZ = (size_t)DM * DM;

#define LAS __attribute__((address_space(3)))
typedef unsigned short bf16;
typedef short bf16x8 __attribute__((ext_vector_type(8)));
typedef float f32x4 __attribute__((ext_vector_type(4)));
typedef float f32x2 __attribute__((ext_vector_type(2)));
typedef unsigned v4u __attribute__((ext_vector_type(4)));
typedef unsigned v2u __attribute__((ext_vector_type(2)));
typedef __bf16 bf16x2_t __attribute__((ext_vector_type(2)));
__device__ __forceinline__ unsigned pk2(float lo, float hi) { f32x2 v = {lo, hi}; bf16x2_t b = __builtin_convertvector(v, bf16x2_t); return __builtin_bit_cast(unsigned, b); }
__device__ __forceinline__ bf16 f2bf(float f) { return (bf16)(pk2(f, 0.f) & 0xffffu); }
__device__ __forceinline__ float bf2f(bf16 h) { return __builtin_bit_cast(float, (unsigned)h << 16); }
__device__ __forceinline__ float fast_exp2(float x) { return __builtin_amdgcn_exp2f(x); }
__device__ __forceinline__ float sigmoidf_(float x) { return 1.0f / (1.0f + __expf(-x)); }
__device__ __forceinline__ float siluf_(float x) { return x / (1.0f + __expf(-x)); }
__device__ __forceinline__ float log_sigmoidf_(float x) { return fminf(x, 0.f) - log1pf(expf(-fabsf(x))); }
#define LDS_WAIT() asm volatile("s_waitcnt lgkmcnt(0)" ::: "memory")

namespace pg8 {
#define PG8_LAS __attribute__((address_space(3)))
typedef unsigned short bf16_t;
typedef short bf16x8 __attribute__((ext_vector_type(8)));
typedef float f32x4 __attribute__((ext_vector_type(4)));
typedef unsigned u32x4 __attribute__((ext_vector_type(4)));
constexpr int BM = 256, BK = 64, HALF = 128, HTB = HALF * BK * 2  , STAGE_BYTES = 8 * HTB, NXCD = 8, WGM = 8;

__host__ __device__ __forceinline__ int lds_byte(int r, int c) { const int st = (r >> 4) * 2 + (c >> 5), rr = r & 15, cc = c & 31, ob = rr * 64 + cc * 2; return st * 1024 + (ob ^ (((ob >> 9) & 1) << 5)); }
__host__ __device__ __forceinline__ void stage_rc(int b, int& R, int& C) { const int st = b / 1024, sb = b % 1024, swz = sb ^ (((sb >> 9) & 1) << 5); R = (st >> 1) * 16 + swz / 64; C = (st & 1) * 32 + (swz % 64) / 2; }
__host__ __device__ __forceinline__ int perm32(int rho) { const int n = rho >> 4, i = rho & 15; return 8 * (i >> 2) + 4 * n + (i & 3); }

struct Unit { int pm, pn, k0, nt; };
struct Gemm { const bf16_t* A; const bf16_t* Bt; int M, N, K; };

struct StaticOrder {
    int nM, nN, nwg, G, c;
    __host__ __device__ __forceinline__ void init(int M, int N, int G_, int c_) { nM = M / BM; nN = N / BM; nwg = nM * nN; G = G_; c = c_; }
    __host__ __device__ __forceinline__ bool next(int i, Unit& u) const {
        u.pm = 0; u.pn = 0; u.k0 = 0; u.nt = 0;
        const long L = (long)i * G + c; if (L >= nwg) return false;
        int wgid = (int)L; { const int q = nwg / NXCD, r = nwg % NXCD, xcd = wgid % NXCD, off = wgid / NXCD; wgid = (xcd < r ? xcd * (q + 1) : r * (q + 1) + (xcd - r) * q) + off; }
        const int nig = WGM * nN, gid = wgid / nig, fm = gid * WGM, gsz = (nM - fm) < WGM ? (nM - fm) : WGM;
        u.pm = fm + ((wgid % nig) % gsz); u.pn = (wgid % nig) / gsz; u.k0 = 0; u.nt = 0; return true;
    }
    __device__ __forceinline__ void a_ready(const Unit&) const {}
    __device__ __forceinline__ void done(const Unit&) const {}
};

struct SplitOrder {
    StaticOrder base; int R, G, c, ntf;
    __host__ __device__ __forceinline__ void init(int Mprompt, int N, int G_, int c_, int ntf_) { base.init(Mprompt, N, G_, c_); G = G_; c = c_; ntf = ntf_; R = (base.nwg + G - 1) / G; }
    __host__ __device__ __forceinline__ bool next(int i, Unit& u) const {
        if (i < R) { if (base.next(i, u)) return true; }
        const int idle = R * G - base.nwg;
        const int j = (i < R) ? (c - (G - idle)) : ((i - R) * G + c + idle);
        if (i < R - 1 || j < 0 || j >= 32) return false;
        const int us = j >> 2, p = j & 3, bs = (ntf / 4) & ~1, rem2 = (ntf - 4 * bs) / 2;
        u.pm = base.nM + (us >> 2); u.pn = us & 3; u.nt = (bs + (p < rem2 ? 2 : 0)) | (p << 16); u.k0 = p * bs + 2 * (p < rem2 ? p : rem2); return true;
    }
    __device__ __forceinline__ void a_ready(const Unit&) const {}
    __device__ __forceinline__ void done(const Unit&) const {}
};

struct EpiSwiglu {
    static constexpr bool PERM = true, AFTER_DRAIN = false;
    bf16_t* O;
    __device__ __forceinline__ void operator()(const f32x4 (&acc)[2][2][4][2], const Unit& u, int wr, int wc, int fr, int fq) const {
        const int row0 = u.pm * BM + wr * 64 + fr, col0 = u.pn * 128 + wc * 32 + 8 * fq;
#pragma unroll
        for (int ai = 0; ai < 2; ++ai)
#pragma unroll
            for (int m = 0; m < 4; ++m) {
                const f32x4 a0 = acc[ai][0][m][0], a1 = acc[ai][0][m][1], b0 = acc[ai][1][m][0], b1 = acc[ai][1][m][1];
                u32x4 w;
                w.x = ::pk2(::siluf_(a0[0]) * b0[0], ::siluf_(a0[1]) * b0[1]); w.y = ::pk2(::siluf_(a0[2]) * b0[2], ::siluf_(a0[3]) * b0[3]);
                w.z = ::pk2(::siluf_(a1[0]) * b1[0], ::siluf_(a1[1]) * b1[1]); w.w = ::pk2(::siluf_(a1[2]) * b1[2], ::siluf_(a1[3]) * b1[3]);
                *(u32x4*)(O + (size_t)(row0 + ai * HALF + m * 16) * ::DFF + col0) = w;
            }
    }
};
struct EpiRes {
    static constexpr bool PERM = false, AFTER_DRAIN = false;
    float* X; float* PART; float scale;
    __device__ __forceinline__ void operator()(const f32x4 (&acc)[2][2][4][2], const Unit& u, int wr, int wc, int fr, int fq) const {
        const int row0 = u.pm * BM + wr * 64 + fr, col0 = u.pn * BM + wc * 32 + 4 * fq;
        float* base = u.nt ? PART + (ptrdiff_t)((u.nt >> 16) * ::MS - ::MP) * ::DM : X;
#pragma unroll
        for (int ai = 0; ai < 2; ++ai)
#pragma unroll
            for (int m = 0; m < 4; ++m) { float* rowp = base + (size_t)(row0 + ai * HALF + m * 16) * ::DM + col0;
#pragma unroll
                for (int bj = 0; bj < 2; ++bj)
#pragma unroll
                    for (int n = 0; n < 2; ++n) { f32x4* p = (f32x4*)(rowp + bj * HALF + n * 16);
                        if (u.nt) *p = acc[ai][bj][m][n]; else *p = *p + acc[ai][bj][m][n] * scale; } }
    }
};
struct EpiInProj {
    static constexpr bool PERM = true, AFTER_DRAIN = false;
    bf16_t *Q, *K, *V; float* H; float* out; int l;
    __device__ __forceinline__ void operator()(const f32x4 (&acc)[2][2][4][2], const Unit& u, int wr, int wc, int fr, int fq) const {
        const int seg = u.pn >> 1, cbase = (u.pn & 1) * 256 + wc * 32 + 8 * fq, row0 = u.pm * BM + wr * 64 + fr;
#pragma unroll
        for (int ai = 0; ai < 2; ++ai)
#pragma unroll
            for (int m = 0; m < 4; ++m) { const int row = row0 + ai * HALF + m * 16;
#pragma unroll
                for (int bj = 0; bj < 2; ++bj) { const int cs = cbase + bj * HALF; f32x4 v0 = acc[ai][bj][m][0], v1 = acc[ai][bj][m][1];
                    if (seg == 0) { v0 = v0 * ::QSCALE; v1 = v1 * ::QSCALE; u32x4 w; w.x = ::pk2(v0[0], v0[1]); w.y = ::pk2(v0[2], v0[3]); w.z = ::pk2(v1[0], v1[1]); w.w = ::pk2(v1[2], v1[3]);
                        *(u32x4*)(Q + (size_t)row * 512 + cs) = w; }
                    else if (seg <= 2) { u32x4 w; w.x = ::pk2(v0[0], v0[1]); w.y = ::pk2(v0[2], v0[3]); w.z = ::pk2(v1[0], v1[1]); w.w = ::pk2(v1[2], v1[3]);
                        *(u32x4*)((seg == 1 ? K : V) + (size_t)row * 512 + cs) = w;
                        const int head = cs >> 6, d = cs & 63; size_t o;
                        if (row < ::MP) { const int b = row >> 13, t = row & 8191; o = (seg == 1 ? ::O_KP : ::O_VP) + ((((size_t)l * 2 + b) * 8 + head) * 8192 + t) * 64 + d; }
                        else { const int rs = row - ::MP, b = rs >> 4, t = rs & 15; o = (seg == 1 ? ::O_KS : ::O_VS) + ((((size_t)l * 32 + b) * 8 + head) * 16 + t) * 64 + d; }
                        *(f32x4*)(out + o) = v0; *(f32x4*)(out + o + 4) = v1; }
                    else { float* hp = H + (size_t)row * 2048 + (seg - 3) * 512 + cs;
                        if (seg == 3) { v0 = (f32x4){::siluf_(v0[0]), ::siluf_(v0[1]), ::siluf_(v0[2]), ::siluf_(v0[3])}; v1 = (f32x4){::siluf_(v1[0]), ::siluf_(v1[1]), ::siluf_(v1[2]), ::siluf_(v1[3])}; }
                        *(f32x4*)hp = v0; *(f32x4*)(hp + 4) = v1; }
                } }
    }
};
template <class Epi, class Sched, bool ALIGN_EPI = false, bool SP2 = false>
__device__ __forceinline__ void gemm_phase(PG8_LAS unsigned char* lds, const Gemm g, const Sched& S, const Epi& E) {
    const int tid = threadIdx.x, wid = __builtin_amdgcn_readfirstlane(tid >> 6), lane = tid & 63, wr = wid >> 2, wc = wid & 3, fr = lane & 15, fq = lane >> 4;
    const int K = g.K, ntf = K / BK;
    unsigned voffA[2], voffB[2];
#pragma unroll
    for (int i = 0; i < 2; ++i) { int R, C; stage_rc(tid * 16 + i * 8192, R, C); const int Rb = Epi::PERM ? ((R & ~31) + perm32(R & 31)) : R;
        voffA[i] = (unsigned)(R * K + C) * 2u; voffB[i] = (unsigned)(Rb * K + C) * 2u; }
    const size_t kstep = (size_t)(BK * 2);
    const size_t hstep = (size_t)HALF * K * 2;
    const size_t tstep = 2 * hstep;
    const unsigned ldsw = (unsigned)wid * 1024u;
    const int aoff = lds_byte(wr * 64 + fr, fq * 8), boff = lds_byte(wc * 32 + fr, fq * 8);
#define PG8_SA(b, h) (((b) * 2 + (h)) * HTB)
#define PG8_SB(b, h) ((4 + (b) * 2 + (h)) * HTB)
#define PG8_STAGE(bufoff, gbase, voff) do { _Pragma("unroll") for (int _i = 0; _i < 2; ++_i) \
        __builtin_amdgcn_global_load_lds((const unsigned*)((const char*)(gbase) + (voff)[_i]), (PG8_LAS unsigned*)(lds + (bufoff) + ldsw + _i * 8192), 16, 0, 0); } while (0)
#define PG8_LDA(dst, b, h) do { _Pragma("unroll") for (int m = 0; m < 4; ++m) _Pragma("unroll") for (int k = 0; k < 2; ++k) dst[m][k] = *(const PG8_LAS bf16x8*)(lds + PG8_SA(b, h) + aoff + m * 2048 + k * 1024); } while (0)
#define PG8_LDB(dst, b, h) do { _Pragma("unroll") for (int n = 0; n < 2; ++n) _Pragma("unroll") for (int k = 0; k < 2; ++k) dst[n][k] = *(const PG8_LAS bf16x8*)(lds + PG8_SB(b, h) + boff + n * 2048 + k * 1024); } while (0)
#define PG8_MMA(ai, bj, At, Bt) do { __builtin_amdgcn_s_setprio(1); _Pragma("unroll") for (int m = 0; m < 4; ++m) _Pragma("unroll") for (int n = 0; n < 2; ++n) _Pragma("unroll") for (int k = 0; k < 2; ++k) \
        acc[ai][bj][m][n] = __builtin_amdgcn_mfma_f32_16x16x32_bf16(Bt[n][k], At[m][k], acc[ai][bj][m][n], 0, 0, 0); __builtin_amdgcn_s_setprio(0); } while (0)
#define PG8_WAIT_V(n) asm volatile("s_waitcnt vmcnt(" #n ")" ::: "memory")
#define PG8_WAIT_L(n) asm volatile("s_waitcnt lgkmcnt(" #n ")" ::: "memory")
#define PG8_BAR __builtin_amdgcn_s_barrier()
#define PG8_SCHED __builtin_amdgcn_sched_barrier(0)
    Unit cur{0, 0, 0, 0}, nxt{0, 0, 0, 0}; int ui = 0;
    if (!S.next(0, cur)) return;
    f32x4 acc[2][2][4][2];
#pragma unroll
    for (int a = 0; a < 2; ++a)
#pragma unroll
        for (int b = 0; b < 2; ++b)
#pragma unroll
            for (int m = 0; m < 4; ++m)
#pragma unroll
                for (int n = 0; n < 2; ++n) acc[a][b][m][n] = (f32x4){0.f, 0.f, 0.f, 0.f};
    bf16x8 At[4][2], B0[2][2], B1[2][2];
    const char* cA = (const char*)g.A + (size_t)cur.pm * tstep + (size_t)cur.k0 * kstep; const char* cB = (const char*)g.Bt + (size_t)cur.pn * tstep + (size_t)cur.k0 * kstep; int nt = cur.nt ? (cur.nt & 0xffff) : ntf;
    S.a_ready(cur);
    if constexpr (SP2) {
        PG8_STAGE(PG8_SB(0, 0), cB, voffB); PG8_STAGE(PG8_SB(0, 1), cB + hstep, voffB); PG8_STAGE(PG8_SA(0, 0), cA, voffA); PG8_STAGE(PG8_SA(0, 1), cA + hstep, voffA);
        if (wr == 1) PG8_BAR;
        PG8_WAIT_V(2); PG8_BAR;
        PG8_STAGE(PG8_SB(1, 0), cB + kstep, voffB); PG8_STAGE(PG8_SA(1, 0), cA + kstep, voffA); PG8_STAGE(PG8_SB(1, 1), cB + hstep + kstep, voffB);
        PG8_WAIT_V(6); PG8_BAR;
    } else {
        PG8_STAGE(PG8_SB(0, 0), cB, voffB); PG8_STAGE(PG8_SA(0, 0), cA, voffA); PG8_STAGE(PG8_SB(0, 1), cB + hstep, voffB); PG8_STAGE(PG8_SA(0, 1), cA + hstep, voffA);
        if (wr == 1) PG8_BAR;
        PG8_WAIT_V(4); PG8_BAR;
        PG8_STAGE(PG8_SB(1, 0), cB + kstep, voffB); PG8_STAGE(PG8_SA(1, 0), cA + kstep, voffA); PG8_STAGE(PG8_SB(1, 1), cB + hstep + kstep, voffB);
        PG8_WAIT_V(6); PG8_BAR;
    }
    for (;;) {
        const bool has_next = S.next(ui + 1, nxt);
        const char* nA = has_next ? (const char*)g.A + (size_t)nxt.pm * tstep + (size_t)nxt.k0 * kstep : cA; const char* nB = has_next ? (const char*)g.Bt + (size_t)nxt.pn * tstep + (size_t)nxt.k0 * kstep : cB;
        for (int t = 0; t < nt; t += 2) {
            const bool last = (t == nt - 2);
            const char* a1 = cA + (size_t)(t + 1) * kstep;
            const char* a2 = last ? nA : cA + (size_t)(t + 2) * kstep; const char* b2 = last ? nB : cB + (size_t)(t + 2) * kstep;
            const char* a3 = a2 + kstep; const char* b3 = b2 + kstep;
            if (last && has_next) S.a_ready(nxt);
            if constexpr (SP2) {
            PG8_LDB(B0, 0, 0); PG8_LDB(B1, 0, 1); PG8_SCHED; PG8_LDA(At, 0, 0); PG8_STAGE(PG8_SA(1, 1), a1 + hstep, voffA);
            PG8_WAIT_V(8); PG8_WAIT_L(0); PG8_BAR; PG8_MMA(0, 0, At, B0); PG8_MMA(0, 1, At, B1); PG8_BAR; PG8_SCHED;
            PG8_LDA(At, 0, 1); PG8_STAGE(PG8_SB(0, 0), b2, voffB); PG8_STAGE(PG8_SB(0, 1), b2 + hstep, voffB); PG8_STAGE(PG8_SA(0, 0), a2, voffA);
            PG8_WAIT_V(8); PG8_WAIT_L(0); PG8_BAR; PG8_MMA(1, 0, At, B0); PG8_MMA(1, 1, At, B1); PG8_BAR; PG8_SCHED;
            PG8_LDB(B0, 1, 0); PG8_LDB(B1, 1, 1); PG8_SCHED; PG8_LDA(At, 1, 0); PG8_STAGE(PG8_SA(0, 1), a2 + hstep, voffA);
            PG8_WAIT_V(8); PG8_WAIT_L(0); PG8_BAR; PG8_MMA(0, 0, At, B0); PG8_MMA(0, 1, At, B1); PG8_BAR; PG8_SCHED;
            PG8_LDA(At, 1, 1); PG8_STAGE(PG8_SB(1, 0), b3, voffB); PG8_STAGE(PG8_SB(1, 1), b3 + hstep, voffB); PG8_STAGE(PG8_SA(1, 0), a3, voffA);
            PG8_WAIT_V(8); PG8_WAIT_L(0); PG8_BAR; PG8_MMA(1, 0, At, B0); PG8_MMA(1, 1, At, B1); PG8_BAR; PG8_SCHED;
            } else {
            PG8_LDB(B0, 0, 0); PG8_SCHED; PG8_LDA(At, 0, 0); PG8_STAGE(PG8_SA(1, 1), a1 + hstep, voffA);
            PG8_WAIT_L(8); PG8_BAR; PG8_WAIT_L(0); PG8_MMA(0, 0, At, B0); PG8_BAR; PG8_SCHED;
            PG8_LDB(B1, 0, 1); PG8_STAGE(PG8_SB(0, 0), b2, voffB);
            PG8_BAR; PG8_WAIT_L(0); PG8_MMA(0, 1, At, B1); PG8_BAR;
            PG8_LDA(At, 0, 1); PG8_STAGE(PG8_SA(0, 0), a2, voffA);
            PG8_BAR; PG8_WAIT_L(0); PG8_MMA(1, 0, At, B0); PG8_BAR; PG8_SCHED;
            PG8_STAGE(PG8_SB(0, 1), b2 + hstep, voffB);
            PG8_WAIT_V(6); PG8_BAR; PG8_MMA(1, 1, At, B1); PG8_BAR;
            PG8_LDB(B0, 1, 0); PG8_SCHED; PG8_LDA(At, 1, 0); PG8_STAGE(PG8_SA(0, 1), a2 + hstep, voffA);
            PG8_WAIT_L(8); PG8_BAR; PG8_WAIT_L(0); PG8_MMA(0, 0, At, B0); PG8_BAR; PG8_SCHED;
            PG8_LDB(B1, 1, 1); PG8_STAGE(PG8_SB(1, 0), b3, voffB);
            PG8_BAR; PG8_WAIT_L(0); PG8_MMA(0, 1, At, B1); PG8_BAR;
            PG8_LDA(At, 1, 1); PG8_STAGE(PG8_SA(1, 0), a3, voffA);
            PG8_BAR; PG8_WAIT_L(0); PG8_MMA(1, 0, At, B0); PG8_BAR; PG8_SCHED;
            PG8_STAGE(PG8_SB(1, 1), b3 + hstep, voffB);
            PG8_WAIT_V(6); PG8_BAR; PG8_MMA(1, 1, At, B1); PG8_BAR;
            }
        }
        if constexpr (ALIGN_EPI) { if (wr == 0) PG8_BAR; }
        if constexpr (!Epi::AFTER_DRAIN) { E(acc, cur, wr, wc, fr, fq); S.done(cur); }
        if (!has_next) break;
#pragma unroll
        for (int a = 0; a < 2; ++a)
#pragma unroll
            for (int b = 0; b < 2; ++b)
#pragma unroll
                for (int m = 0; m < 4; ++m)
#pragma unroll
                    for (int n = 0; n < 2; ++n) acc[a][b][m][n] = (f32x4){0.f, 0.f, 0.f, 0.f};
        cur = nxt; cA = nA; cB = nB; ++ui; nt = cur.nt ? (cur.nt & 0xffff) : ntf;
        if constexpr (ALIGN_EPI) { if (wr == 1) PG8_BAR; }
    }
    PG8_WAIT_V(0);
    if constexpr (!ALIGN_EPI) { if (wr == 0) PG8_BAR; }
    PG8_BAR;
    if constexpr (Epi::AFTER_DRAIN) { E.fused(acc, cur, wr, wc, fr, fq, lds, wid, lane); S.done(cur); }
#undef PG8_SA
#undef PG8_SB
#undef PG8_STAGE
#undef PG8_LDA
#undef PG8_LDB
#undef PG8_MMA
#undef PG8_WAIT_V
#undef PG8_WAIT_L
#undef PG8_BAR
#undef PG8_SCHED
}
}

constexpr int NWAVES = 8, NTHR = 512;
constexpr int RING_BYTES = 131072, LDS_BYTES = 147456;
struct Params { const float* in[19]; float* out; unsigned char* ws; int ph_lo, ph_hi; };

struct Ctx {
    LAS unsigned char* lds;
    int tid, lane, wave, G, bid;
    const float* in[19]; float* out; unsigned char* ws;
};
#define CTX_GW(C) ((C).bid * NWAVES + (C).wave)
#define CTX_NGW(C) ((C).G * NWAVES)

__device__ __forceinline__ float wave_sum(float v) {
#pragma unroll
    for (int o = 1; o < 64; o <<= 1) v += __shfl_xor(v, o);
    return v;
}
__device__ __forceinline__ float wave_max(float v) {
#pragma unroll
    for (int o = 1; o < 64; o <<= 1) v = fmaxf(v, __shfl_xor(v, o));
    return v;
}
__device__ __forceinline__ f32x4 mfma16(bf16x8 a, bf16x8 b, f32x4 c) { return __builtin_amdgcn_mfma_f32_16x16x32_bf16(a, b, c, 0, 0, 0); }

__device__ __forceinline__ void transpose_item(const float* W, int K, int N, int srccol0, bf16* WT, int dstrow0, int k0, LAS float* scr, int lane) {
#pragma unroll 8
    for (int i = 0; i < 32; ++i) { const int kk = 2 * i + (lane >> 5); scr[kk * 33 + (lane & 31)] = W[(size_t)(k0 + kk) * N + srccol0 + (lane & 31)]; }
    LDS_WAIT();
    const int c = lane & 7;
#pragma unroll
    for (int j = 0; j < 4; ++j) { const int n = (lane >> 3) + 8 * j; const LAS float* s = scr + (8 * c) * 33 + n;
        v4u o; o.x = pk2(s[0 * 33], s[1 * 33]); o.y = pk2(s[2 * 33], s[3 * 33]); o.z = pk2(s[4 * 33], s[5 * 33]); o.w = pk2(s[6 * 33], s[7 * 33]);
        *(v4u*)(WT + (size_t)(dstrow0 + n) * K + k0 + 8 * c) = o; }
    LDS_WAIT();
}
__device__ __forceinline__ void phase_prologue(Ctx& C) {
    LAS float* scr = (LAS float*)(C.lds + C.wave * 16384);
    const int gw = CTX_GW(C), NGW = CTX_NGW(C);
    constexpr int I_UP = 16 * 176, I_DN = 44 * 32, I_IN = 16 * 112, I_OUT = 16 * 32, I_LAYER = 2 * I_UP + 2 * I_DN + I_IN + I_OUT;
    for (int it = gw; it < 2 * I_LAYER; it += NGW) {
        const int l = it / I_LAYER; int r = it % I_LAYER;
        int which;
        if (r < I_UP) which = 0; else if ((r -= I_UP) < I_DN) which = 1; else if ((r -= I_DN) < I_IN) which = 2; else if ((r -= I_IN) < I_OUT) which = 3; else if ((r -= I_OUT) < I_UP) which = 4; else { r -= I_UP; which = 5; }
        if (which == 0 || which == 4) {
            const int nb = r % 176, kb = r / 176, d0 = nb * 32, pn = d0 >> 8, w = d0 & 255;
            const int src = (w < 128) ? (128 * pn + w) : (DFF + 128 * pn + (w - 128));
            const float* W = C.in[which == 0 ? 7 : 16] + (size_t)l * DM * 2 * DFF;
            bf16* WT = (bf16*)(C.ws + WS_W1T) + (size_t)(l * 2 + (which == 4)) * W1T_SZ;
            transpose_item(W, DM, 2 * DFF, src, WT, d0, kb * 64, scr, C.lane);
        } else if (which == 1 || which == 5) {
            const int nb = r % 32, kb = r / 32;
            const float* W = C.in[which == 1 ? 8 : 17] + (size_t)l * DFF * DM;
            bf16* WT = (bf16*)(C.ws + WS_W2T) + (size_t)(l * 2 + (which == 5)) * W2T_SZ;
            transpose_item(W, DFF, DM, nb * 32, WT, nb * 32, kb * 64, scr, C.lane);
        } else if (which == 2) {
            const int nb = r % 112, kb = r / 112, d0 = nb * 32, src = d0 < 1536 ? d0 : d0 + 8;
            transpose_item(C.in[10] + (size_t)l * DM * NIN_RAW, DM, NIN_RAW, src, (bf16*)(C.ws + WS_WINT) + (size_t)l * WINT_SZ, d0, kb * 64, scr, C.lane);
        } else {
            const int nb = r % 32, kb = r / 32;
            transpose_item(C.in[14] + (size_t)l * DM * DM, DM, DM, nb * 32, (bf16*)(C.ws + WS_WOT) + (size_t)l * WOT_SZ, nb * 32, kb * 64, scr, C.lane);
        }
    }
    const int gt = C.bid * NTHR + C.tid, NGT = C.G * NTHR;
    float* WFG = (float*)(C.ws + WS_WFG);
    for (int i = gt; i < 2 * 8 * DM; i += NGT) { const int l = i >> 13, j = (i >> 10) & 7, k = i & 1023; WFG[i] = C.in[10][((size_t)l * DM + k) * NIN_RAW + 1536 + j]; }
    float* LB = (float*)(C.ws + WS_LB);
    for (int i = gt; i < 512; i += NGT) { const float p0 = C.in[12][i], p1 = C.in[12][512 + i], mx = fmaxf(p0, p1), e0 = expf(p0 - mx), e1 = expf(p1 - mx);
        LB[i] = 0.f; LB[512 + i] = e1 / (e0 + e1); }
    f32x4* X4 = (f32x4*)(C.ws + WS_X); const f32x4* xp = (const f32x4*)C.in[0]; const f32x4* xs = (const f32x4*)C.in[1];
    for (int i = gt; i < MP * DM / 4; i += NGT) X4[i] = xp[i];
    for (int i = gt; i < MS * DM / 4; i += NGT) X4[MP * DM / 4 + i] = xs[i];
}

template <int MODE> __device__ __forceinline__ void phase_rms(Ctx& C, const float* g, int l, float pend) {
    const int gw = CTX_GW(C), NGW = CTX_NGW(C), lane = C.lane;
    float* X = (float*)(C.ws + WS_X); bf16* HN = (bf16*)(C.ws + WS_HN); const float* PART = (const float*)(C.ws + WS_PART);
    f32x4 gv[4];
#pragma unroll
    for (int j = 0; j < 4; ++j) gv[j] = ((const f32x4*)g)[lane + 64 * j];
    for (int row = gw; row < MT; row += NGW) {
        const f32x4* xr = (const f32x4*)(X + (size_t)row * DM) + lane;
        f32x4 v[4]; float s = 0.f;
#pragma unroll
        for (int j = 0; j < 4; ++j) v[j] = xr[64 * j];
        if (pend != 0.f && row >= MP) {
#pragma unroll
            for (int j = 0; j < 4; ++j) { const f32x4* pp = (const f32x4*)(PART + (size_t)(row - MP) * DM) + lane + 64 * j;
                v[j] = v[j] + ((pp[0] + pp[MS * DM / 4]) + (pp[2 * MS * DM / 4] + pp[3 * MS * DM / 4])) * pend;
                ((f32x4*)(X + (size_t)row * DM))[lane + 64 * j] = v[j]; } }
#pragma unroll
        for (int j = 0; j < 4; ++j) s += (v[j].x * v[j].x + v[j].y * v[j].y) + (v[j].z * v[j].z + v[j].w * v[j].w);
        const float rstd = 1.0f / sqrtf(wave_sum(s) * (1.0f / DM) + RMS_EPS);
#pragma unroll
        for (int j = 0; j < 4; ++j) v[j] = v[j] * rstd * gv[j];
        if (MODE == 2) {
            float* o = C.out + (row < MP ? O_YP + (size_t)row * DM : O_YS + (size_t)(row - MP) * DM);
#pragma unroll
            for (int j = 0; j < 4; ++j) ((f32x4*)o)[lane + 64 * j] = v[j];
        } else {
            v2u* o8 = (v2u*)(HN + (size_t)row * DM) + lane;
#pragma unroll
            for (int j = 0; j < 4; ++j) { v2u w; w.x = pk2(v[j].x, v[j].y); w.y = pk2(v[j].z, v[j].w); o8[64 * j] = w; }
        }
        if (MODE == 1) {
            const float* WFG = (const float*)(C.ws + WS_WFG) + (size_t)l * 8 * DM;
            float fg[8];
#pragma unroll
            for (int jj = 0; jj < 8; ++jj) { float a = 0.f;
#pragma unroll
                for (int j = 0; j < 4; ++j) { const f32x4 w = ((const f32x4*)(WFG + jj * DM))[lane + 64 * j]; a += (v[j].x * w.x + v[j].y * w.y) + (v[j].z * w.z + v[j].w * w.w); }
                fg[jj] = wave_sum(a); }
            float mine = fg[0];
#pragma unroll
            for (int jj = 1; jj < 8; ++jj) mine = (lane == jj) ? fg[jj] : mine;
            if (lane < 8) { const float lf = log_sigmoidf_(mine + C.in[11][l * 8 + lane]);
                size_t o;
                if (row < MP) { const int b = row >> 13, t = row & 8191; o = O_LFP + (((size_t)l * 2 + b) * 8 + lane) * 8192 + t; }
                else { const int rs = row - MP, b = rs >> 4, t = rs & 15; o = O_LFS + (((size_t)l * 32 + b) * 8 + lane) * 16 + t; }
                C.out[o] = lf; }
        }
    }
}

constexpr int HL_LF = 0, HL_SEG = 32768, HL_QT = 34816, HL_KTL = HL_QT + 17408, HL_VT = HL_KTL + 17408, HL_ST = HL_VT + 18432, HL_AS = HL_ST + 34816, HL_KH = HL_AS + 9216, HL_END = HL_KH + 10240;
static_assert(HL_END <= LDS_BYTES - 1024, "HGRN LDS map");
constexpr int HP_Q = 136, HP_V = 72, HP_O = 132;

template <int CH> __device__ __forceinline__ void hgrn_decay_prefix(Ctx& C, const float* HALL, int row0, int h, const float* lb) {
    LAS float* LF = (LAS float*)(C.lds + HL_LF); LAS float* SEG = (LAS float*)(C.lds + HL_SEG);
    const int tid = C.tid;
    for (int idx = tid; idx < CH * 128; idx += NTHR) { const int s = idx >> 7, d = idx & 127;
        const float z = HALL[(size_t)(row0 + s) * 2048 + 512 + h * 128 + d], lbv = lb[d];
        LF[idx] = (lbv == 0.f) ? log_sigmoidf_(z) : logf(lbv + (1.f - lbv) * sigmoidf_(z)); }
    __syncthreads();
    const int seg = tid >> 7, d = tid & 127; constexpr int R = CH / 4;
    float run = 0.f;
#pragma unroll
    for (int i = 0; i < R; ++i) { run += LF[(seg * R + i) * 128 + d]; LF[(seg * R + i) * 128 + d] = run; }
    SEG[seg * 128 + d] = run;
    __syncthreads();
    float off = 0.f;
#pragma unroll
    for (int s2 = 0; s2 < 3; ++s2) if (s2 < seg) off += SEG[s2 * 128 + d];
#pragma unroll
    for (int i = 0; i < R; ++i) LF[(seg * R + i) * 128 + d] += off;
    __syncthreads();
}

__device__ __forceinline__ void hgrn_local_unit(Ctx& C, int unit, int l) {
    const int bh = unit >> 7, c = unit & 127, b = bh >> 2, h = bh & 3, row0 = b * SEQ + c * 64;
    const float* HALL = (const float*)(C.ws + WS_HALL); const float* lb = (const float*)(C.ws + WS_LB) + l * 512 + h * 128;
    hgrn_decay_prefix<64>(C, HALL, row0, h, lb);
    LAS float* LF = (LAS float*)(C.lds + HL_LF);
    LAS bf16* KT = (LAS bf16*)(C.lds + HL_QT); LAS bf16* VT = (LAS bf16*)(C.lds + HL_VT);
    const int tid = C.tid;
    for (int idx = tid; idx < 64 * 128; idx += NTHR) { const int s = idx >> 7, d = idx & 127;
        const float* hr = HALL + (size_t)(row0 + s) * 2048 + h * 128 + d;
        const float z = hr[512], v = hr[1024], k = (1.f - lb[d]) * sigmoidf_(-z);
        KT[d * HP_V + s] = f2bf(k * __expf(LF[63 * 128 + d] - LF[idx])); VT[d * HP_V + s] = f2bf(v); }
    if (tid < 128) ((float*)(C.ws + WS_G))[(size_t)unit * 128 + tid] = __expf(LF[63 * 128 + tid]);
    __syncthreads();
    const int lane = C.lane, w = C.wave, r16 = lane & 15, quad = lane >> 4;
    f32x4 acc[8];
#pragma unroll
    for (int nb = 0; nb < 8; ++nb) acc[nb] = (f32x4){0.f, 0.f, 0.f, 0.f};
#pragma unroll
    for (int ks = 0; ks < 2; ++ks) { const bf16x8 a = *(const LAS bf16x8*)(VT + (w * 16 + r16) * HP_V + ks * 32 + quad * 8);
#pragma unroll
        for (int nb = 0; nb < 8; ++nb) { const bf16x8 bb = *(const LAS bf16x8*)(KT + (nb * 16 + r16) * HP_V + ks * 32 + quad * 8); acc[nb] = mfma16(a, bb, acc[nb]); } }
    float* US = (float*)(C.ws + WS_US) + (size_t)unit * 16384;
#pragma unroll
    for (int nb = 0; nb < 8; ++nb)
#pragma unroll
        for (int j = 0; j < 4; ++j) US[(w * 16 + quad * 4 + j) * 128 + nb * 16 + r16] = acc[nb][j];
    __syncthreads();
}

__device__ __forceinline__ void hgrn_scan(Ctx& C, int l, bool dummy = false) {
    float* US = (float*)(C.ws + WS_US); const size_t doff = dummy ? (WS_END - WS_US) / 4 : 0; const float* Gg = (const float*)(C.ws + WS_G);
    for (int e = C.bid * NTHR + C.tid; e < 8 * 16384; e += C.G * NTHR) {
        const int bh = e >> 14, el = e & 16383, dk = el & 127, dv = el >> 7;
        float* p = US + (size_t)bh * 128 * 16384 + el; const float* gp = Gg + (size_t)bh * 128 * 128 + dk;
        float s = 0.f;
        for (int c0 = 0; c0 < 128; c0 += 8) { float u[8], g[8];
#pragma unroll
            for (int i = 0; i < 8; ++i) { u[i] = p[(size_t)(c0 + i) * 16384]; g[i] = gp[(c0 + i) * 128]; }
#pragma unroll
            for (int i = 0; i < 8; ++i) { p[(size_t)(c0 + i) * 16384 + doff] = s; s = g[i] * s + u[i]; } }
        if (!dummy) C.out[O_HSP + ((size_t)l * 8 + bh) * 16384 + dk * 128 + dv] = s;
    }
}

template <int CH> __device__ __forceinline__ void hgrn_out_unit(Ctx& C, int unit, int l) {
    int row0, h, bh; const float* Ssrc;
    if (CH == 64) { bh = unit >> 7; const int c = unit & 127, b = bh >> 2; h = bh & 3; row0 = b * SEQ + c * 64; Ssrc = (const float*)(C.ws + WS_US) + (size_t)unit * 16384; }
    else { bh = unit; const int b = unit >> 2; h = unit & 3; row0 = MP + b * 16; Ssrc = C.in[5] + ((size_t)l * 128 + unit) * 16384; }
    const float* HALL = (const float*)(C.ws + WS_HALL); const float* lb = (const float*)(C.ws + WS_LB) + l * 512 + h * 128;
    hgrn_decay_prefix<CH>(C, HALL, row0, h, lb);
    LAS float* LF = (LAS float*)(C.lds + HL_LF);
    LAS bf16* QT = (LAS bf16*)(C.lds + HL_QT); LAS bf16* KTL = (LAS bf16*)(C.lds + HL_KTL); LAS bf16* VT = (LAS bf16*)(C.lds + HL_VT);
    LAS bf16* ST = (LAS bf16*)(C.lds + HL_ST); LAS bf16* AS = (LAS bf16*)(C.lds + HL_AS);
    LAS bf16* KH = (LAS bf16*)(C.lds + HL_KH);
    LAS float* BL = (LAS float*)(C.lds + HL_SEG);
    const int tid = C.tid; constexpr int MID = CH / 2, SP = (CH < 32) ? 32 : CH;
    if (CH == 16) {
        for (int i = tid; i < 128 * 16; i += NTHR) { const int d = i >> 4, s = 16 + (i & 15); VT[d * HP_V + s] = 0; KH[d * 40 + s] = 0; if (d < 16) AS[d * HP_V + s] = 0; }
    }
    for (int idx = tid; idx < CH * 128; idx += NTHR) { const int s = idx >> 7, d = idx & 127;
        const float* hr = HALL + (size_t)(row0 + s) * 2048 + h * 128 + d;
        const float q = hr[0], z = hr[512], v = hr[1024], k = (1.f - lb[d]) * sigmoidf_(-z);
        const float bs = LF[idx], r = LF[MID * 128 + d];
        QT[s * HP_Q + d] = f2bf(q * __expf(fminf(bs - r, 80.f))); KTL[s * HP_Q + d] = f2bf(k * __expf(fminf(r - bs, 80.f))); VT[d * HP_V + s] = f2bf(v);
        if (CH == 16) { KH[d * 40 + s] = f2bf(k * __expf(LF[(CH - 1) * 128 + d] - bs)); if (s == CH - 1) BL[d] = bs; } }
    if (CH == 64) { for (int i = tid; i < 16384; i += NTHR) { const int dv = i >> 7, dk = i & 127; ST[dv * HP_Q + dk] = f2bf(Ssrc[i] * __expf(LF[MID * 128 + dk])); } }
    else { for (int i = tid; i < 16384; i += NTHR) { const int dk = i >> 7, dv = i & 127; ST[dv * HP_Q + dk] = f2bf(Ssrc[i] * __expf(LF[MID * 128 + dk])); } }
    __syncthreads();
    const int lane = C.lane, w = C.wave, r16 = lane & 15, quad = lane >> 4;
    { constexpr int NTB = CH / 16;
      for (int blk = w; blk < NTB * NTB; blk += NWAVES) { const int tb = blk / NTB, sb = blk % NTB;
        f32x4 a = (f32x4){0.f, 0.f, 0.f, 0.f};
        if (sb <= tb) {
#pragma unroll
            for (int ks = 0; ks < 4; ++ks) { const bf16x8 qa = *(const LAS bf16x8*)(QT + (tb * 16 + r16) * HP_Q + ks * 32 + quad * 8), kb = *(const LAS bf16x8*)(KTL + (sb * 16 + r16) * HP_Q + ks * 32 + quad * 8); a = mfma16(qa, kb, a); } }
#pragma unroll
        for (int j = 0; j < 4; ++j) { const int t = tb * 16 + quad * 4 + j, s = sb * 16 + r16; AS[t * HP_V + s] = f2bf(s <= t ? a[j] : 0.f); } } }
    __syncthreads();
    LAS float* OS = (LAS float*)(C.lds + HL_LF);
    { constexpr int NTB = CH / 16;
      for (int blk = w; blk < NTB * 8; blk += NWAVES) { const int tb = blk >> 3, db = blk & 7;
        f32x4 o = (f32x4){0.f, 0.f, 0.f, 0.f};
#pragma unroll
        for (int ks = 0; ks < SP / 32; ++ks) { const bf16x8 pa = *(const LAS bf16x8*)(AS + (tb * 16 + r16) * HP_V + ks * 32 + quad * 8), vb = *(const LAS bf16x8*)(VT + (db * 16 + r16) * HP_V + ks * 32 + quad * 8); o = mfma16(pa, vb, o); }
#pragma unroll
        for (int ks = 0; ks < 4; ++ks) { const bf16x8 qa = *(const LAS bf16x8*)(QT + (tb * 16 + r16) * HP_Q + ks * 32 + quad * 8), sb_ = *(const LAS bf16x8*)(ST + (db * 16 + r16) * HP_Q + ks * 32 + quad * 8); o = mfma16(qa, sb_, o); }
#pragma unroll
        for (int j = 0; j < 4; ++j) OS[(tb * 16 + quad * 4 + j) * HP_O + db * 16 + r16] = o[j]; } }
    if (CH == 16) {
        f32x4 acc[8];
        const bf16x8 a = *(const LAS bf16x8*)(KH + (w * 16 + r16) * 40 + quad * 8);
#pragma unroll
        for (int nb = 0; nb < 8; ++nb) { const bf16x8 vb = *(const LAS bf16x8*)(VT + (nb * 16 + r16) * HP_V + quad * 8); acc[nb] = mfma16(a, vb, (f32x4){0.f, 0.f, 0.f, 0.f}); }
        float* So = C.out + O_HSS + ((size_t)l * 128 + unit) * 16384;
#pragma unroll
        for (int j = 0; j < 4; ++j) { const int dk = w * 16 + quad * 4 + j; const float g = __expf(BL[dk]);
#pragma unroll
            for (int nb = 0; nb < 8; ++nb) { const int dv = nb * 16 + r16; So[dk * 128 + dv] = g * Ssrc[dk * 128 + dv] + acc[nb][j]; } }
    }
    __syncthreads();
    if (tid < CH * 8) { const int t = tid >> 3, part = tid & 7; const LAS float* orow = OS + t * HP_O + part * 16;
        float ov[16]; float ss = 0.f;
#pragma unroll
        for (int i = 0; i < 4; ++i) { const f32x4 x = *(const LAS f32x4*)(orow + 4 * i); ov[4 * i] = x.x; ov[4 * i + 1] = x.y; ov[4 * i + 2] = x.z; ov[4 * i + 3] = x.w; ss += (x.x * x.x + x.y * x.y) + (x.z * x.z + x.w * x.w); }
        ss += __shfl_xor(ss, 1); ss += __shfl_xor(ss, 2); ss += __shfl_xor(ss, 4);
        const float rstd = 1.0f / sqrtf(ss * (1.0f / 128.f) + RMS_EPS);
        const float* gn = C.in[13] + l * 128 + part * 16; const float* hg = HALL + (size_t)(row0 + t) * 2048 + 1536 + h * 128 + part * 16;
        bf16* mo = (bf16*)(C.ws + WS_MIX) + (size_t)(row0 + t) * DM + 512 + h * 128 + part * 16;
        v4u w0, w1; unsigned pk[8];
#pragma unroll
        for (int i = 0; i < 8; ++i) pk[i] = pk2(ov[2 * i] * rstd * gn[2 * i] * siluf_(hg[2 * i]), ov[2 * i + 1] * rstd * gn[2 * i + 1] * siluf_(hg[2 * i + 1]));
        w0.x = pk[0]; w0.y = pk[1]; w0.z = pk[2]; w0.w = pk[3]; w1.x = pk[4]; w1.y = pk[5]; w1.z = pk[6]; w1.w = pk[7];
        *(v4u*)mo = w0; *(v4u*)(mo + 8) = w1; }
    __syncthreads();
}

__device__ __forceinline__ float block_excl_scan(Ctx& C, float total, LAS float* sm) {
    float x = total;
#pragma unroll
    for (int o = 1; o < 64; o <<= 1) { const float y = __shfl_up(x, o); if (C.lane >= o) x += y; }
    if (C.lane == 63) sm[C.wave] = x;
    __syncthreads();
    float woff = 0.f;
#pragma unroll
    for (int w2 = 0; w2 < NWAVES; ++w2) if (w2 < C.wave) woff += sm[w2];
    __syncthreads();
    return woff + (x - total);
}
__device__ __forceinline__ void cumsum_unit(Ctx& C, int unit, int l) {
    LAS float* sm = (LAS float*)(C.lds);
    if (unit < 16) {
        const float* src = C.out + O_LFP + ((size_t)l * 16 + unit) * 8192 + C.tid * 16; float* dst = (float*)(C.ws + WS_CP) + (size_t)unit * 8192 + C.tid * 16;
        float v[16];
#pragma unroll
        for (int i = 0; i < 4; ++i) { const f32x4 x = ((const f32x4*)src)[i]; v[4 * i] = x.x; v[4 * i + 1] = x.y; v[4 * i + 2] = x.z; v[4 * i + 3] = x.w; }
#pragma unroll
        for (int i = 1; i < 16; ++i) v[i] += v[i - 1];
        const float off = block_excl_scan(C, v[15], sm);
#pragma unroll
        for (int i = 0; i < 4; ++i) ((f32x4*)dst)[i] = (f32x4){(v[4 * i] + off) * LOG2E, (v[4 * i + 1] + off) * LOG2E, (v[4 * i + 2] + off) * LOG2E, (v[4 * i + 3] + off) * LOG2E};
    } else {
        const int bh = unit - 16;
        const float* src = C.in[4] + ((size_t)l * 256 + bh) * PAST + C.tid * 4; float* dst = (float*)(C.ws + WS_CS) + (size_t)bh * SKV;
        f32x4 x = *(const f32x4*)src; x.y += x.x; x.z += x.y; x.w += x.z;
        const float off = block_excl_scan(C, x.w, sm);
        *(f32x4*)(dst + C.tid * 4) = (x + off) * LOG2E;
        if (C.tid == NTHR - 1) { float run = x.w + off; const float* nl = C.out + O_LFS + ((size_t)l * 256 + bh) * 16;
            for (int t = 0; t < 16; ++t) { run += nl[t]; dst[PAST + t] = run * LOG2E; } }
    }
}
__device__ __forceinline__ void ktn_task(Ctx& C, int task) {
    const int bh = task >> 7, tile = task & 127, b = bh >> 3, h = bh & 7, lane = C.lane;
    const bf16* Kb = (const bf16*)(C.ws + WS_KB) + ((size_t)b * SEQ + tile * 64) * 512 + h * 64;
    float mx = 0.f;
#pragma unroll
    for (int i = 0; i < 8; ++i) { const int key = i * 8 + (lane >> 3); const v4u w = *(const v4u*)(Kb + (size_t)key * 512 + (lane & 7) * 8);
        float s = 0.f; const unsigned ww[4] = {w.x, w.y, w.z, w.w};
#pragma unroll
        for (int e = 0; e < 4; ++e) { const float lo = __builtin_bit_cast(float, ww[e] << 16), hi = __builtin_bit_cast(float, ww[e] & 0xffff0000u); s += lo * lo + hi * hi; }
        s += __shfl_xor(s, 1); s += __shfl_xor(s, 2); s += __shfl_xor(s, 4);
        mx = fmaxf(mx, s); }
    mx = wave_max(mx);
    if (lane == 0) ((float*)(C.ws + WS_KTN))[task] = sqrtf(mx);
}

constexpr int AT_SLOT = 16384, AT_VT = 0, AT_P = 9216, AP = 72;
struct AttnState { bf16x8 qa[2]; float cq[4], m[4], l[4]; f32x4 o[4]; };
__device__ __forceinline__ bf16x8 kfrag_bf16(const bf16* p) { return *(const bf16x8*)p; }
__device__ __forceinline__ bf16x8 kfrag_f32(const float* p) { const f32x4 a = *(const f32x4*)p, b = *(const f32x4*)(p + 4); v4u w; w.x = pk2(a.x, a.y); w.y = pk2(a.z, a.w); w.z = pk2(b.x, b.y); w.w = pk2(b.z, b.w); return __builtin_bit_cast(bf16x8, w); }
template <bool F32> __device__ __forceinline__ void attn_tile(AttnState& S, const void* Ksrc, const void* Vsrc, int pitch, int nvalid, const float* ck, int diag, LAS bf16* VT, LAS bf16* PL, int lane) {
    const int col = lane & 15, quad = lane >> 4;
    if (F32) { const float* V = (const float*)Vsrc;
#pragma unroll 4
        for (int i = 0; i < 16; ++i) { const int key = i * 4 + (lane >> 4), dc = (lane & 15) * 4; f32x4 x = (f32x4){0.f, 0.f, 0.f, 0.f};
            if (key < nvalid) x = *(const f32x4*)(V + (size_t)key * pitch + dc);
            VT[(dc + 0) * AP + key] = f2bf(x.x); VT[(dc + 1) * AP + key] = f2bf(x.y); VT[(dc + 2) * AP + key] = f2bf(x.z); VT[(dc + 3) * AP + key] = f2bf(x.w); }
    } else { const bf16* V = (const bf16*)Vsrc;
#pragma unroll 4
        for (int i = 0; i < 8; ++i) { const int key = i * 8 + (lane >> 3), dc = (lane & 7) * 8; v4u w = (v4u){0u, 0u, 0u, 0u};
            if (key < nvalid) w = *(const v4u*)(V + (size_t)key * pitch + dc);
            VT[(dc + 0) * AP + key] = (bf16)(w.x & 0xffffu); VT[(dc + 1) * AP + key] = (bf16)(w.x >> 16); VT[(dc + 2) * AP + key] = (bf16)(w.y & 0xffffu); VT[(dc + 3) * AP + key] = (bf16)(w.y >> 16);
            VT[(dc + 4) * AP + key] = (bf16)(w.z & 0xffffu); VT[(dc + 5) * AP + key] = (bf16)(w.z >> 16); VT[(dc + 6) * AP + key] = (bf16)(w.w & 0xffffu); VT[(dc + 7) * AP + key] = (bf16)(w.w >> 16); }
    }
    f32x4 s[4];
#pragma unroll
    for (int nb = 0; nb < 4; ++nb) { const int key = nb * 16 + col, kc = key < nvalid ? key : (nvalid - 1);
        f32x4 a = (f32x4){0.f, 0.f, 0.f, 0.f};
#pragma unroll
        for (int ks = 0; ks < 2; ++ks) { const bf16x8 kb = F32 ? kfrag_f32((const float*)Ksrc + (size_t)kc * pitch + ks * 32 + quad * 8) : kfrag_bf16((const bf16*)Ksrc + (size_t)kc * pitch + ks * 32 + quad * 8);
            a = mfma16(S.qa[ks], kb, a); }
        const float ckv = ck[kc];
#pragma unroll
        for (int j = 0; j < 4; ++j) { const int r = quad * 4 + j; const bool ok = (key < nvalid) && (key <= r + diag); a[j] = ok ? (a[j] + (S.cq[j] - ckv)) : -INFINITY; }
        s[nb] = a; }
    float alpha[4];
#pragma unroll
    for (int j = 0; j < 4; ++j) { float mx = fmaxf(fmaxf(s[0][j], s[1][j]), fmaxf(s[2][j], s[3][j]));
        mx = fmaxf(mx, __shfl_xor(mx, 1)); mx = fmaxf(mx, __shfl_xor(mx, 2)); mx = fmaxf(mx, __shfl_xor(mx, 4)); mx = fmaxf(mx, __shfl_xor(mx, 8));
        const float mnew = fmaxf(S.m[j], mx), msafe = (mnew == -INFINITY) ? 0.f : mnew;
        alpha[j] = fast_exp2(S.m[j] - msafe); S.m[j] = mnew;
        float ps = 0.f;
#pragma unroll
        for (int nb = 0; nb < 4; ++nb) { const float p = fast_exp2(s[nb][j] - msafe); s[nb][j] = p; ps += p; }
        S.l[j] = S.l[j] * alpha[j] + ps; }
#pragma unroll
    for (int nb = 0; nb < 4; ++nb)
#pragma unroll
        for (int j = 0; j < 4; ++j) { PL[(quad * 4 + j) * AP + nb * 16 + col] = f2bf(s[nb][j]); S.o[nb][j] *= alpha[j]; }
    LDS_WAIT(); __builtin_amdgcn_wave_barrier(); asm volatile("" ::: "memory");
    bf16x8 pa[2];
#pragma unroll
    for (int ks = 0; ks < 2; ++ks) pa[ks] = *(const LAS bf16x8*)(PL + col * AP + ks * 32 + quad * 8);
#pragma unroll
    for (int nb = 0; nb < 4; ++nb)
#pragma unroll
        for (int ks = 0; ks < 2; ++ks) { const bf16x8 vb = *(const LAS bf16x8*)(VT + (nb * 16 + col) * AP + ks * 32 + quad * 8); S.o[nb] = mfma16(pa[ks], vb, S.o[nb]); }
    LDS_WAIT(); __builtin_amdgcn_wave_barrier(); asm volatile("" ::: "memory");
}
__device__ __forceinline__ void attn_init(AttnState& S, const bf16* Qrow0, const float* cq0, int lane) {
    const int col = lane & 15, quad = lane >> 4;
#pragma unroll
    for (int ks = 0; ks < 2; ++ks) S.qa[ks] = *(const bf16x8*)(Qrow0 + (size_t)col * 512 + ks * 32 + quad * 8);
#pragma unroll
    for (int j = 0; j < 4; ++j) { S.cq[j] = cq0[quad * 4 + j]; S.m[j] = -INFINITY; S.l[j] = 0.f; }
#pragma unroll
    for (int nb = 0; nb < 4; ++nb) S.o[nb] = (f32x4){0.f, 0.f, 0.f, 0.f};
}
__device__ __forceinline__ float attn_qmax(const AttnState& S) {
    float s = 0.f;
#pragma unroll
    for (int ks = 0; ks < 2; ++ks)
#pragma unroll
        for (int e = 0; e < 8; ++e) { const float x = bf2f((bf16)S.qa[ks][e]); s += x * x; }
    s += __shfl_xor(s, 16); s += __shfl_xor(s, 32);
    return sqrtf(wave_max(s));
}
__device__ __forceinline__ void attn_prompt_task(Ctx& C, int task) {
    const int bh = task >> 9, rb = task & 511, b = bh >> 3, h = bh & 7, lane = C.lane, i0 = rb * 16;
    const bf16* Qb = (const bf16*)(C.ws + WS_QB); const bf16* Kb = (const bf16*)(C.ws + WS_KB); const bf16* Vb = (const bf16*)(C.ws + WS_VB);
    const float* cp = (const float*)(C.ws + WS_CP) + (size_t)bh * SEQ;
    LAS bf16* VT = (LAS bf16*)(C.lds + C.wave * AT_SLOT + AT_VT); LAS bf16* PL = (LAS bf16*)(C.lds + C.wave * AT_SLOT + AT_P);
    AttnState S; attn_init(S, Qb + ((size_t)b * SEQ + i0) * 512 + h * 64, cp + i0, lane);
    const float* ktn = (const float*)(C.ws + WS_KTN) + bh * 128;
    const float kmax = wave_max(fmaxf(ktn[lane], ktn[lane + 64])), bound = 2.0f * attn_qmax(S) * kmax;
    const int jd = i0 >> 6; const float c0 = cp[i0];
    int jstart = jd;
    { const int t0 = lane, t1 = lane + 64;
      const bool n0 = (t0 < jd) && (c0 - cp[t0 * 64 + 63] + bound >= -151.5f), n1 = (t1 < jd) && (c0 - cp[(t1 < jd ? t1 : 0) * 64 + 63] + bound >= -151.5f);
      const unsigned long long m0 = __ballot(n0), m1 = __ballot(n1);
      if (m0) jstart = __builtin_ctzll(m0); else if (m1) jstart = 64 + __builtin_ctzll(m1); }
    for (int t = jstart; t <= jd; ++t) {
        const size_t krow = ((size_t)b * SEQ + t * 64) * 512 + h * 64;
        attn_tile<false>(S, Kb + krow, Vb + krow, 512, 64, cp + t * 64, (t == jd) ? (i0 - t * 64) : 64, VT, PL, lane);
    }
    const int col = lane & 15, quad = lane >> 4;
#pragma unroll
    for (int j = 0; j < 4; ++j) { float lt = S.l[j]; lt += __shfl_xor(lt, 1); lt += __shfl_xor(lt, 2); lt += __shfl_xor(lt, 4); lt += __shfl_xor(lt, 8); const float inv = 1.0f / lt;
#pragma unroll
        for (int nb = 0; nb < 4; ++nb) PL[(quad * 4 + j) * AP + nb * 16 + col] = f2bf(S.o[nb][j] * inv); }
    LDS_WAIT(); __builtin_amdgcn_wave_barrier(); asm volatile("" ::: "memory");
    bf16* mix = (bf16*)(C.ws + WS_MIX) + ((size_t)b * SEQ + i0) * DM + h * 64;
#pragma unroll
    for (int i = 0; i < 2; ++i) { const int r = i * 8 + (lane >> 3), ch = lane & 7; *(v4u*)(mix + (size_t)r * DM + ch * 8) = *(const LAS v4u*)(PL + r * AP + ch * 8); }
    LDS_WAIT(); __builtin_amdgcn_wave_barrier(); asm volatile("" ::: "memory");
}
constexpr int AB_K = 0, AB_V = 18432, AB_P = 36864, AB_CK = 55296, AB_RED = 55808;
__device__ __forceinline__ void attn_tile_lds(AttnState& S, const LAS bf16* KL, const LAS bf16* VT, const LAS float* CK, int diag, LAS bf16* PL, int lane) {
    const int col = lane & 15, quad = lane >> 4;
    f32x4 s[4];
#pragma unroll
    for (int nb = 0; nb < 4; ++nb) { const int key = nb * 16 + col;
        f32x4 a = (f32x4){0.f, 0.f, 0.f, 0.f};
#pragma unroll
        for (int ks = 0; ks < 2; ++ks) { const bf16x8 kb = *(const LAS bf16x8*)(KL + key * AP + ks * 32 + quad * 8); a = mfma16(S.qa[ks], kb, a); }
        const float ckv = CK[key];
#pragma unroll
        for (int j = 0; j < 4; ++j) { const int r = quad * 4 + j; a[j] = (key <= r + diag) ? (a[j] + (S.cq[j] - ckv)) : -INFINITY; }
        s[nb] = a; }
    float alpha[4];
#pragma unroll
    for (int j = 0; j < 4; ++j) { float mx = fmaxf(fmaxf(s[0][j], s[1][j]), fmaxf(s[2][j], s[3][j]));
        mx = fmaxf(mx, __shfl_xor(mx, 1)); mx = fmaxf(mx, __shfl_xor(mx, 2)); mx = fmaxf(mx, __shfl_xor(mx, 4)); mx = fmaxf(mx, __shfl_xor(mx, 8));
        const float mnew = fmaxf(S.m[j], mx), msafe = (mnew == -INFINITY) ? 0.f : mnew;
        alpha[j] = fast_exp2(S.m[j] - msafe); S.m[j] = mnew;
        float ps = 0.f;
#pragma unroll
        for (int nb = 0; nb < 4; ++nb) { const float p = fast_exp2(s[nb][j] - msafe); s[nb][j] = p; ps += p; }
        S.l[j] = S.l[j] * alpha[j] + ps; }
#pragma unroll
    for (int nb = 0; nb < 4; ++nb)
#pragma unroll
        for (int j = 0; j < 4; ++j) { PL[(quad * 4 + j) * AP + nb * 16 + col] = f2bf(s[nb][j]); S.o[nb][j] *= alpha[j]; }
    LDS_WAIT(); __builtin_amdgcn_wave_barrier(); asm volatile("" ::: "memory");
    bf16x8 pa[2];
#pragma unroll
    for (int ks = 0; ks < 2; ++ks) pa[ks] = *(const LAS bf16x8*)(PL + col * AP + ks * 32 + quad * 8);
#pragma unroll
    for (int nb = 0; nb < 4; ++nb)
#pragma unroll
        for (int ks = 0; ks < 2; ++ks) { const bf16x8 vb = *(const LAS bf16x8*)(VT + (nb * 16 + col) * AP + ks * 32 + quad * 8); S.o[nb] = mfma16(pa[ks], vb, S.o[nb]); }
    LDS_WAIT(); __builtin_amdgcn_wave_barrier(); asm volatile("" ::: "memory");
}
__device__ __forceinline__ void attn_prompt_unit(Ctx& C, int unit) {
    const int bh = unit >> 6, qb = 63 - (unit & 63), b = bh >> 3, h = bh & 7, lane = C.lane, w = C.wave, tid = C.tid, i0b = qb * 128, i0 = i0b + 16 * w;
    const bf16* Qb = (const bf16*)(C.ws + WS_QB); const bf16* Kb = (const bf16*)(C.ws + WS_KB) + (size_t)b * SEQ * 512 + h * 64; const bf16* Vb = (const bf16*)(C.ws + WS_VB) + (size_t)b * SEQ * 512 + h * 64;
    const float* cp = (const float*)(C.ws + WS_CP) + (size_t)bh * SEQ;
    LAS bf16* KL = (LAS bf16*)(C.lds + AB_K); LAS bf16* VT = (LAS bf16*)(C.lds + AB_V); LAS bf16* PL = (LAS bf16*)(C.lds + AB_P) + w * 16 * AP;
    LAS float* CK = (LAS float*)(C.lds + AB_CK); LAS float* RED = (LAS float*)(C.lds + AB_RED);
    AttnState S; attn_init(S, Qb + ((size_t)b * SEQ + i0) * 512 + h * 64, cp + i0, lane);
    { const float qm = attn_qmax(S); if (lane == 0) RED[w] = qm; }
    __syncthreads();
    float qmax = RED[0];
#pragma unroll
    for (int i = 1; i < NWAVES; ++i) qmax = fmaxf(qmax, RED[i]);
    const float* ktn = (const float*)(C.ws + WS_KTN) + bh * 128;
    const float kmax = wave_max(fmaxf(ktn[lane], ktn[lane + 64])), bound = 2.0f * qmax * kmax;
    const int jd0 = i0b >> 6, jlast = jd0 + 1; const float c0 = cp[i0b];
    int jstart = jd0;
    { const int t0 = lane, t1 = lane + 64;
      const bool n0 = (t0 < jd0) && (c0 - cp[t0 * 64 + 63] + bound >= -151.5f), n1 = (t1 < jd0) && (c0 - cp[(t1 < jd0 ? t1 : 0) * 64 + 63] + bound >= -151.5f);
      const unsigned long long m0 = __ballot(n0), m1 = __ballot(n1);
      if (m0) jstart = __builtin_ctzll(m0); else if (m1) jstart = 64 + __builtin_ctzll(m1); }
    const int skey = tid >> 3, sch = tid & 7;
    v4u kreg, vreg; float creg = 0.f;
#define AT_LOAD(t) do { kreg = *(const v4u*)(Kb + (size_t)((t) * 64 + skey) * 512 + sch * 8); vreg = *(const v4u*)(Vb + (size_t)((t) * 64 + lane) * 512 + w * 8); if (tid < 64) creg = cp[(t) * 64 + tid]; } while (0)
#define AT_STORE(bf) do { *(LAS v4u*)(KL + (bf) * 64 * AP + skey * AP + sch * 8) = kreg; LAS bf16* vt_ = VT + (bf) * 64 * AP + (w * 8) * AP + lane; \
        vt_[0 * AP] = (bf16)(vreg.x & 0xffffu); vt_[1 * AP] = (bf16)(vreg.x >> 16); vt_[2 * AP] = (bf16)(vreg.y & 0xffffu); vt_[3 * AP] = (bf16)(vreg.y >> 16); \
        vt_[4 * AP] = (bf16)(vreg.z & 0xffffu); vt_[5 * AP] = (bf16)(vreg.z >> 16); vt_[6 * AP] = (bf16)(vreg.w & 0xffffu); vt_[7 * AP] = (bf16)(vreg.w >> 16); \
        if (tid < 64) CK[(bf) * 64 + tid] = creg; } while (0)
    AT_LOAD(jstart); AT_STORE(0);
    __syncthreads();
    for (int t = jstart; t <= jlast; ++t) { const int bf = (t - jstart) & 1;
        if (t < jlast) AT_LOAD(t + 1);
        const int diag = i0 - 64 * t;
        if (diag >= 0) attn_tile_lds(S, KL + bf * 64 * AP, VT + bf * 64 * AP, CK + bf * 64, diag, PL, lane);
        if (t < jlast) AT_STORE(bf ^ 1);
        __syncthreads();
    }
#undef AT_LOAD
#undef AT_STORE
    const int col = lane & 15, quad = lane >> 4;
#pragma unroll
    for (int j = 0; j < 4; ++j) { float lt = S.l[j]; lt += __shfl_xor(lt, 1); lt += __shfl_xor(lt, 2); lt += __shfl_xor(lt, 4); lt += __shfl_xor(lt, 8); const float inv = 1.0f / lt;
#pragma unroll
        for (int nb = 0; nb < 4; ++nb) PL[(quad * 4 + j) * AP + nb * 16 + col] = f2bf(S.o[nb][j] * inv); }
    LDS_WAIT(); __builtin_amdgcn_wave_barrier(); asm volatile("" ::: "memory");
    bf16* mix = (bf16*)(C.ws + WS_MIX) + ((size_t)b * SEQ + i0) * DM + h * 64;
#pragma unroll
    for (int i = 0; i < 2; ++i) { const int r = i * 8 + (lane >> 3), ch = lane & 7; *(v4u*)(mix + (size_t)r * DM + ch * 8) = *(const LAS v4u*)(PL + r * AP + ch * 8); }
    LDS_WAIT(); __builtin_amdgcn_wave_barrier(); asm volatile("" ::: "memory");
}
__device__ __forceinline__ void attn_sample_unit(Ctx& C, int unit, int l) {
    const int b = unit >> 3, h = unit & 7, lane = C.lane, w = C.wave;
    const bf16* Qb = (const bf16*)(C.ws + WS_QB); const bf16* Kb = (const bf16*)(C.ws + WS_KB); const bf16* Vb = (const bf16*)(C.ws + WS_VB);
    const float* cs = (const float*)(C.ws + WS_CS) + (size_t)unit * SKV;
    LAS bf16* VT = (LAS bf16*)(C.lds + w * AT_SLOT + AT_VT); LAS bf16* PL = (LAS bf16*)(C.lds + w * AT_SLOT + AT_P);
    const size_t srow = ((size_t)MP + b * 16) * 512 + h * 64;
    AttnState S; attn_init(S, Qb + srow, cs + PAST, lane);
    const float* ck = C.in[2] + (((size_t)l * 32 + b) * 8 + h) * PAST * 64; const float* cv = C.in[3] + (((size_t)l * 32 + b) * 8 + h) * PAST * 64;
    for (int t = w; t < 32; t += NWAVES) attn_tile<true>(S, ck + (size_t)t * 64 * 64, cv + (size_t)t * 64 * 64, 64, 64, cs + t * 64, 64, VT, PL, lane);
    if (w == 0) attn_tile<false>(S, Kb + srow, Vb + srow, 512, 16, cs + PAST, 0, VT, PL, lane);
    const int col = lane & 15, quad = lane >> 4;
    LAS float* slot = (LAS float*)(C.lds + w * AT_SLOT);
#pragma unroll
    for (int j = 0; j < 4; ++j) { float lt = S.l[j]; lt += __shfl_xor(lt, 1); lt += __shfl_xor(lt, 2); lt += __shfl_xor(lt, 4); lt += __shfl_xor(lt, 8);
        if (col == 0) { slot[quad * 4 + j] = S.m[j]; slot[16 + quad * 4 + j] = lt; }
#pragma unroll
        for (int nb = 0; nb < 4; ++nb) slot[64 + (quad * 4 + j) * 64 + nb * 16 + col] = S.o[nb][j]; }
    __syncthreads();
    bf16* mix = (bf16*)(C.ws + WS_MIX) + ((size_t)MP + b * 16) * DM + h * 64;
    for (int e = C.tid; e < 16 * 64; e += NTHR) { const int r = e >> 6, d = e & 63;
        float M = -INFINITY;
#pragma unroll
        for (int w2 = 0; w2 < NWAVES; ++w2) M = fmaxf(M, ((const LAS float*)(C.lds + w2 * AT_SLOT))[r]);
        float num = 0.f, den = 0.f;
#pragma unroll
        for (int w2 = 0; w2 < NWAVES; ++w2) { const LAS float* sl = (const LAS float*)(C.lds + w2 * AT_SLOT); const float f = fast_exp2(sl[r] - M); num += f * sl[64 + r * 64 + d]; den += f * sl[16 + r]; }
        mix[(size_t)r * DM + d] = f2bf(num / den); }
    __syncthreads();
}

constexpr int LDSCTL_OFF = LDS_BYTES - 64, CW_BAR = 4096;
#define XB_TMO      128
#define XB_XCNT(j)  (256  + 64 * (j))
#define XB_XSUB(j)  (1280 + 64 * (j))
#define XB_XGEN(j)  (2304 + 64 * (j))
#define XB_TOP      3328
#define XB_TOPGEN   3392
#define XCD_BAR_WORDS 3456
#define XB_SPIN_CAP (1u << 18)

__device__ __forceinline__ unsigned xb_ld(unsigned* p)              { return __hip_atomic_load(p, __ATOMIC_RELAXED, __HIP_MEMORY_SCOPE_AGENT); }
__device__ __forceinline__ unsigned xb_add(unsigned* p, unsigned v) { return __hip_atomic_fetch_add(p, v, __ATOMIC_RELAXED, __HIP_MEMORY_SCOPE_AGENT); }
__device__ __forceinline__ unsigned xb_xcc_id() { return (unsigned)__builtin_amdgcn_s_getreg((3 << 11) | 20) & 0xFu; }
#define XB_SPIN(cond, bar) do { unsigned _sp = 0; while (cond) { __builtin_amdgcn_s_sleep(1); \
    if ((++_sp & 255u) == 0u) { if (xb_ld(&(bar)[XB_TMO])) break; if (_sp > XB_SPIN_CAP) { atomicAdd(&(bar)[XB_TMO], 1u); break; } } } } while (0)

struct XcdBarrier {
    unsigned* bar; unsigned x;
    volatile LAS unsigned* st;
};

__device__ __forceinline__ XcdBarrier xcd_barrier_post(unsigned* bar, volatile LAS unsigned* st) {
    XcdBarrier b; b.bar = bar; b.x = xb_xcc_id(); b.st = st;
    if (threadIdx.x == 0) (void)xb_add(&bar[XB_XCNT(b.x)], 1u);
    return b;
}
__device__ __forceinline__ void xcd_barrier_complete(unsigned* bar, unsigned x, unsigned& nloc, unsigned& nx) {
    const unsigned G = gridDim.x * gridDim.y * gridDim.z;
    unsigned sum, cnt, mine, sp = 0u;
    for (;;) {
        sum = 0u; cnt = 0u; mine = 0u;
#pragma unroll
        for (unsigned j = 0; j < 16; ++j) { const unsigned c = xb_ld(&bar[XB_XCNT(j)]); sum += c; cnt += (c > 0u) ? 1u : 0u; mine = (j == x) ? c : mine; }
        if (sum == G) break;
        __builtin_amdgcn_s_sleep(1);
        if ((++sp & 255u) == 0u) { if (xb_ld(&bar[XB_TMO])) break; if (sp > XB_SPIN_CAP) { atomicAdd(&bar[XB_TMO], 1u); break; } }
    }
    nloc = mine > 0u ? mine : 1u; nx = cnt > 0u ? cnt : 1u;
}

__device__ __forceinline__ void xcd_barrier(const XcdBarrier& b) {
    asm volatile("s_waitcnt vmcnt(0)" ::: "memory");
    __syncthreads();
    if (threadIdx.x == 0) {
        unsigned* bar = b.bar;
        __builtin_amdgcn_s_waitcnt(0);
        unsigned nloc = b.st[0], nx = b.st[1];
        if (nloc == 0u) { xcd_barrier_complete(bar, b.x, nloc, nx); b.st[0] = nloc; b.st[1] = nx; }
        const unsigned old = xb_add(&bar[XB_XSUB(b.x)], 1u);
        const unsigned gen = old / nloc;
        if (old + 1u == (gen + 1u) * nloc) {
            __builtin_amdgcn_fence(__ATOMIC_RELEASE, "agent");
            asm volatile("s_waitcnt vmcnt(0)" ::: "memory");
            const unsigned og = xb_add(&bar[XB_TOP], 1u);
            const unsigned tg = og / nx;
            if (og + 1u == (tg + 1u) * nx) xb_add(&bar[XB_TOPGEN], 1u);
            else XB_SPIN(xb_ld(&bar[XB_TOPGEN]) == tg, bar);
            __builtin_amdgcn_fence(__ATOMIC_ACQUIRE, "agent");
            xb_add(&bar[XB_XGEN(b.x)], 1u);
            asm volatile("s_waitcnt vmcnt(0)" ::: "memory");
        } else {
            XB_SPIN(xb_ld(&bar[XB_XGEN(b.x)]) == gen, bar);
            __builtin_amdgcn_fence(__ATOMIC_ACQUIRE, "agent");
            asm volatile("s_waitcnt vmcnt(0)" ::: "memory");
        }
    }
    __syncthreads();
}

template <int KIND, int L> __device__ __forceinline__ void gemm_up(Ctx& C) {
    pg8::Gemm g{(const bf16*)(C.ws + WS_HN), (const bf16*)(C.ws + WS_W1T) + (size_t)(L * 2 + KIND) * W1T_SZ, MT, 2 * DFF, DM}; pg8::StaticOrder S; S.init(MT, 2 * DFF, C.G, C.bid);
    pg8::EpiSwiglu E{(bf16*)(C.ws + WS_ACT)};
    pg8::gemm_phase<pg8::EpiSwiglu, pg8::StaticOrder, true, true>(C.lds, g, S, E);
}
template <int KIND, int L> __device__ __forceinline__ void gemm_res(Ctx& C, bool dummy = false) {
    pg8::Gemm g;
    if (KIND == 2) g = pg8::Gemm{(const bf16*)(C.ws + WS_MIX), (const bf16*)(C.ws + WS_WOT) + (size_t)L * WOT_SZ, MT, DM, DM};
    else g = pg8::Gemm{(const bf16*)(C.ws + WS_ACT), (const bf16*)(C.ws + WS_W2T) + (size_t)(L * 2 + KIND) * W2T_SZ, MT, DM, DFF};
    pg8::SplitOrder S; S.init(MP, DM, C.G, C.bid, (KIND == 2 ? DM : DFF) / 64);
    pg8::EpiRes E{(float*)(C.ws + (dummy ? WS_END : WS_X)), (float*)(C.ws + (dummy ? WS_END + 100 * MiB : WS_PART)), KIND == 2 ? 1.0f : 0.5f};
    pg8::gemm_phase<pg8::EpiRes, pg8::SplitOrder, true, true>(C.lds, g, S, E);
}
template <int L> __device__ __forceinline__ void gemm_inproj(Ctx& C) {
    pg8::Gemm g{(const bf16*)(C.ws + WS_HN), (const bf16*)(C.ws + WS_WINT) + (size_t)L * WINT_SZ, MT, NIN, DM}; pg8::StaticOrder S; S.init(MT, NIN, C.G, C.bid);
    pg8::EpiInProj E{(bf16*)(C.ws + WS_QB), (bf16*)(C.ws + WS_KB), (bf16*)(C.ws + WS_VB), (float*)(C.ws + WS_HALL), C.out, L};
    pg8::gemm_phase<pg8::EpiInProj, pg8::StaticOrder, true, true>(C.lds, g, S, E);
}
__device__ __forceinline__ void phase_prep(Ctx& C, int l) {
    for (int u = C.bid; u < 1024; u += C.G) hgrn_local_unit(C, u, l);
    for (int u = C.bid; u < 272; u += C.G) cumsum_unit(C, u, l);
    for (int t = CTX_GW(C); t < 2048; t += CTX_NGW(C)) ktn_task(C, t);
}
__device__ __forceinline__ void phase_attn(Ctx& C, int l, bool noscan = false) {
    for (int u = C.bid; u < 256; u += C.G) attn_sample_unit(C, u, l);
    if (!noscan) hgrn_scan(C, l);
    for (int u = C.bid; u < 1024; u += C.G) attn_prompt_unit(C, u);
}
__device__ __forceinline__ void phase_hout(Ctx& C, int l) {
    for (int u = C.bid; u < 1024; u += C.G) hgrn_out_unit<64>(C, u, l);
    for (int u = C.bid; u < 128; u += C.G) hgrn_out_unit<16>(C, u, l);
}
template <int L> __device__ __forceinline__ void layer_phases(Ctx& C, const XcdBarrier& bar, int lo, int hi) {
    constexpr int P = 1 + 12 * L;
#define IN(k) (lo <= (k) && (k) < hi)
#define SEAM(k) do { if (IN(k) && IN((k) + 1)) xcd_barrier(bar); } while (0)
#define DUPK(k) (L == 0 && ((DUP >> (k)) & 1))
    if (IN(P + 0)) { phase_rms<0>(C, C.in[6] + L * DM, L, L == 0 ? 0.f : 0.5f); if (DUPK(0)) { xcd_barrier(bar); phase_rms<0>(C, C.in[6] + L * DM, L, L == 0 ? 0.f : 0.5f); } }
    SEAM(P + 0);
    if (IN(P + 1)) { gemm_up<0, L>(C); if (DUPK(1)) { xcd_barrier(bar); gemm_up<0, L>(C); } }
    SEAM(P + 1);
    if (IN(P + 2)) { gemm_res<0, L>(C); if (DUPK(2)) { xcd_barrier(bar); gemm_res<0, L>(C, true); } }
    SEAM(P + 2);
    if (IN(P + 3)) { phase_rms<1>(C, C.in[9] + L * DM, L, 0.5f); if (DUPK(3)) { xcd_barrier(bar); phase_rms<1>(C, C.in[9] + L * DM, L, 0.5f); } }
    SEAM(P + 3);
    if (IN(P + 4)) { gemm_inproj<L>(C); if (DUPK(4)) { xcd_barrier(bar); gemm_inproj<L>(C); } }
    SEAM(P + 4);
    if (IN(P + 5)) { phase_prep(C, L); if (DUPK(5)) { xcd_barrier(bar); phase_prep(C, L); } }
    SEAM(P + 5);
    if (IN(P + 6)) { phase_attn(C, L); if (DUPK(6)) { xcd_barrier(bar); phase_attn(C, L, true); } if (DUPK(10)) { xcd_barrier(bar); hgrn_scan(C, L, true); } if (DUPK(11)) { xcd_barrier(bar); for (int u = C.bid; u < 256; u += C.G) attn_sample_unit(C, u, L); } }
    SEAM(P + 6);
    if (IN(P + 7)) { phase_hout(C, L); if (DUPK(7)) { xcd_barrier(bar); phase_hout(C, L); } }
    SEAM(P + 7);
    if (IN(P + 8)) { gemm_res<2, L>(C); if (DUPK(8)) { xcd_barrier(bar); gemm_res<2, L>(C, true); } }
    SEAM(P + 8);
    if (IN(P + 9)) { phase_rms<0>(C, C.in[15] + L * DM, L, 1.0f); if (DUPK(9)) { xcd_barrier(bar); phase_rms<0>(C, C.in[15] + L * DM, L, 1.0f); } }
    SEAM(P + 9);
    if (IN(P + 10)) gemm_up<1, L>(C);
    SEAM(P + 10);
    if (IN(P + 11)) gemm_res<1, L>(C);
    SEAM(P + 11);
#undef DUPK
#undef IN
#undef SEAM
}

__global__ void __launch_bounds__(NTHR, 2) fwd_megakernel(Params prm) {
    extern __shared__ __attribute__((aligned(16))) unsigned char lds_raw[];
    Ctx C;
    C.lds = (LAS unsigned char*)lds_raw; C.tid = threadIdx.x; C.lane = C.tid & 63; C.wave = __builtin_amdgcn_readfirstlane(C.tid >> 6); C.G = gridDim.x; C.bid = blockIdx.x;
#pragma unroll
    for (int i = 0; i < 19; ++i) C.in[i] = prm.in[i];
    C.out = prm.out; C.ws = prm.ws;
    cg::grid_group grid = cg::this_grid();
    volatile LAS unsigned* MISC = (volatile LAS unsigned*)(C.lds + LDSCTL_OFF);
    if (C.tid < 16) MISC[C.tid] = 0u;
    __syncthreads();
    XcdBarrier bar; bar.bar = (unsigned*)(C.ws + WS_CTL) + CW_BAR; bar.x = 0; bar.st = nullptr;
    if (ONE_LAUNCH) bar = xcd_barrier_post((unsigned*)(C.ws + WS_CTL) + CW_BAR, MISC + 8);
    const int lo = prm.ph_lo, hi = prm.ph_hi;
#define IN(k) (lo <= (k) && (k) < hi)
#define SEAM(k) do { if (IN(k) && IN((k) + 1)) grid.sync(); } while (0)
    if (IN(0)) { phase_prologue(C); if ((DUP >> 12) & 1) { grid.sync(); phase_prologue(C); } if ((DUP >> 13) & 1) { for (int i = 0; i < 16; ++i) xcd_barrier(bar); } } SEAM(0);
    layer_phases<0>(C, bar, lo, hi);
    layer_phases<1>(C, bar, lo, hi);
    if (IN(25)) phase_rms<2>(C, C.in[18], 0, 0.5f);
#undef IN
#undef SEAM
}

extern "C" void kernel_launch(void* const* d_in, const int* in_sizes, int n_in, void* d_out, int out_size, void* d_ws, size_t ws_size, hipStream_t stream) {
    static int grid = 0;
    if (grid == 0) {
        if (n_in != 19 || (size_t)out_size != O_END || ws_size < WS_PART + 8 * MiB) { fprintf(stderr, "kernel_launch: unexpected problem (n_in %d out %d ws %zu)\n", n_in, out_size, ws_size); grid = -1; return; }
        int dev = 0, cus = 0, per_cu = 0;
        hipGetDevice(&dev); hipDeviceGetAttribute(&cus, hipDeviceAttributeMultiprocessorCount, dev);
        if (hipFuncSetAttribute((const void*)fwd_megakernel, hipFuncAttributeMaxDynamicSharedMemorySize, LDS_BYTES) != hipSuccess) { fprintf(stderr, "kernel_launch: hipFuncSetAttribute failed\n"); grid = -1; return; }
        if (hipOccupancyMaxActiveBlocksPerMultiprocessor(&per_cu, (const void*)fwd_megakernel, NTHR, LDS_BYTES) != hipSuccess || per_cu < 1) { fprintf(stderr, "kernel_launch: occupancy query says %d\n", per_cu); per_cu = 1; }
        (void)hipGetLastError();
        grid = cus * 1;
        if (grid <= 0) grid = 256;
    }
    if (grid < 0) return;
    Params p{};
    for (int i = 0; i < 19; ++i) p.in[i] = (const float*)d_in[i];
    p.out = (float*)d_out; p.ws = (unsigned char*)d_ws;
#if ONE_LAUNCH
    if (hipMemsetAsync((char*)d_ws + WS_CTL, 0, 65536, stream) != hipSuccess) { fprintf(stderr, "kernel_launch: memset of the barrier words failed\n"); return; }
    p.ph_lo = 0; p.ph_hi = 26;
    void* args[] = {&p};
    hipError_t e = hipLaunchCooperativeKernel((const void*)fwd_megakernel, dim3(grid), dim3(NTHR), args, LDS_BYTES, stream);
    if (e != hipSuccess) fprintf(stderr, "cooperative launch failed: %s (grid %d)\n", hipGetErrorString(e), grid);
#else
    for (int ph = 0; ph < 26; ++ph) { p.ph_lo = ph; p.ph_hi = ph + 1; hipLaunchKernelGGL(fwd_megakernel, dim3(grid), dim3(NTHR), LDS_BYTES, stream, p); }
#endif
}
```

```cpp
#include <hip/hip_runtime.h>
#include <hip/hip_cooperative_groups.h>
#include <cstdio>
#include <cstdint>
namespace cg = cooperative_groups;

#ifndef DUP
#define DUP 0
#endif
#ifndef ONE_LAUNCH
#define ONE_LAUNCH 1
#endif

constexpr int DM = 1024, SEQ = 8192, NB = 2, DEC_B = 32, DEC_T = 16, PAST = 2048;
constexpr int MP = NB * SEQ, MS = DEC_B * DEC_T, MT = MP + MS;
constexpr int DFF = 2816, NIN_RAW = 3592, NIN = 3584;
constexpr int SKV = PAST + DEC_T;
constexpr float RMS_EPS = 1e-6f;
constexpr float LOG2E = 1.4426950408889634f;
constexpr float QSCALE = 0.125f * LOG2E;
constexpr size_t O_YP = 0, O_YS = 16777216, O_KP = 17301504, O_VP = 34078720, O_LFP = 50855936, O_HSP = 51118080,
                 O_KS = 51380224, O_VS = 51904512, O_LFS = 52428800, O_HSS = 52436992, O_END = 56631296;
constexpr size_t MiB = 1u << 20;
constexpr size_t WS_CTL = 0, WS_WFG = 1 * MiB, WS_LB = 1 * MiB + 65536, WS_KTN = 1 * MiB + 131072, WS_G = 2 * MiB, WS_CP = 3 * MiB, WS_CS = 4 * MiB;
constexpr size_t WS_W1T = 8 * MiB, WS_W2T = 52 * MiB, WS_WINT = 74 * MiB, WS_WOT = 88 * MiB;
constexpr size_t WS_X = 92 * MiB, WS_HN = 158 * MiB, WS_ACT = 192 * MiB, WS_QB = 284 * MiB, WS_KB = 301 * MiB, WS_VB = 318 * MiB;
constexpr size_t WS_HF = 336 * MiB, WS_HB = 376 * MiB, WS_MIX = 468 * MiB, WS_US = 502 * MiB, WS_END = 566 * MiB, WS_PART = 760 * MiB;
constexpr size_t W1T_SZ = (size_t)2 * DFF * DM, W2T_SZ = (size_t)DM * DFF, WINT_SZ = (size_t)NIN * DM, WOT_SZ = (size_t)DM * DM;

#define LAS __attribute__((address_space(3)))
typedef unsigned short bf16;
typedef short bf16x8 __attribute__((ext_vector_type(8)));
typedef float f32x4 __attribute__((ext_vector_type(4)));
typedef float f32x2 __attribute__((ext_vector_type(2)));
typedef unsigned v4u __attribute__((ext_vector_type(4)));
typedef unsigned v2u __attribute__((ext_vector_type(2)));
typedef __bf16 bf16x2_t __attribute__((ext_vector_type(2)));
__device__ __forceinline__ unsigned pk2(float lo, float hi) { f32x2 v = {lo, hi}; bf16x2_t b = __builtin_convertvector(v, bf16x2_t); return __builtin_bit_cast(unsigned, b); }
__device__ __forceinline__ bf16 f2bf(float f) { return (bf16)(pk2(f, 0.f) & 0xffffu); }
__device__ __forceinline__ float bf2f(bf16 h) { return __builtin_bit_cast(float, (unsigned)h << 16); }
__device__ __forceinline__ float fast_exp2(float x) { return __builtin_amdgcn_exp2f(x); }
__device__ __forceinline__ float sigmoidf_(float x) { return 1.0f / (1.0f + __expf(-x)); }
__device__ __forceinline__ float siluf_(float x) { return x / (1.0f + __expf(-x)); }
__device__ __forceinline__ float log_sigmoidf_(float x) { return fminf(x, 0.f) - log1pf(expf(-fabsf(x))); }
#define LDS_WAIT() asm volatile("s_waitcnt lgkmcnt(0)" ::: "memory")

namespace pg8 {
#define PG8_LAS __attribute__((address_space(3)))
typedef unsigned short bf16_t;
typedef short bf16x8 __attribute__((ext_vector_type(8)));
typedef float f32x4 __attribute__((ext_vector_type(4)));
typedef unsigned u32x4 __attribute__((ext_vector_type(4)));
constexpr int BM = 256, BK = 64, HALF = 128, HTB = HALF * BK * 2  , STAGE_BYTES = 8 * HTB, NXCD = 8, WGM = 8;

__host__ __device__ __forceinline__ int lds_byte(int r, int c) { const int st = (r >> 4) * 2 + (c >> 5), rr = r & 15, cc = c & 31, ob = rr * 64 + cc * 2; return st * 1024 + (ob ^ (((ob >> 9) & 1) << 5)); }
__host__ __device__ __forceinline__ void stage_rc(int b, int& R, int& C) { const int st = b / 1024, sb = b % 1024, swz = sb ^ (((sb >> 9) & 1) << 5); R = (st >> 1) * 16 + swz / 64; C = (st & 1) * 32 + (swz % 64) / 2; }
__host__ __device__ __forceinline__ int perm32(int rho) { const int n = rho >> 4, i = rho & 15; return 8 * (i >> 2) + 4 * n + (i & 3); }

struct Unit { int pm, pn, k0, nt; };
struct Gemm { const bf16_t* A; const bf16_t* Bt; int M, N, K; };

struct StaticOrder {
    int nM, nN, nwg, G, c;
    __host__ __device__ __forceinline__ void init(int M, int N, int G_, int c_) { nM = M / BM; nN = N / BM; nwg = nM * nN; G = G_; c = c_; }
    __host__ __device__ __forceinline__ bool next(int i, Unit& u) const {
        u.pm = 0; u.pn = 0; u.k0 = 0; u.nt = 0;
        const long L = (long)i * G + c; if (L >= nwg) return false;
        int wgid = (int)L; { const int q = nwg / NXCD, r = nwg % NXCD, xcd = wgid % NXCD, off = wgid / NXCD; wgid = (xcd < r ? xcd * (q + 1) : r * (q + 1) + (xcd - r) * q) + off; }
        const int nig = WGM * nN, gid = wgid / nig, fm = gid * WGM, gsz = (nM - fm) < WGM ? (nM - fm) : WGM;
        u.pm = fm + ((wgid % nig) % gsz); u.pn = (wgid % nig) / gsz; u.k0 = 0; u.nt = 0; return true;
    }
    __device__ __forceinline__ void a_ready(const Unit&) const {}
    __device__ __forceinline__ void done(const Unit&) const {}
};

struct SplitOrder {
    StaticOrder base; int R, G, c, ntf;
    __host__ __device__ __forceinline__ void init(int Mprompt, int N, int G_, int c_, int ntf_) { base.init(Mprompt, N, G_, c_); G = G_; c = c_; ntf = ntf_; R = (base.nwg + G - 1) / G; }
    __host__ __device__ __forceinline__ bool next(int i, Unit& u) const {
        if (i < R) { if (base.next(i, u)) return true; }
        const int idle = R * G - base.nwg;
        const int j = (i < R) ? (c - (G - idle)) : ((i - R) * G + c + idle);
        if (i < R - 1 || j < 0 || j >= 32) return false;
        const int us = j >> 2, p = j & 3, bs = (ntf / 4) & ~1, rem2 = (ntf - 4 * bs) / 2;
        u.pm = base.nM + (us >> 2); u.pn = us & 3; u.nt = (bs + (p < rem2 ? 2 : 0)) | (p << 16); u.k0 = p * bs + 2 * (p < rem2 ? p : rem2); return true;
    }
    __device__ __forceinline__ void a_ready(const Unit&) const {}
    __device__ __forceinline__ void done(const Unit&) const {}
};

struct EpiSwiglu {
    static constexpr bool PERM = true, AFTER_DRAIN = false;
    bf16_t* O;
    __device__ __forceinline__ void operator()(const f32x4 (&acc)[2][2][4][2], const Unit& u, int wr, int wc, int fr, int fq) const {
        const int row0 = u.pm * BM + wr * 64 + fr, col0 = u.pn * 128 + wc * 32 + 8 * fq;
#pragma unroll
        for (int ai = 0; ai < 2; ++ai)
#pragma unroll
            for (int m = 0; m < 4; ++m) {
                const f32x4 a0 = acc[ai][0][m][0], a1 = acc[ai][0][m][1], b0 = acc[ai][1][m][0], b1 = acc[ai][1][m][1];
                u32x4 w;
                w.x = ::pk2(::siluf_(a0[0]) * b0[0], ::siluf_(a0[1]) * b0[1]); w.y = ::pk2(::siluf_(a0[2]) * b0[2], ::siluf_(a0[3]) * b0[3]);
                w.z = ::pk2(::siluf_(a1[0]) * b1[0], ::siluf_(a1[1]) * b1[1]); w.w = ::pk2(::siluf_(a1[2]) * b1[2], ::siluf_(a1[3]) * b1[3]);
                *(u32x4*)(O + (size_t)(row0 + ai * HALF + m * 16) * ::DFF + col0) = w;
            }
    }
};
struct EpiRes {
    static constexpr bool PERM = false, AFTER_DRAIN = false;
    float* X; const float* BASE; float* PART; float scale;
    __device__ __forceinline__ void operator()(const f32x4 (&acc)[2][2][4][2], const Unit& u, int wr, int wc, int fr, int fq) const {
        const int row0 = u.pm * BM + wr * 64 + fr, col0 = u.pn * BM + wc * 32 + 4 * fq;
        float* base = u.nt ? PART + (ptrdiff_t)((u.nt >> 16) * ::MS - ::MP) * ::DM : X; const ptrdiff_t boff = BASE - X;
#pragma unroll
        for (int ai = 0; ai < 2; ++ai)
#pragma unroll
            for (int m = 0; m < 4; ++m) { float* rowp = base + (size_t)(row0 + ai * HALF + m * 16) * ::DM + col0;
#pragma unroll
                for (int bj = 0; bj < 2; ++bj)
#pragma unroll
                    for (int n = 0; n < 2; ++n) { f32x4* p = (f32x4*)(rowp + bj * HALF + n * 16);
                        if (u.nt) *p = acc[ai][bj][m][n]; else *p = *(const f32x4*)((const float*)p + boff) + acc[ai][bj][m][n] * scale; } }
    }
};
struct EpiInProj {
    static constexpr bool PERM = true, AFTER_DRAIN = false;
    bf16_t *Q, *K, *V; float* HF; bf16_t* HB; float* out; int l;
    __device__ __forceinline__ void operator()(const f32x4 (&acc)[2][2][4][2], const Unit& u, int wr, int wc, int fr, int fq) const {
        const int seg = u.pn >> 1, cbase = (u.pn & 1) * 256 + wc * 32 + 8 * fq, row0 = u.pm * BM + wr * 64 + fr;
#pragma unroll
        for (int ai = 0; ai < 2; ++ai)
#pragma unroll
            for (int m = 0; m < 4; ++m) { const int row = row0 + ai * HALF + m * 16;
#pragma unroll
                for (int bj = 0; bj < 2; ++bj) { const int cs = cbase + bj * HALF; f32x4 v0 = acc[ai][bj][m][0], v1 = acc[ai][bj][m][1];
                    if (seg == 0) { v0 = v0 * ::QSCALE; v1 = v1 * ::QSCALE; u32x4 w; w.x = ::pk2(v0[0], v0[1]); w.y = ::pk2(v0[2], v0[3]); w.z = ::pk2(v1[0], v1[1]); w.w = ::pk2(v1[2], v1[3]);
                        *(u32x4*)(Q + (size_t)row * 512 + cs) = w; }
                    else if (seg <= 2) { u32x4 w; w.x = ::pk2(v0[0], v0[1]); w.y = ::pk2(v0[2], v0[3]); w.z = ::pk2(v1[0], v1[1]); w.w = ::pk2(v1[2], v1[3]);
                        *(u32x4*)((seg == 1 ? K : V) + (size_t)row * 512 + cs) = w;
                        const int head = cs >> 6, d = cs & 63; size_t o;
                        if (row < ::MP) { const int b = row >> 13, t = row & 8191; o = (seg == 1 ? ::O_KP : ::O_VP) + ((((size_t)l * 2 + b) * 8 + head) * 8192 + t) * 64 + d; }
                        else { const int rs = row - ::MP, b = rs >> 4, t = rs & 15; o = (seg == 1 ? ::O_KS : ::O_VS) + ((((size_t)l * 32 + b) * 8 + head) * 16 + t) * 64 + d; }
                        *(f32x4*)(out + o) = v0; *(f32x4*)(out + o + 4) = v1; }
                    else if (seg == 4) { float* hp = HF + (size_t)row * 512 + cs; *(f32x4*)hp = v0; *(f32x4*)(hp + 4) = v1; }
                    else { if (seg == 3) { v0 = (f32x4){::siluf_(v0[0]), ::siluf_(v0[1]), ::siluf_(v0[2]), ::siluf_(v0[3])}; v1 = (f32x4){::siluf_(v1[0]), ::siluf_(v1[1]), ::siluf_(v1[2]), ::siluf_(v1[3])}; }
                        u32x4 w; w.x = ::pk2(v0[0], v0[1]); w.y = ::pk2(v0[2], v0[3]); w.z = ::pk2(v1[0], v1[1]); w.w = ::pk2(v1[2], v1[3]);
                        *(u32x4*)(HB + (size_t)row * 1536 + (seg == 3 ? 0 : (seg == 5 ? 512 : 1024)) + cs) = w; }
                } }
    }
};
template <class Epi, class Sched, bool ALIGN_EPI = false, bool SP2 = false>
__device__ __forceinline__ void gemm_phase(PG8_LAS unsigned char* lds, const Gemm g, const Sched& S, const Epi& E) {
    const int tid = threadIdx.x, wid = __builtin_amdgcn_readfirstlane(tid >> 6), lane = tid & 63, wr = wid >> 2, wc = wid & 3, fr = lane & 15, fq = lane >> 4;
    const int K = g.K, ntf = K / BK;
    unsigned voffA[2], voffB[2];
#pragma unroll
    for (int i = 0; i < 2; ++i) { int R, C; stage_rc(tid * 16 + i * 8192, R, C); const int Rb = Epi::PERM ? ((R & ~31) + perm32(R & 31)) : R;
        voffA[i] = (unsigned)(R * K + C) * 2u; voffB[i] = (unsigned)(Rb * K + C) * 2u; }
    const size_t kstep = (size_t)(BK * 2);
    const size_t hstep = (size_t)HALF * K * 2;
    const size_t tstep = 2 * hstep;
    const unsigned ldsw = (unsigned)wid * 1024u;
    const int aoff = lds_byte(wr * 64 + fr, fq * 8), boff = lds_byte(wc * 32 + fr, fq * 8);
#define PG8_SA(b, h) (((b) * 2 + (h)) * HTB)
#define PG8_SB(b, h) ((4 + (b) * 2 + (h)) * HTB)
#define PG8_STAGE(bufoff, gbase, voff) do { _Pragma("unroll") for (int _i = 0; _i < 2; ++_i) \
        __builtin_amdgcn_global_load_lds((const unsigned*)((const char*)(gbase) + (voff)[_i]), (PG8_LAS unsigned*)(lds + (bufoff) + ldsw + _i * 8192), 16, 0, 0); } while (0)
#define PG8_LDA(dst, b, h) do { _Pragma("unroll") for (int m = 0; m < 4; ++m) _Pragma("unroll") for (int k = 0; k < 2; ++k) dst[m][k] = *(const PG8_LAS bf16x8*)(lds + PG8_SA(b, h) + aoff + m * 2048 + k * 1024); } while (0)
#define PG8_LDB(dst, b, h) do { _Pragma("unroll") for (int n = 0; n < 2; ++n) _Pragma("unroll") for (int k = 0; k < 2; ++k) dst[n][k] = *(const PG8_LAS bf16x8*)(lds + PG8_SB(b, h) + boff + n * 2048 + k * 1024); } while (0)
#define PG8_MMA(ai, bj, At, Bt) do { __builtin_amdgcn_s_setprio(1); _Pragma("unroll") for (int m = 0; m < 4; ++m) _Pragma("unroll") for (int n = 0; n < 2; ++n) _Pragma("unroll") for (int k = 0; k < 2; ++k) \
        acc[ai][bj][m][n] = __builtin_amdgcn_mfma_f32_16x16x32_bf16(Bt[n][k], At[m][k], acc[ai][bj][m][n], 0, 0, 0); __builtin_amdgcn_s_setprio(0); } while (0)
#define PG8_WAIT_V(n) asm volatile("s_waitcnt vmcnt(" #n ")" ::: "memory")
#define PG8_WAIT_L(n) asm volatile("s_waitcnt lgkmcnt(" #n ")" ::: "memory")
#define PG8_BAR __builtin_amdgcn_s_barrier()
#define PG8_SCHED __builtin_amdgcn_sched_barrier(0)
    Unit cur{0, 0, 0, 0}, nxt{0, 0, 0, 0}; int ui = 0;
    if (!S.next(0, cur)) return;
    f32x4 acc[2][2][4][2];
#pragma unroll
    for (int a = 0; a < 2; ++a)
#pragma unroll
        for (int b = 0; b < 2; ++b)
#pragma unroll
            for (int m = 0; m < 4; ++m)
#pragma unroll
                for (int n = 0; n < 2; ++n) acc[a][b][m][n] = (f32x4){0.f, 0.f, 0.f, 0.f};
    bf16x8 At[4][2], B0[2][2], B1[2][2];
    const char* cA = (const char*)g.A + (size_t)cur.pm * tstep + (size_t)cur.k0 * kstep; const char* cB = (const char*)g.Bt + (size_t)cur.pn * tstep + (size_t)cur.k0 * kstep; int nt = cur.nt ? (cur.nt & 0xffff) : ntf;
    S.a_ready(cur);
    if constexpr (SP2) {
        PG8_STAGE(PG8_SB(0, 0), cB, voffB); PG8_STAGE(PG8_SB(0, 1), cB + hstep, voffB); PG8_STAGE(PG8_SA(0, 0), cA, voffA); PG8_STAGE(PG8_SA(0, 1), cA + hstep, voffA);
        if (wr == 1) PG8_BAR;
        PG8_WAIT_V(2); PG8_BAR;
        PG8_STAGE(PG8_SB(1, 0), cB + kstep, voffB); PG8_STAGE(PG8_SA(1, 0), cA + kstep, voffA); PG8_STAGE(PG8_SB(1, 1), cB + hstep + kstep, voffB);
        PG8_WAIT_V(6); PG8_BAR;
    } else {
        PG8_STAGE(PG8_SB(0, 0), cB, voffB); PG8_STAGE(PG8_SA(0, 0), cA, voffA); PG8_STAGE(PG8_SB(0, 1), cB + hstep, voffB); PG8_STAGE(PG8_SA(0, 1), cA + hstep, voffA);
        if (wr == 1) PG8_BAR;
        PG8_WAIT_V(4); PG8_BAR;
        PG8_STAGE(PG8_SB(1, 0), cB + kstep, voffB); PG8_STAGE(PG8_SA(1, 0), cA + kstep, voffA); PG8_STAGE(PG8_SB(1, 1), cB + hstep + kstep, voffB);
        PG8_WAIT_V(6); PG8_BAR;
    }
    for (;;) {
        const bool has_next = S.next(ui + 1, nxt);
        const char* nA = has_next ? (const char*)g.A + (size_t)nxt.pm * tstep + (size_t)nxt.k0 * kstep : cA; const char* nB = has_next ? (const char*)g.Bt + (size_t)nxt.pn * tstep + (size_t)nxt.k0 * kstep : cB;
        for (int t = 0; t < nt; t += 2) {
            const bool last = (t == nt - 2);
            const char* a1 = cA + (size_t)(t + 1) * kstep;
            const char* a2 = last ? nA : cA + (size_t)(t + 2) * kstep; const char* b2 = last ? nB : cB + (size_t)(t + 2) * kstep;
            const char* a3 = a2 + kstep; const char* b3 = b2 + kstep;
            if (last && has_next) S.a_ready(nxt);
            if constexpr (SP2) {
            PG8_LDB(B0, 0, 0); PG8_LDB(B1, 0, 1); PG8_SCHED; PG8_LDA(At, 0, 0); PG8_STAGE(PG8_SA(1, 1), a1 + hstep, voffA);
            PG8_WAIT_V(8); PG8_WAIT_L(0); PG8_BAR; PG8_MMA(0, 0, At, B0); PG8_MMA(0, 1, At, B1); PG8_BAR; PG8_SCHED;
            PG8_LDA(At, 0, 1); PG8_STAGE(PG8_SB(0, 0), b2, voffB); PG8_STAGE(PG8_SB(0, 1), b2 + hstep, voffB); PG8_STAGE(PG8_SA(0, 0), a2, voffA);
            PG8_WAIT_V(8); PG8_WAIT_L(0); PG8_BAR; PG8_MMA(1, 0, At, B0); PG8_MMA(1, 1, At, B1); PG8_BAR; PG8_SCHED;
            PG8_LDB(B0, 1, 0); PG8_LDB(B1, 1, 1); PG8_SCHED; PG8_LDA(At, 1, 0); PG8_STAGE(PG8_SA(0, 1), a2 + hstep, voffA);
            PG8_WAIT_V(8); PG8_WAIT_L(0); PG8_BAR; PG8_MMA(0, 0, At, B0); PG8_MMA(0, 1, At, B1); PG8_BAR; PG8_SCHED;
            PG8_LDA(At, 1, 1); PG8_STAGE(PG8_SB(1, 0), b3, voffB); PG8_STAGE(PG8_SB(1, 1), b3 + hstep, voffB); PG8_STAGE(PG8_SA(1, 0), a3, voffA);
            PG8_WAIT_V(8); PG8_WAIT_L(0); PG8_BAR; PG8_MMA(1, 0, At, B0); PG8_MMA(1, 1, At, B1); PG8_BAR; PG8_SCHED;
            } else {
            PG8_LDB(B0, 0, 0); PG8_SCHED; PG8_LDA(At, 0, 0); PG8_STAGE(PG8_SA(1, 1), a1 + hstep, voffA);
            PG8_WAIT_L(8); PG8_BAR; PG8_WAIT_L(0); PG8_MMA(0, 0, At, B0); PG8_BAR; PG8_SCHED;
            PG8_LDB(B1, 0, 1); PG8_STAGE(PG8_SB(0, 0), b2, voffB);
            PG8_BAR; PG8_WAIT_L(0); PG8_MMA(0, 1, At, B1); PG8_BAR;
            PG8_LDA(At, 0, 1); PG8_STAGE(PG8_SA(0, 0), a2, voffA);
            PG8_BAR; PG8_WAIT_L(0); PG8_MMA(1, 0, At, B0); PG8_BAR; PG8_SCHED;
            PG8_STAGE(PG8_SB(0, 1), b2 + hstep, voffB);
            PG8_WAIT_V(6); PG8_BAR; PG8_MMA(1, 1, At, B1); PG8_BAR;
            PG8_LDB(B0, 1, 0); PG8_SCHED; PG8_LDA(At, 1, 0); PG8_STAGE(PG8_SA(0, 1), a2 + hstep, voffA);
            PG8_WAIT_L(8); PG8_BAR; PG8_WAIT_L(0); PG8_MMA(0, 0, At, B0); PG8_BAR; PG8_SCHED;
            PG8_LDB(B1, 1, 1); PG8_STAGE(PG8_SB(1, 0), b3, voffB);
            PG8_BAR; PG8_WAIT_L(0); PG8_MMA(0, 1, At, B1); PG8_BAR;
            PG8_LDA(At, 1, 1); PG8_STAGE(PG8_SA(1, 0), a3, voffA);
            PG8_BAR; PG8_WAIT_L(0); PG8_MMA(1, 0, At, B0); PG8_BAR; PG8_SCHED;
            PG8_STAGE(PG8_SB(1, 1), b3 + hstep, voffB);
            PG8_WAIT_V(6); PG8_BAR; PG8_MMA(1, 1, At, B1); PG8_BAR;
            }
        }
        if constexpr (ALIGN_EPI) { if (wr == 0) PG8_BAR; }
        if constexpr (!Epi::AFTER_DRAIN) { E(acc, cur, wr, wc, fr, fq); S.done(cur); }
        if (!has_next) break;
#pragma unroll
        for (int a = 0; a < 2; ++a)
#pragma unroll
            for (int b = 0; b < 2; ++b)
#pragma unroll
                for (int m = 0; m < 4; ++m)
#pragma unroll
                    for (int n = 0; n < 2; ++n) acc[a][b][m][n] = (f32x4){0.f, 0.f, 0.f, 0.f};
        cur = nxt; cA = nA; cB = nB; ++ui; nt = cur.nt ? (cur.nt & 0xffff) : ntf;
        if constexpr (ALIGN_EPI) { if (wr == 1) PG8_BAR; }
    }
    PG8_WAIT_V(0);
    if constexpr (!ALIGN_EPI) { if (wr == 0) PG8_BAR; }
    PG8_BAR;
    if constexpr (Epi::AFTER_DRAIN) { E.fused(acc, cur, wr, wc, fr, fq, lds, wid, lane); S.done(cur); }
#undef PG8_SA
#undef PG8_SB
#undef PG8_STAGE
#undef PG8_LDA
#undef PG8_LDB
#undef PG8_MMA
#undef PG8_WAIT_V
#undef PG8_WAIT_L
#undef PG8_BAR
#undef PG8_SCHED
}
}

constexpr int NWAVES = 8, NTHR = 512;
constexpr int RING_BYTES = 131072, LDS_BYTES = 147456;
struct Params { const float* in[19]; float* out; unsigned char* ws; int ph_lo, ph_hi; };

struct Ctx {
    LAS unsigned char* lds;
    int tid, lane, wave, G, bid;
    const float* in[19]; float* out; unsigned char* ws;
};
#define CTX_GW(C) ((C).bid * NWAVES + (C).wave)
#define CTX_NGW(C) ((C).G * NWAVES)

__device__ __forceinline__ float wave_sum(float v) {
#pragma unroll
    for (int o = 1; o < 64; o <<= 1) v += __shfl_xor(v, o);
    return v;
}
__device__ __forceinline__ float wave_max(float v) {
#pragma unroll
    for (int o = 1; o < 64; o <<= 1) v = fmaxf(v, __shfl_xor(v, o));
    return v;
}
__device__ __forceinline__ f32x4 mfma16(bf16x8 a, bf16x8 b, f32x4 c) { return __builtin_amdgcn_mfma_f32_16x16x32_bf16(a, b, c, 0, 0, 0); }

__device__ __forceinline__ void transpose_item(const float* W, int K, int N, int srccol0, bf16* WT, int dstrow0, int k0, LAS float* scr, int lane) {
#pragma unroll 8
    for (int i = 0; i < 32; ++i) { const int kk = 2 * i + (lane >> 5); scr[kk * 33 + (lane & 31)] = W[(size_t)(k0 + kk) * N + srccol0 + (lane & 31)]; }
    LDS_WAIT();
    const int c = lane & 7;
#pragma unroll
    for (int j = 0; j < 4; ++j) { const int n = (lane >> 3) + 8 * j; const LAS float* s = scr + (8 * c) * 33 + n;
        v4u o; o.x = pk2(s[0 * 33], s[1 * 33]); o.y = pk2(s[2 * 33], s[3 * 33]); o.z = pk2(s[4 * 33], s[5 * 33]); o.w = pk2(s[6 * 33], s[7 * 33]);
        *(v4u*)(WT + (size_t)(dstrow0 + n) * K + k0 + 8 * c) = o; }
    LDS_WAIT();
}
__device__ __forceinline__ void phase_prologue(Ctx& C) {
    LAS float* scr = (LAS float*)(C.lds + C.wave * 16384);
    const int gw = CTX_GW(C), NGW = CTX_NGW(C);
    constexpr int I_UP = 16 * 176, I_DN = 44 * 32, I_IN = 16 * 112, I_OUT = 16 * 32, I_LAYER = 2 * I_UP + 2 * I_DN + I_IN + I_OUT;
    for (int it = gw; it < 2 * I_LAYER; it += NGW) {
        const int l = it / I_LAYER; int r = it % I_LAYER;
        int which;
        if (r < I_UP) which = 0; else if ((r -= I_UP) < I_DN) which = 1; else if ((r -= I_DN) < I_IN) which = 2; else if ((r -= I_IN) < I_OUT) which = 3; else if ((r -= I_OUT) < I_UP) which = 4; else { r -= I_UP; which = 5; }
        if (which == 0 || which == 4) {
            const int nb = r % 176, kb = r / 176, d0 = nb * 32, pn = d0 >> 8, w = d0 & 255;
            const int src = (w < 128) ? (128 * pn + w) : (DFF + 128 * pn + (w - 128));
            const float* W = C.in[which == 0 ? 7 : 16] + (size_t)l * DM * 2 * DFF;
            bf16* WT = (bf16*)(C.ws + WS_W1T) + (size_t)(l * 2 + (which == 4)) * W1T_SZ;
            transpose_item(W, DM, 2 * DFF, src, WT, d0, kb * 64, scr, C.lane);
        } else if (which == 1 || which == 5) {
            const int nb = r % 32, kb = r / 32;
            const float* W = C.in[which == 1 ? 8 : 17] + (size_t)l * DFF * DM;
            bf16* WT = (bf16*)(C.ws + WS_W2T) + (size_t)(l * 2 + (which == 5)) * W2T_SZ;
            transpose_item(W, DFF, DM, nb * 32, WT, nb * 32, kb * 64, scr, C.lane);
        } else if (which == 2) {
            const int nb = r % 112, kb = r / 112, d0 = nb * 32, src = d0 < 1536 ? d0 : d0 + 8;
            transpose_item(C.in[10] + (size_t)l * DM * NIN_RAW, DM, NIN_RAW, src, (bf16*)(C.ws + WS_WINT) + (size_t)l * WINT_SZ, d0, kb * 64, scr, C.lane);
        } else {
            const int nb = r % 32, kb = r / 32;
            transpose_item(C.in[14] + (size_t)l * DM * DM, DM, DM, nb * 32, (bf16*)(C.ws + WS_WOT) + (size_t)l * WOT_SZ, nb * 32, kb * 64, scr, C.lane);
        }
    }
    const int gt = C.bid * NTHR + C.tid, NGT = C.G * NTHR;
    float* WFG = (float*)(C.ws + WS_WFG);
    for (int i = gt; i < 2 * 8 * DM; i += NGT) { const int l = i >> 13, j = (i >> 10) & 7, k = i & 1023; WFG[i] = C.in[10][((size_t)l * DM + k) * NIN_RAW + 1536 + j]; }
    float* LB = (float*)(C.ws + WS_LB);
    for (int i = gt; i < 512; i += NGT) { const float p0 = C.in[12][i], p1 = C.in[12][512 + i], mx = fmaxf(p0, p1), e0 = expf(p0 - mx), e1 = expf(p1 - mx);
        LB[i] = 0.f; LB[512 + i] = e1 / (e0 + e1); }
}

template <int MODE> __device__ __forceinline__ void phase_rms(Ctx& C, const float* g, int l, float pend, int src) {
    const int gw = CTX_GW(C), NGW = CTX_NGW(C), lane = C.lane;
    float* X = (float*)(C.ws + WS_X); bf16* HN = (bf16*)(C.ws + WS_HN); const float* PART = (const float*)(C.ws + WS_PART);
    f32x4 gv[4];
#pragma unroll
    for (int j = 0; j < 4; ++j) gv[j] = ((const f32x4*)g)[lane + 64 * j];
    for (int row = gw; row < MT; row += NGW) {
        const float* xrow = X + (size_t)row * DM;
        if (src == 1 && row < MP) xrow = C.in[0] + (size_t)row * DM;
        if (src != 0 && row >= MP) xrow = C.in[1] + (size_t)(row - MP) * DM;
        const f32x4* xr = (const f32x4*)xrow + lane;
        f32x4 v[4]; float s = 0.f;
#pragma unroll
        for (int j = 0; j < 4; ++j) v[j] = xr[64 * j];
        if (pend != 0.f && row >= MP) {
#pragma unroll
            for (int j = 0; j < 4; ++j) { const f32x4* pp = (const f32x4*)(PART + (size_t)(row - MP) * DM) + lane + 64 * j;
                v[j] = v[j] + ((pp[0] + pp[MS * DM / 4]) + (pp[2 * MS * DM / 4] + pp[3 * MS * DM / 4])) * pend;
                ((f32x4*)(X + (size_t)row * DM))[lane + 64 * j] = v[j]; } }
#pragma unroll
        for (int j = 0; j < 4; ++j) s += (v[j].x * v[j].x + v[j].y * v[j].y) + (v[j].z * v[j].z + v[j].w * v[j].w);
        const float rstd = 1.0f / sqrtf(wave_sum(s) * (1.0f / DM) + RMS_EPS);
#pragma unroll
        for (int j = 0; j < 4; ++j) v[j] = v[j] * rstd * gv[j];
        if (MODE == 2) {
            float* o = C.out + (row < MP ? O_YP + (size_t)row * DM : O_YS + (size_t)(row - MP) * DM);
#pragma unroll
            for (int j = 0; j < 4; ++j) ((f32x4*)o)[lane + 64 * j] = v[j];
        } else {
            v2u* o8 = (v2u*)(HN + (size_t)row * DM) + lane;
#pragma unroll
            for (int j = 0; j < 4; ++j) { v2u w; w.x = pk2(v[j].x, v[j].y); w.y = pk2(v[j].z, v[j].w); o8[64 * j] = w; }
        }
        if (MODE == 1) {
            const float* WFG = (const float*)(C.ws + WS_WFG) + (size_t)l * 8 * DM;
            float fg[8];
#pragma unroll
            for (int jj = 0; jj < 8; ++jj) { float a = 0.f;
#pragma unroll
                for (int j = 0; j < 4; ++j) { const f32x4 w = ((const f32x4*)(WFG + jj * DM))[lane + 64 * j]; a += (v[j].x * w.x + v[j].y * w.y) + (v[j].z * w.z + v[j].w * w.w); }
                fg[jj] = wave_sum(a); }
            float mine = fg[0];
#pragma unroll
            for (int jj = 1; jj < 8; ++jj) mine = (lane == jj) ? fg[jj] : mine;
            if (lane < 8) { const float lf = log_sigmoidf_(mine + C.in[11][l * 8 + lane]);
                size_t o;
                if (row < MP) { const int b = row >> 13, t = row & 8191; o = O_LFP + (((size_t)l * 2 + b) * 8 + lane) * 8192 + t; }
                else { const int rs = row - MP, b = rs >> 4, t = rs & 15; o = O_LFS + (((size_t)l * 32 + b) * 8 + lane) * 16 + t; }
                C.out[o] = lf; }
        }
    }
}

constexpr int HL_LF = 0, HL_SEG = 32768, HL_QT = 34816, HL_KTL = HL_QT + 17408, HL_VT = HL_KTL + 17408, HL_ST = HL_VT + 18432, HL_AS = HL_ST + 34816, HL_KH = HL_AS + 9216, HL_END = HL_KH + 10240;
static_assert(HL_END <= LDS_BYTES - 1024, "HGRN LDS map");
constexpr int HP_Q = 136, HP_V = 72, HP_O = 132;

template <int CH> __device__ __forceinline__ void hgrn_decay_prefix(Ctx& C, const float* HF, int row0, int h, const float* lb) {
    LAS float* LF = (LAS float*)(C.lds + HL_LF); LAS float* SEG = (LAS float*)(C.lds + HL_SEG);
    const int tid = C.tid;
    for (int idx = tid; idx < CH * 128; idx += NTHR) { const int s = idx >> 7, d = idx & 127;
        const float z = HF[(size_t)(row0 + s) * 512 + h * 128 + d], lbv = lb[d];
        LF[idx] = (lbv == 0.f) ? log_sigmoidf_(z) : logf(lbv + (1.f - lbv) * sigmoidf_(z)); }
    __syncthreads();
    const int seg = tid >> 7, d = tid & 127; constexpr int R = CH / 4;
    float run = 0.f;
#pragma unroll
    for (int i = 0; i < R; ++i) { run += LF[(seg * R + i) * 128 + d]; LF[(seg * R + i) * 128 + d] = run; }
    SEG[seg * 128 + d] = run;
    __syncthreads();
    float off = 0.f;
#pragma unroll
    for (int s2 = 0; s2 < 3; ++s2) if (s2 < seg) off += SEG[s2 * 128 + d];
#pragma unroll
    for (int i = 0; i < R; ++i) LF[(seg * R + i) * 128 + d] += off;
    __syncthreads();
}

__device__ __forceinline__ void hgrn_local_unit(Ctx& C, int unit, int l) {
    const int bh = unit >> 7, c = unit & 127, b = bh >> 2, h = bh & 3, row0 = b * SEQ + c * 64;
    const float* HF = (const float*)(C.ws + WS_HF); const bf16* HB = (const bf16*)(C.ws + WS_HB); const float* lb = (const float*)(C.ws + WS_LB) + l * 512 + h * 128;
    hgrn_decay_prefix<64>(C, HF, row0, h, lb);
    LAS float* LF = (LAS float*)(C.lds + HL_LF);
    LAS bf16* KT = (LAS bf16*)(C.lds + HL_QT); LAS bf16* VT = (LAS bf16*)(C.lds + HL_VT);
    const int tid = C.tid;
    for (int idx = tid; idx < 64 * 128; idx += NTHR) { const int s = idx >> 7, d = idx & 127;
        const float z = HF[(size_t)(row0 + s) * 512 + h * 128 + d], v = bf2f(HB[(size_t)(row0 + s) * 1536 + 512 + h * 128 + d]), k = (1.f - lb[d]) * sigmoidf_(-z);
        KT[d * HP_V + s] = f2bf(k * __expf(LF[63 * 128 + d] - LF[idx])); VT[d * HP_V + s] = f2bf(v); }
    if (tid < 128) ((float*)(C.ws + WS_G))[(size_t)unit * 128 + tid] = __expf(LF[63 * 128 + tid]);
    __syncthreads();
    const int lane = C.lane, w = C.wave, r16 = lane & 15, quad = lane >> 4;
    f32x4 acc[8];
#pragma unroll
    for (int nb = 0; nb < 8; ++nb) acc[nb] = (f32x4){0.f, 0.f, 0.f, 0.f};
#pragma unroll
    for (int ks = 0; ks < 2; ++ks) { const bf16x8 a = *(const LAS bf16x8*)(VT + (w * 16 + r16) * HP_V + ks * 32 + quad * 8);
#pragma unroll
        for (int nb = 0; nb < 8; ++nb) { const bf16x8 bb = *(const LAS bf16x8*)(KT + (nb * 16 + r16) * HP_V + ks * 32 + quad * 8); acc[nb] = mfma16(a, bb, acc[nb]); } }
    float* US = (float*)(C.ws + WS_US) + (size_t)unit * 16384;
#pragma unroll
    for (int nb = 0; nb < 8; ++nb)
#pragma unroll
        for (int j = 0; j < 4; ++j) US[(w * 16 + quad * 4 + j) * 128 + nb * 16 + r16] = acc[nb][j];
    __syncthreads();
}

__device__ __forceinline__ void hgrn_scan(Ctx& C, int l, bool dummy = false) {
    float* US = (float*)(C.ws + WS_US); const size_t doff = dummy ? (WS_END - WS_US) / 4 : 0; const float* Gg = (const float*)(C.ws + WS_G);
    for (int e = C.bid * NTHR + C.tid; e < 8 * 16384; e += C.G * NTHR) {
        const int bh = e >> 14, el = e & 16383, dk = el & 127, dv = el >> 7;
        float* p = US + (size_t)bh * 128 * 16384 + el; const float* gp = Gg + (size_t)bh * 128 * 128 + dk;
        float s = 0.f;
        for (int c0 = 0; c0 < 128; c0 += 8) { float u[8], g[8];
#pragma unroll
            for (int i = 0; i < 8; ++i) { u[i] = p[(size_t)(c0 + i) * 16384]; g[i] = gp[(c0 + i) * 128]; }
#pragma unroll
            for (int i = 0; i < 8; ++i) { p[(size_t)(c0 + i) * 16384 + doff] = s; s = g[i] * s + u[i]; } }
        if (!dummy) C.out[O_HSP + ((size_t)l * 8 + bh) * 16384 + dk * 128 + dv] = s;
    }
}

template <int CH> __device__ __forceinline__ void hgrn_out_unit(Ctx& C, int unit, int l) {
    int row0, h, bh; const float* Ssrc;
    if (CH == 64) { bh = unit >> 7; const int c = unit & 127, b = bh >> 2; h = bh & 3; row0 = b * SEQ + c * 64; Ssrc = (const float*)(C.ws + WS_US) + (size_t)unit * 16384; }
    else { bh = unit; const int b = unit >> 2; h = unit & 3; row0 = MP + b * 16; Ssrc = C.in[5] + ((size_t)l * 128 + unit) * 16384; }
    const float* HF = (const float*)(C.ws + WS_HF); const bf16* HB = (const bf16*)(C.ws + WS_HB); const float* lb = (const float*)(C.ws + WS_LB) + l * 512 + h * 128;
    hgrn_decay_prefix<CH>(C, HF, row0, h, lb);
    LAS float* LF = (LAS float*)(C.lds + HL_LF);
    LAS bf16* QT = (LAS bf16*)(C.lds + HL_QT); LAS bf16* KTL = (LAS bf16*)(C.lds + HL_KTL); LAS bf16* VT = (LAS bf16*)(C.lds + HL_VT);
    LAS bf16* ST = (LAS bf16*)(C.lds + HL_ST); LAS bf16* AS = (LAS bf16*)(C.lds + HL_AS);
    LAS bf16* KH = (LAS bf16*)(C.lds + HL_KH);
    LAS float* BL = (LAS float*)(C.lds + HL_SEG);
    const int tid = C.tid; constexpr int MID = CH / 2, SP = (CH < 32) ? 32 : CH;
    if (CH == 16) {
        for (int i = tid; i < 128 * 16; i += NTHR) { const int d = i >> 4, s = 16 + (i & 15); VT[d * HP_V + s] = 0; KH[d * 40 + s] = 0; if (d < 16) AS[d * HP_V + s] = 0; }
    }
    for (int idx = tid; idx < CH * 128; idx += NTHR) { const int s = idx >> 7, d = idx & 127;
        const bf16* hb = HB + (size_t)(row0 + s) * 1536 + h * 128 + d;
        const float q = bf2f(hb[0]), z = HF[(size_t)(row0 + s) * 512 + h * 128 + d], v = bf2f(hb[512]), k = (1.f - lb[d]) * sigmoidf_(-z);
        const float bs = LF[idx], r = LF[MID * 128 + d];
        QT[s * HP_Q + d] = f2bf(q * __expf(fminf(bs - r, 80.f))); KTL[s * HP_Q + d] = f2bf(k * __expf(fminf(r - bs, 80.f))); VT[d * HP_V + s] = f2bf(v);
        if (CH == 16) { KH[d * 40 + s] = f2bf(k * __expf(LF[(CH - 1) * 128 + d] - bs)); if (s == CH - 1) BL[d] = bs; } }
    if (CH == 64) { for (int i = tid; i < 16384; i += NTHR) { const int dv = i >> 7, dk = i & 127; ST[dv * HP_Q + dk] = f2bf(Ssrc[i] * __expf(LF[MID * 128 + dk])); } }
    else { for (int i = tid; i < 16384; i += NTHR) { const int dk = i >> 7, dv = i & 127; ST[dv * HP_Q + dk] = f2bf(Ssrc[i] * __expf(LF[MID * 128 + dk])); } }
    __syncthreads();
    const int lane = C.lane, w = C.wave, r16 = lane & 15, quad = lane >> 4;
    { constexpr int NTB = CH / 16;
      for (int blk = w; blk < NTB * NTB; blk += NWAVES) { const int tb = blk / NTB, sb = blk % NTB;
        f32x4 a = (f32x4){0.f, 0.f, 0.f, 0.f};
        if (sb <= tb) {
#pragma unroll
            for (int ks = 0; ks < 4; ++ks) { const bf16x8 qa = *(const LAS bf16x8*)(QT + (tb * 16 + r16) * HP_Q + ks * 32 + quad * 8), kb = *(const LAS bf16x8*)(KTL + (sb * 16 + r16) * HP_Q + ks * 32 + quad * 8); a = mfma16(qa, kb, a); } }
#pragma unroll
        for (int j = 0; j < 4; ++j) { const int t = tb * 16 + quad * 4 + j, s = sb * 16 + r16; AS[t * HP_V + s] = f2bf(s <= t ? a[j] : 0.f); } } }
    __syncthreads();
    LAS float* OS = (LAS float*)(C.lds + HL_LF);
    { constexpr int NTB = CH / 16;
      for (int blk = w; blk < NTB * 8; blk += NWAVES) { const int tb = blk >> 3, db = blk & 7;
        f32x4 o = (f32x4){0.f, 0.f, 0.f, 0.f};
#pragma unroll
        for (int ks = 0; ks < SP / 32; ++ks) { const bf16x8 pa = *(const LAS bf16x8*)(AS + (tb * 16 + r16) * HP_V + ks * 32 + quad * 8), vb = *(const LAS bf16x8*)(VT + (db * 16 + r16) * HP_V + ks * 32 + quad * 8); o = mfma16(pa, vb, o); }
#pragma unroll
        for (int ks = 0; ks < 4; ++ks) { const bf16x8 qa = *(const LAS bf16x8*)(QT + (tb * 16 + r16) * HP_Q + ks * 32 + quad * 8), sb_ = *(const LAS bf16x8*)(ST + (db * 16 + r16) * HP_Q + ks * 32 + quad * 8); o = mfma16(qa, sb_, o); }
#pragma unroll
        for (int j = 0; j < 4; ++j) OS[(tb * 16 + quad * 4 + j) * HP_O + db * 16 + r16] = o[j]; } }
    if (CH == 16) {
        f32x4 acc[8];
        const bf16x8 a = *(const LAS bf16x8*)(KH + (w * 16 + r16) * 40 + quad * 8);
#pragma unroll
        for (int nb = 0; nb < 8; ++nb) { const bf16x8 vb = *(const LAS bf16x8*)(VT + (nb * 16 + r16) * HP_V + quad * 8); acc[nb] = mfma16(a, vb, (f32x4){0.f, 0.f, 0.f, 0.f}); }
        float* So = C.out + O_HSS + ((size_t)l * 128 + unit) * 16384;
#pragma unroll
        for (int j = 0; j < 4; ++j) { const int dk = w * 16 + quad * 4 + j; const float g = __expf(BL[dk]);
#pragma unroll
            for (int nb = 0; nb < 8; ++nb) { const int dv = nb * 16 + r16; So[dk * 128 + dv] = g * Ssrc[dk * 128 + dv] + acc[nb][j]; } }
    }
    __syncthreads();
    if (tid < CH * 8) { const int t = tid >> 3, part = tid & 7; const LAS float* orow = OS + t * HP_O + part * 16;
        float ov[16]; float ss = 0.f;
#pragma unroll
        for (int i = 0; i < 4; ++i) { const f32x4 x = *(const LAS f32x4*)(orow + 4 * i); ov[4 * i] = x.x; ov[4 * i + 1] = x.y; ov[4 * i + 2] = x.z; ov[4 * i + 3] = x.w; ss += (x.x * x.x + x.y * x.y) + (x.z * x.z + x.w * x.w); }
        ss += __shfl_xor(ss, 1); ss += __shfl_xor(ss, 2); ss += __shfl_xor(ss, 4);
        const float rstd = 1.0f / sqrtf(ss * (1.0f / 128.f) + RMS_EPS);
        const float* gn = C.in[13] + l * 128 + part * 16; const bf16* hg = HB + (size_t)(row0 + t) * 1536 + 1024 + h * 128 + part * 16;
        bf16* mo = (bf16*)(C.ws + WS_MIX) + (size_t)(row0 + t) * DM + 512 + h * 128 + part * 16;
        v4u w0, w1; unsigned pk[8];
#pragma unroll
        for (int i = 0; i < 8; ++i) pk[i] = pk2(ov[2 * i] * rstd * gn[2 * i] * siluf_(bf2f(hg[2 * i])), ov[2 * i + 1] * rstd * gn[2 * i + 1] * siluf_(bf2f(hg[2 * i + 1])));
        w0.x = pk[0]; w0.y = pk[1]; w0.z = pk[2]; w0.w = pk[3]; w1.x = pk[4]; w1.y = pk[5]; w1.z = pk[6]; w1.w = pk[7];
        *(v4u*)mo = w0; *(v4u*)(mo + 8) = w1; }
    __syncthreads();
}

__device__ __forceinline__ float block_excl_scan(Ctx& C, float total, LAS float* sm) {
    float x = total;
#pragma unroll
    for (int o = 1; o < 64; o <<= 1) { const float y = __shfl_up(x, o); if (C.lane >= o) x += y; }
    if (C.lane == 63) sm[C.wave] = x;
    __syncthreads();
    float woff = 0.f;
#pragma unroll
    for (int w2 = 0; w2 < NWAVES; ++w2) if (w2 < C.wave) woff += sm[w2];
    __syncthreads();
    return woff + (x - total);
}
__device__ __forceinline__ void cumsum_unit(Ctx& C, int unit, int l) {
    LAS float* sm = (LAS float*)(C.lds);
    if (unit < 16) {
        const float* src = C.out + O_LFP + ((size_t)l * 16 + unit) * 8192 + C.tid * 16; float* dst = (float*)(C.ws + WS_CP) + (size_t)unit * 8192 + C.tid * 16;
        float v[16];
#pragma unroll
        for (int i = 0; i < 4; ++i) { const f32x4 x = ((const f32x4*)src)[i]; v[4 * i] = x.x; v[4 * i + 1] = x.y; v[4 * i + 2] = x.z; v[4 * i + 3] = x.w; }
#pragma unroll
        for (int i = 1; i < 16; ++i) v[i] += v[i - 1];
        const float off = block_excl_scan(C, v[15], sm);
#pragma unroll
        for (int i = 0; i < 4; ++i) ((f32x4*)dst)[i] = (f32x4){(v[4 * i] + off) * LOG2E, (v[4 * i + 1] + off) * LOG2E, (v[4 * i + 2] + off) * LOG2E, (v[4 * i + 3] + off) * LOG2E};
    } else {
        const int bh = unit - 16;
        const float* src = C.in[4] + ((size_t)l * 256 + bh) * PAST + C.tid * 4; float* dst = (float*)(C.ws + WS_CS) + (size_t)bh * SKV;
        f32x4 x = *(const f32x4*)src; x.y += x.x; x.z += x.y; x.w += x.z;
        const float off = block_excl_scan(C, x.w, sm);
        *(f32x4*)(dst + C.tid * 4) = (x + off) * LOG2E;
        if (C.tid == NTHR - 1) { float run = x.w + off; const float* nl = C.out + O_LFS + ((size_t)l * 256 + bh) * 16;
            for (int t = 0; t < 16; ++t) { run += nl[t]; dst[PAST + t] = run * LOG2E; } }
    }
}
__device__ __forceinline__ void ktn_task(Ctx& C, int task) {
    const int bh = task >> 7, tile = task & 127, b = bh >> 3, h = bh & 7, lane = C.lane;
    const bf16* Kb = (const bf16*)(C.ws + WS_KB) + ((size_t)b * SEQ + tile * 64) * 512 + h * 64;
    float mx = 0.f;
#pragma unroll
    for (int i = 0; i < 8; ++i) { const int key = i * 8 + (lane >> 3); const v4u w = *(const v4u*)(Kb + (size_t)key * 512 + (lane & 7) * 8);
        float s = 0.f; const unsigned ww[4] = {w.x, w.y, w.z, w.w};
#pragma unroll
        for (int e = 0; e < 4; ++e) { const float lo = __builtin_bit_cast(float, ww[e] << 16), hi = __builtin_bit_cast(float, ww[e] & 0xffff0000u); s += lo * lo + hi * hi; }
        s += __shfl_xor(s, 1); s += __shfl_xor(s, 2); s += __shfl_xor(s, 4);
        mx = fmaxf(mx, s); }
    mx = wave_max(mx);
    if (lane == 0) ((float*)(C.ws + WS_KTN))[task] = sqrtf(mx);
}

constexpr int AT_SLOT = 16384, AT_VT = 0, AT_P = 9216, AP = 72;
struct AttnState { bf16x8 qa[2]; float cq[4], m[4], l[4]; f32x4 o[4]; };
__device__ __forceinline__ bf16x8 kfrag_bf16(const bf16* p) { return *(const bf16x8*)p; }
__device__ __forceinline__ bf16x8 kfrag_f32(const float* p) { const f32x4 a = *(const f32x4*)p, b = *(const f32x4*)(p + 4); v4u w; w.x = pk2(a.x, a.y); w.y = pk2(a.z, a.w); w.z = pk2(b.x, b.y); w.w = pk2(b.z, b.w); return __builtin_bit_cast(bf16x8, w); }
template <bool F32> __device__ __forceinline__ void attn_tile(AttnState& S, const void* Ksrc, const void* Vsrc, int pitch, int nvalid, const float* ck, int diag, LAS bf16* VT, LAS bf16* PL, int lane) {
    const int col = lane & 15, quad = lane >> 4;
    if (F32) { const float* V = (const float*)Vsrc;
#pragma unroll 4
        for (int i = 0; i < 16; ++i) { const int key = i * 4 + (lane >> 4), dc = (lane & 15) * 4; f32x4 x = (f32x4){0.f, 0.f, 0.f, 0.f};
            if (key < nvalid) x = *(const f32x4*)(V + (size_t)key * pitch + dc);
            VT[(dc + 0) * AP + key] = f2bf(x.x); VT[(dc + 1) * AP + key] = f2bf(x.y); VT[(dc + 2) * AP + key] = f2bf(x.z); VT[(dc + 3) * AP + key] = f2bf(x.w); }
    } else { const bf16* V = (const bf16*)Vsrc;
#pragma unroll 4
        for (int i = 0; i < 8; ++i) { const int key = i * 8 + (lane >> 3), dc = (lane & 7) * 8; v4u w = (v4u){0u, 0u, 0u, 0u};
            if (key < nvalid) w = *(const v4u*)(V + (size_t)key * pitch + dc);
            VT[(dc + 0) * AP + key] = (bf16)(w.x & 0xffffu); VT[(dc + 1) * AP + key] = (bf16)(w.x >> 16); VT[(dc + 2) * AP + key] = (bf16)(w.y & 0xffffu); VT[(dc + 3) * AP + key] = (bf16)(w.y >> 16);
            VT[(dc + 4) * AP + key] = (bf16)(w.z & 0xffffu); VT[(dc + 5) * AP + key] = (bf16)(w.z >> 16); VT[(dc + 6) * AP + key] = (bf16)(w.w & 0xffffu); VT[(dc + 7) * AP + key] = (bf16)(w.w >> 16); }
    }
    f32x4 s[4];
#pragma unroll
    for (int nb = 0; nb < 4; ++nb) { const int key = nb * 16 + col, kc = key < nvalid ? key : (nvalid - 1);
        f32x4 a = (f32x4){0.f, 0.f, 0.f, 0.f};
#pragma unroll
        for (int ks = 0; ks < 2; ++ks) { const bf16x8 kb = F32 ? kfrag_f32((const float*)Ksrc + (size_t)kc * pitch + ks * 32 + quad * 8) : kfrag_bf16((const bf16*)Ksrc + (size_t)kc * pitch + ks * 32 + quad * 8);
            a = mfma16(S.qa[ks], kb, a); }
        const float ckv = ck[kc];
#pragma unroll
        for (int j = 0; j < 4; ++j) { const int r = quad * 4 + j; const bool ok = (key < nvalid) && (key <= r + diag); a[j] = ok ? (a[j] + (S.cq[j] - ckv)) : -INFINITY; }
        s[nb] = a; }
    float alpha[4];
#pragma unroll
    for (int j = 0; j < 4; ++j) { float mx = fmaxf(fmaxf(s[0][j], s[1][j]), fmaxf(s[2][j], s[3][j]));
        mx = fmaxf(mx, __shfl_xor(mx, 1)); mx = fmaxf(mx, __shfl_xor(mx, 2)); mx = fmaxf(mx, __shfl_xor(mx, 4)); mx = fmaxf(mx, __shfl_xor(mx, 8));
        const float mnew = fmaxf(S.m[j], mx), msafe = (mnew == -INFINITY) ? 0.f : mnew;
        alpha[j] = fast_exp2(S.m[j] - msafe); S.m[j] = mnew;
        float ps = 0.f;
#pragma unroll
        for (int nb = 0; nb < 4; ++nb) { const float p = fast_exp2(s[nb][j] - msafe); s[nb][j] = p; ps += p; }
        S.l[j] = S.l[j] * alpha[j] + ps; }
#pragma unroll
    for (int nb = 0; nb < 4; ++nb)
#pragma unroll
        for (int j = 0; j < 4; ++j) { PL[(quad * 4 + j) * AP + nb * 16 + col] = f2bf(s[nb][j]); S.o[nb][j] *= alpha[j]; }
    LDS_WAIT(); __builtin_amdgcn_wave_barrier(); asm volatile("" ::: "memory");
    bf16x8 pa[2];
#pragma unroll
    for (int ks = 0; ks < 2; ++ks) pa[ks] = *(const LAS bf16x8*)(PL + col * AP + ks * 32 + quad * 8);
#pragma unroll
    for (int nb = 0; nb < 4; ++nb)
#pragma unroll
        for (int ks = 0; ks < 2; ++ks) { const bf16x8 vb = *(const LAS bf16x8*)(VT + (nb * 16 + col) * AP + ks * 32 + quad * 8); S.o[nb] = mfma16(pa[ks], vb, S.o[nb]); }
    LDS_WAIT(); __builtin_amdgcn_wave_barrier(); asm volatile("" ::: "memory");
}
__device__ __forceinline__ void attn_init(AttnState& S, const bf16* Qrow0, const float* cq0, int lane) {
    const int col = lane & 15, quad = lane >> 4;
#pragma unroll
    for (int ks = 0; ks < 2; ++ks) S.qa[ks] = *(const bf16x8*)(Qrow0 + (size_t)col * 512 + ks * 32 + quad * 8);
#pragma unroll
    for (int j = 0; j < 4; ++j) { S.cq[j] = cq0[quad * 4 + j]; S.m[j] = -INFINITY; S.l[j] = 0.f; }
#pragma unroll
    for (int nb = 0; nb < 4; ++nb) S.o[nb] = (f32x4){0.f, 0.f, 0.f, 0.f};
}
__device__ __forceinline__ float attn_qmax(const AttnState& S) {
    float s = 0.f;
#pragma unroll
    for (int ks = 0; ks < 2; ++ks)
#pragma unroll
        for (int e = 0; e < 8; ++e) { const float x = bf2f((bf16)S.qa[ks][e]); s += x * x; }
    s += __shfl_xor(s, 16); s += __shfl_xor(s, 32);
    return sqrtf(wave_max(s));
}
__device__ __forceinline__ void attn_prompt_task(Ctx& C, int task) {
    const int bh = task >> 9, rb = task & 511, b = bh >> 3, h = bh & 7, lane = C.lane, i0 = rb * 16;
    const bf16* Qb = (const bf16*)(C.ws + WS_QB); const bf16* Kb = (const bf16*)(C.ws + WS_KB); const bf16* Vb = (const bf16*)(C.ws + WS_VB);
    const float* cp = (const float*)(C.ws + WS_CP) + (size_t)bh * SEQ;
    LAS bf16* VT = (LAS bf16*)(C.lds + C.wave * AT_SLOT + AT_VT); LAS bf16* PL = (LAS bf16*)(C.lds + C.wave * AT_SLOT + AT_P);
    AttnState S; attn_init(S, Qb + ((size_t)b * SEQ + i0) * 512 + h * 64, cp + i0, lane);
    const float* ktn = (const float*)(C.ws + WS_KTN) + bh * 128;
    const float kmax = wave_max(fmaxf(ktn[lane], ktn[lane + 64])), bound = 2.0f * attn_qmax(S) * kmax;
    const int jd = i0 >> 6; const float c0 = cp[i0];
    int jstart = jd;
    { const int t0 = lane, t1 = lane + 64;
      const bool n0 = (t0 < jd) && (c0 - cp[t0 * 64 + 63] + bound >= -151.5f), n1 = (t1 < jd) && (c0 - cp[(t1 < jd ? t1 : 0) * 64 + 63] + bound >= -151.5f);
      const unsigned long long m0 = __ballot(n0), m1 = __ballot(n1);
      if (m0) jstart = __builtin_ctzll(m0); else if (m1) jstart = 64 + __builtin_ctzll(m1); }
    for (int t = jstart; t <= jd; ++t) {
        const size_t krow = ((size_t)b * SEQ + t * 64) * 512 + h * 64;
        attn_tile<false>(S, Kb + krow, Vb + krow, 512, 64, cp + t * 64, (t == jd) ? (i0 - t * 64) : 64, VT, PL, lane);
    }
    const int col = lane & 15, quad = lane >> 4;
#pragma unroll
    for (int j = 0; j < 4; ++j) { float lt = S.l[j]; lt += __shfl_xor(lt, 1); lt += __shfl_xor(lt, 2); lt += __shfl_xor(lt, 4); lt += __shfl_xor(lt, 8); const float inv = 1.0f / lt;
#pragma unroll
        for (int nb = 0; nb < 4; ++nb) PL[(quad * 4 + j) * AP + nb * 16 + col] = f2bf(S.o[nb][j] * inv); }
    LDS_WAIT(); __builtin_amdgcn_wave_barrier(); asm volatile("" ::: "memory");
    bf16* mix = (bf16*)(C.ws + WS_MIX) + ((size_t)b * SEQ + i0) * DM + h * 64;
#pragma unroll
    for (int i = 0; i < 2; ++i) { const int r = i * 8 + (lane >> 3), ch = lane & 7; *(v4u*)(mix + (size_t)r * DM + ch * 8) = *(const LAS v4u*)(PL + r * AP + ch * 8); }
    LDS_WAIT(); __builtin_amdgcn_wave_barrier(); asm volatile("" ::: "memory");
}
constexpr int AB_K = 0, AB_V = 18432, AB_P = 36864, AB_CK = 55296, AB_RED = 55808;
__device__ __forceinline__ void attn_tile_lds(AttnState& S, const LAS bf16* KL, const LAS bf16* VT, const LAS float* CK, int diag, LAS bf16* PL, int lane) {
    const int col = lane & 15, quad = lane >> 4;
    f32x4 s[4];
#pragma unroll
    for (int nb = 0; nb < 4; ++nb) { const int key = nb * 16 + col;
        f32x4 a = (f32x4){0.f, 0.f, 0.f, 0.f};
#pragma unroll
        for (int ks = 0; ks < 2; ++ks) { const bf16x8 kb = *(const LAS bf16x8*)(KL + key * AP + ks * 32 + quad * 8); a = mfma16(S.qa[ks], kb, a); }
        const float ckv = CK[key];
#pragma unroll
        for (int j = 0; j < 4; ++j) { const int r = quad * 4 + j; a[j] = (key <= r + diag) ? (a[j] + (S.cq[j] - ckv)) : -INFINITY; }
        s[nb] = a; }
    float alpha[4];
#pragma unroll
    for (int j = 0; j < 4; ++j) { float mx = fmaxf(fmaxf(s[0][j], s[1][j]), fmaxf(s[2][j], s[3][j]));
        mx = fmaxf(mx, __shfl_xor(mx, 1)); mx = fmaxf(mx, __shfl_xor(mx, 2)); mx = fmaxf(mx, __shfl_xor(mx, 4)); mx = fmaxf(mx, __shfl_xor(mx, 8));
        const float mnew = fmaxf(S.m[j], mx), msafe = (mnew == -INFINITY) ? 0.f : mnew;
        alpha[j] = fast_exp2(S.m[j] - msafe); S.m[j] = mnew;
        float ps = 0.f;
#pragma unroll
        for (int nb = 0; nb < 4; ++nb) { const float p = fast_exp2(s[nb][j] - msafe); s[nb][j] = p; ps += p; }
        S.l[j] = S.l[j] * alpha[j] + ps; }
#pragma unroll
    for (int nb = 0; nb < 4; ++nb)
#pragma unroll
        for (int j = 0; j < 4; ++j) { PL[(quad * 4 + j) * AP + nb * 16 + col] = f2bf(s[nb][j]); S.o[nb][j] *= alpha[j]; }
    LDS_WAIT(); __builtin_amdgcn_wave_barrier(); asm volatile("" ::: "memory");
    bf16x8 pa[2];
#pragma unroll
    for (int ks = 0; ks < 2; ++ks) pa[ks] = *(const LAS bf16x8*)(PL + col * AP + ks * 32 + quad * 8);
#pragma unroll
    for (int nb = 0; nb < 4; ++nb)
#pragma unroll
        for (int ks = 0; ks < 2; ++ks) { const bf16x8 vb = *(const LAS bf16x8*)(VT + (nb * 16 + col) * AP + ks * 32 + quad * 8); S.o[nb] = mfma16(pa[ks], vb, S.o[nb]); }
    LDS_WAIT(); __builtin_amdgcn_wave_barrier(); asm volatile("" ::: "memory");
}
__device__ __forceinline__ void attn_prompt_unit(Ctx& C, int unit) {
    const int bh = unit >> 6, qb = 63 - (unit & 63), b = bh >> 3, h = bh & 7, lane = C.lane, w = C.wave, tid = C.tid, i0b = qb * 128, i0 = i0b + 16 * w;
    const bf16* Qb = (const bf16*)(C.ws + WS_QB); const bf16* Kb = (const bf16*)(C.ws + WS_KB) + (size_t)b * SEQ * 512 + h * 64; const bf16* Vb = (const bf16*)(C.ws + WS_VB) + (size_t)b * SEQ * 512 + h * 64;
    const float* cp = (const float*)(C.ws + WS_CP) + (size_t)bh * SEQ;
    LAS bf16* KL = (LAS bf16*)(C.lds + AB_K); LAS bf16* VT = (LAS bf16*)(C.lds + AB_V); LAS bf16* PL = (LAS bf16*)(C.lds + AB_P) + w * 16 * AP;
    LAS float* CK = (LAS float*)(C.lds + AB_CK); LAS float* RED = (LAS float*)(C.lds + AB_RED);
    AttnState S; attn_init(S, Qb + ((size_t)b * SEQ + i0) * 512 + h * 64, cp + i0, lane);
    { const float qm = attn_qmax(S); if (lane == 0) RED[w] = qm; }
    __syncthreads();
    float qmax = RED[0];
#pragma unroll
    for (int i = 1; i < NWAVES; ++i) qmax = fmaxf(qmax, RED[i]);
    const float* ktn = (const float*)(C.ws + WS_KTN) + bh * 128;
    const float kmax = wave_max(fmaxf(ktn[lane], ktn[lane + 64])), bound = 2.0f * qmax * kmax;
    const int jd0 = i0b >> 6, jlast = jd0 + 1; const float c0 = cp[i0b];
    int jstart = jd0;
    { const int t0 = lane, t1 = lane + 64;
      const bool n0 = (t0 < jd0) && (c0 - cp[t0 * 64 + 63] + bound >= -151.5f), n1 = (t1 < jd0) && (c0 - cp[(t1 < jd0 ? t1 : 0) * 64 + 63] + bound >= -151.5f);
      const unsigned long long m0 = __ballot(n0), m1 = __ballot(n1);
      if (m0) jstart = __builtin_ctzll(m0); else if (m1) jstart = 64 + __builtin_ctzll(m1); }
    const int skey = tid >> 3, sch = tid & 7;
    v4u kreg, vreg; float creg = 0.f;
#define AT_LOAD(t) do { kreg = *(const v4u*)(Kb + (size_t)((t) * 64 + skey) * 512 + sch * 8); vreg = *(const v4u*)(Vb + (size_t)((t) * 64 + lane) * 512 + w * 8); if (tid < 64) creg = cp[(t) * 64 + tid]; } while (0)
#define AT_STORE(bf) do { *(LAS v4u*)(KL + (bf) * 64 * AP + skey * AP + sch * 8) = kreg; LAS bf16* vt_ = VT + (bf) * 64 * AP + (w * 8) * AP + lane; \
        vt_[0 * AP] = (bf16)(vreg.x & 0xffffu); vt_[1 * AP] = (bf16)(vreg.x >> 16); vt_[2 * AP] = (bf16)(vreg.y & 0xffffu); vt_[3 * AP] = (bf16)(vreg.y >> 16); \
        vt_[4 * AP] = (bf16)(vreg.z & 0xffffu); vt_[5 * AP] = (bf16)(vreg.z >> 16); vt_[6 * AP] = (bf16)(vreg.w & 0xffffu); vt_[7 * AP] = (bf16)(vreg.w >> 16); \
        if (tid < 64) CK[(bf) * 64 + tid] = creg; } while (0)
    AT_LOAD(jstart); AT_STORE(0);
    __syncthreads();
    for (int t = jstart; t <= jlast; ++t) { const int bf = (t - jstart) & 1;
        if (t < jlast) AT_LOAD(t + 1);
        const int diag = i0 - 64 * t;
        if (diag >= 0) attn_tile_lds(S, KL + bf * 64 * AP, VT + bf * 64 * AP, CK + bf * 64, diag, PL, lane);
        if (t < jlast) AT_STORE(bf ^ 1);
        __syncthreads();
    }
#undef AT_LOAD
#undef AT_STORE
    const int col = lane & 15, quad = lane >> 4;
#pragma unroll
    for (int j = 0; j < 4; ++j) { float lt = S.l[j]; lt += __shfl_xor(lt, 1); lt += __shfl_xor(lt, 2); lt += __shfl_xor(lt, 4); lt += __shfl_xor(lt, 8); const float inv = 1.0f / lt;
#pragma unroll
        for (int nb = 0; nb < 4; ++nb) PL[(quad * 4 + j) * AP + nb * 16 + col] = f2bf(S.o[nb][j] * inv); }
    LDS_WAIT(); __builtin_amdgcn_wave_barrier(); asm volatile("" ::: "memory");
    bf16* mix = (bf16*)(C.ws + WS_MIX) + ((size_t)b * SEQ + i0) * DM + h * 64;
#pragma unroll
    for (int i = 0; i < 2; ++i) { const int r = i * 8 + (lane >> 3), ch = lane & 7; *(v4u*)(mix + (size_t)r * DM + ch * 8) = *(const LAS v4u*)(PL + r * AP + ch * 8); }
    LDS_WAIT(); __builtin_amdgcn_wave_barrier(); asm volatile("" ::: "memory");
}
__device__ __forceinline__ void attn_sample_unit(Ctx& C, int unit, int l) {
    const int b = unit >> 3, h = unit & 7, lane = C.lane, w = C.wave;
    const bf16* Qb = (const bf16*)(C.ws + WS_QB); const bf16* Kb = (const bf16*)(C.ws + WS_KB); const bf16* Vb = (const bf16*)(C.ws + WS_VB);
    const float* cs = (const float*)(C.ws + WS_CS) + (size_t)unit * SKV;
    LAS bf16* VT = (LAS bf16*)(C.lds + w * AT_SLOT + AT_VT); LAS bf16* PL = (LAS bf16*)(C.lds + w * AT_SLOT + AT_P);
    const size_t srow = ((size_t)MP + b * 16) * 512 + h * 64;
    AttnState S; attn_init(S, Qb + srow, cs + PAST, lane);
    const float* ck = C.in[2] + (((size_t)l * 32 + b) * 8 + h) * PAST * 64; const float* cv = C.in[3] + (((size_t)l * 32 + b) * 8 + h) * PAST * 64;
    for (int t = w; t < 32; t += NWAVES) attn_tile<true>(S, ck + (size_t)t * 64 * 64, cv + (size_t)t * 64 * 64, 64, 64, cs + t * 64, 64, VT, PL, lane);
    if (w == 0) attn_tile<false>(S, Kb + srow, Vb + srow, 512, 16, cs + PAST, 0, VT, PL, lane);
    const int col = lane & 15, quad = lane >> 4;
    LAS float* slot = (LAS float*)(C.lds + w * AT_SLOT);
#pragma unroll
    for (int j = 0; j < 4; ++j) { float lt = S.l[j]; lt += __shfl_xor(lt, 1); lt += __shfl_xor(lt, 2); lt += __shfl_xor(lt, 4); lt += __shfl_xor(lt, 8);
        if (col == 0) { slot[quad * 4 + j] = S.m[j]; slot[16 + quad * 4 + j] = lt; }
#pragma unroll
        for (int nb = 0; nb < 4; ++nb) slot[64 + (quad * 4 + j) * 64 + nb * 16 + col] = S.o[nb][j]; }
    __syncthreads();
    bf16* mix = (bf16*)(C.ws + WS_MIX) + ((size_t)MP + b * 16) * DM + h * 64;
    for (int e = C.tid; e < 16 * 64; e += NTHR) { const int r = e >> 6, d = e & 63;
        float M = -INFINITY;
#pragma unroll
        for (int w2 = 0; w2 < NWAVES; ++w2) M = fmaxf(M, ((const LAS float*)(C.lds + w2 * AT_SLOT))[r]);
        float num = 0.f, den = 0.f;
#pragma unroll
        for (int w2 = 0; w2 < NWAVES; ++w2) { const LAS float* sl = (const LAS float*)(C.lds + w2 * AT_SLOT); const float f = fast_exp2(sl[r] - M); num += f * sl[64 + r * 64 + d]; den += f * sl[16 + r]; }
        mix[(size_t)r * DM + d] = f2bf(num / den); }
    __syncthreads();
}

constexpr int LDSCTL_OFF = LDS_BYTES - 64, CW_BAR = 4096;
#define XB_TMO      128
#define XB_XCNT(j)  (256  + 64 * (j))
#define XB_XSUB(j)  (1280 + 64 * (j))
#define XB_XGEN(j)  (2304 + 64 * (j))
#define XB_TOP      3328
#define XB_TOPGEN   3392
#define XCD_BAR_WORDS 3456
#define XB_SPIN_CAP (1u << 18)

__device__ __forceinline__ unsigned xb_ld(unsigned* p)              { return __hip_atomic_load(p, __ATOMIC_RELAXED, __HIP_MEMORY_SCOPE_AGENT); }
__device__ __forceinline__ unsigned xb_add(unsigned* p, unsigned v) { return __hip_atomic_fetch_add(p, v, __ATOMIC_RELAXED, __HIP_MEMORY_SCOPE_AGENT); }
__device__ __forceinline__ unsigned xb_xcc_id() { return (unsigned)__builtin_amdgcn_s_getreg((3 << 11) | 20) & 0xFu; }
#define XB_SPIN(cond, bar) do { unsigned _sp = 0; while (cond) { __builtin_amdgcn_s_sleep(1); \
    if ((++_sp & 255u) == 0u) { if (xb_ld(&(bar)[XB_TMO])) break; if (_sp > XB_SPIN_CAP) { atomicAdd(&(bar)[XB_TMO], 1u); break; } } } } while (0)

struct XcdBarrier {
    unsigned* bar; unsigned x;
    volatile LAS unsigned* st;
};

__device__ __forceinline__ XcdBarrier xcd_barrier_post(unsigned* bar, volatile LAS unsigned* st) {
    XcdBarrier b; b.bar = bar; b.x = xb_xcc_id(); b.st = st;
    if (threadIdx.x == 0) (void)xb_add(&bar[XB_XCNT(b.x)], 1u);
    return b;
}
__device__ __forceinline__ void xcd_barrier_complete(unsigned* bar, unsigned x, unsigned& nloc, unsigned& nx) {
    const unsigned G = gridDim.x * gridDim.y * gridDim.z;
    unsigned sum, cnt, mine, sp = 0u;
    for (;;) {
        sum = 0u; cnt = 0u; mine = 0u;
#pragma unroll
        for (unsigned j = 0; j < 16; ++j) { const unsigned c = xb_ld(&bar[XB_XCNT(j)]); sum += c; cnt += (c > 0u) ? 1u : 0u; mine = (j == x) ? c : mine; }
        if (sum == G) break;
        __builtin_amdgcn_s_sleep(1);
        if ((++sp & 255u) == 0u) { if (xb_ld(&bar[XB_TMO])) break; if (sp > XB_SPIN_CAP) { atomicAdd(&bar[XB_TMO], 1u); break; } }
    }
    nloc = mine > 0u ? mine : 1u; nx = cnt > 0u ? cnt : 1u;
}

__device__ __forceinline__ void xcd_barrier(const XcdBarrier& b) {
    asm volatile("s_waitcnt vmcnt(0)" ::: "memory");
    __syncthreads();
    if (threadIdx.x == 0) {
        unsigned* bar = b.bar;
        __builtin_amdgcn_s_waitcnt(0);
        unsigned nloc = b.st[0], nx = b.st[1];
        if (nloc == 0u) { xcd_barrier_complete(bar, b.x, nloc, nx); b.st[0] = nloc; b.st[1] = nx; }
        const unsigned old = xb_add(&bar[XB_XSUB(b.x)], 1u);
        const unsigned gen = old / nloc;
        if (old + 1u == (gen + 1u) * nloc) {
            __builtin_amdgcn_fence(__ATOMIC_RELEASE, "agent");
            asm volatile("s_waitcnt vmcnt(0)" ::: "memory");
            const unsigned og = xb_add(&bar[XB_TOP], 1u);
            const unsigned tg = og / nx;
            if (og + 1u == (tg + 1u) * nx) xb_add(&bar[XB_TOPGEN], 1u);
            else XB_SPIN(xb_ld(&bar[XB_TOPGEN]) == tg, bar);
            __builtin_amdgcn_fence(__ATOMIC_ACQUIRE, "agent");
            xb_add(&bar[XB_XGEN(b.x)], 1u);
            asm volatile("s_waitcnt vmcnt(0)" ::: "memory");
        } else {
            XB_SPIN(xb_ld(&bar[XB_XGEN(b.x)]) == gen, bar);
            __builtin_amdgcn_fence(__ATOMIC_ACQUIRE, "agent");
            asm volatile("s_waitcnt vmcnt(0)" ::: "memory");
        }
    }
    __syncthreads();
}

template <int KIND, int L> __device__ __forceinline__ void gemm_up(Ctx& C) {
    pg8::Gemm g{(const bf16*)(C.ws + WS_HN), (const bf16*)(C.ws + WS_W1T) + (size_t)(L * 2 + KIND) * W1T_SZ, MT, 2 * DFF, DM}; pg8::StaticOrder S; S.init(MT, 2 * DFF, C.G, C.bid);
    pg8::EpiSwiglu E{(bf16*)(C.ws + WS_ACT)};
    pg8::gemm_phase<pg8::EpiSwiglu, pg8::StaticOrder, true, true>(C.lds, g, S, E);
}
template <int KIND, int L> __device__ __forceinline__ void gemm_res(Ctx& C, bool dummy = false) {
    pg8::Gemm g;
    if (KIND == 2) g = pg8::Gemm{(const bf16*)(C.ws + WS_MIX), (const bf16*)(C.ws + WS_WOT) + (size_t)L * WOT_SZ, MT, DM, DM};
    else g = pg8::Gemm{(const bf16*)(C.ws + WS_ACT), (const bf16*)(C.ws + WS_W2T) + (size_t)(L * 2 + KIND) * W2T_SZ, MT, DM, DFF};
    pg8::SplitOrder S; S.init(MP, DM, C.G, C.bid, (KIND == 2 ? DM : DFF) / 64);
    float* Xo = (float*)(C.ws + (dummy ? WS_END : WS_X));
    pg8::EpiRes E{Xo, (KIND == 0 && L == 0 && !dummy) ? C.in[0] : Xo, (float*)(C.ws + (dummy ? WS_END + 100 * MiB : WS_PART)), KIND == 2 ? 1.0f : 0.5f};
    pg8::gemm_phase<pg8::EpiRes, pg8::SplitOrder, true, true>(C.lds, g, S, E);
}
template <int L> __device__ __forceinline__ void gemm_inproj(Ctx& C) {
    pg8::Gemm g{(const bf16*)(C.ws + WS_HN), (const bf16*)(C.ws + WS_WINT) + (size_t)L * WINT_SZ, MT, NIN, DM}; pg8::StaticOrder S; S.init(MT, NIN, C.G, C.bid);
    pg8::EpiInProj E{(bf16*)(C.ws + WS_QB), (bf16*)(C.ws + WS_KB), (bf16*)(C.ws + WS_VB), (float*)(C.ws + WS_HF), (bf16*)(C.ws + WS_HB), C.out, L};
    pg8::gemm_phase<pg8::EpiInProj, pg8::StaticOrder, true, true>(C.lds, g, S, E);
}
__device__ __forceinline__ void phase_prep(Ctx& C, int l) {
    for (int u = C.bid; u < 1024; u += C.G) hgrn_local_unit(C, u, l);
    for (int u = C.bid; u < 272; u += C.G) cumsum_unit(C, u, l);
    for (int t = CTX_GW(C); t < 2048; t += CTX_NGW(C)) ktn_task(C, t);
}
__device__ __forceinline__ void phase_attn(Ctx& C, int l, bool noscan = false) {
    for (int u = C.bid; u < 256; u += C.G) attn_sample_unit(C, u, l);
    if (!noscan) hgrn_scan(C, l);
    for (int u = C.bid; u < 1024; u += C.G) attn_prompt_unit(C, u);
}
__device__ __forceinline__ void phase_hout(Ctx& C, int l) {
    for (int u = C.bid; u < 1024; u += C.G) hgrn_out_unit<64>(C, u, l);
    for (int u = C.bid; u < 128; u += C.G) hgrn_out_unit<16>(C, u, l);
}
template <int L> __device__ __forceinline__ void layer_phases(Ctx& C, const XcdBarrier& bar, int lo, int hi) {
    constexpr int P = 1 + 12 * L;
#define IN(k) (lo <= (k) && (k) < hi)
#define SEAM(k) do { if (IN(k) && IN((k) + 1)) xcd_barrier(bar); } while (0)
#define DUPK(k) (L == 0 && ((DUP >> (k)) & 1))
    if (IN(P + 0)) { phase_rms<0>(C, C.in[6] + L * DM, L, L == 0 ? 0.f : 0.5f, L == 0 ? 1 : 0); if (DUPK(0)) { xcd_barrier(bar); phase_rms<0>(C, C.in[6] + L * DM, L, L == 0 ? 0.f : 0.5f, L == 0 ? 1 : 0); } }
    SEAM(P + 0);
    if (IN(P + 1)) { gemm_up<0, L>(C); if (DUPK(1)) { xcd_barrier(bar); gemm_up<0, L>(C); } }
    SEAM(P + 1);
    if (IN(P + 2)) { gemm_res<0, L>(C); if (DUPK(2)) { xcd_barrier(bar); gemm_res<0, L>(C, true); } }
    SEAM(P + 2);
    if (IN(P + 3)) { phase_rms<1>(C, C.in[9] + L * DM, L, 0.5f, L == 0 ? 2 : 0); if (DUPK(3)) { xcd_barrier(bar); phase_rms<1>(C, C.in[9] + L * DM, L, 0.5f, L == 0 ? 2 : 0); } }
    SEAM(P + 3);
    if (IN(P + 4)) { gemm_inproj<L>(C); if (DUPK(4)) { xcd_barrier(bar); gemm_inproj<L>(C); } }
    SEAM(P + 4);
    if (IN(P + 5)) { phase_prep(C, L); if (DUPK(5)) { xcd_barrier(bar); phase_prep(C, L); } }
    SEAM(P + 5);
    if (IN(P + 6)) { phase_attn(C, L); if (DUPK(6)) { xcd_barrier(bar); phase_attn(C, L, true); } if (DUPK(10)) { xcd_barrier(bar); hgrn_scan(C, L, true); } if (DUPK(11)) { xcd_barrier(bar); for (int u = C.bid; u < 256; u += C.G) attn_sample_unit(C, u, L); } }
    SEAM(P + 6);
    if (IN(P + 7)) { phase_hout(C, L); if (DUPK(7)) { xcd_barrier(bar); phase_hout(C, L); } }
    SEAM(P + 7);
    if (IN(P + 8)) { gemm_res<2, L>(C); if (DUPK(8)) { xcd_barrier(bar); gemm_res<2, L>(C, true); } }
    SEAM(P + 8);
    if (IN(P + 9)) { phase_rms<0>(C, C.in[15] + L * DM, L, 1.0f, 0); if (DUPK(9)) { xcd_barrier(bar); phase_rms<0>(C, C.in[15] + L * DM, L, 1.0f, 0); } }
    SEAM(P + 9);
    if (IN(P + 10)) gemm_up<1, L>(C);
    SEAM(P + 10);
    if (IN(P + 11)) gemm_res<1, L>(C);
    SEAM(P + 11);
#undef DUPK
#undef IN
#undef SEAM
}

__global__ void __launch_bounds__(NTHR, 2) fwd_megakernel(Params prm) {
    extern __shared__ __attribute__((aligned(16))) unsigned char lds_raw[];
    Ctx C;
    C.lds = (LAS unsigned char*)lds_raw; C.tid = threadIdx.x; C.lane = C.tid & 63; C.wave = __builtin_amdgcn_readfirstlane(C.tid >> 6); C.G = gridDim.x; C.bid = blockIdx.x;
#pragma unroll
    for (int i = 0; i < 19; ++i) C.in[i] = prm.in[i];
    C.out = prm.out; C.ws = prm.ws;
    cg::grid_group grid = cg::this_grid();
    volatile LAS unsigned* MISC = (volatile LAS unsigned*)(C.lds + LDSCTL_OFF);
    if (C.tid < 16) MISC[C.tid] = 0u;
    __syncthreads();
    XcdBarrier bar; bar.bar = (unsigned*)(C.ws + WS_CTL) + CW_BAR; bar.x = 0; bar.st = nullptr;
    if (ONE_LAUNCH) bar = xcd_barrier_post((unsigned*)(C.ws + WS_CTL) + CW_BAR, MISC + 8);
    const int lo = prm.ph_lo, hi = prm.ph_hi;
#define IN(k) (lo <= (k) && (k) < hi)
#define SEAM(k) do { if (IN(k) && IN((k) + 1)) grid.sync(); } while (0)
    if (IN(0)) { phase_prologue(C); if ((DUP >> 12) & 1) { grid.sync(); phase_prologue(C); } if ((DUP >> 13) & 1) { for (int i = 0; i < 16; ++i) xcd_barrier(bar); } } SEAM(0);
    layer_phases<0>(C, bar, lo, hi);
    layer_phases<1>(C, bar, lo, hi);
    if (IN(25)) phase_rms<2>(C, C.in[18], 0, 0.5f, 0);
#undef IN
#undef SEAM
}

extern "C" void kernel_launch(void* const* d_in, const int* in_sizes, int n_in, void* d_out, int out_size, void* d_ws, size_t ws_size, hipStream_t stream) {
    static int grid = 0;
    if (grid == 0) {
        if (n_in != 19 || (size_t)out_size != O_END || ws_size < WS_PART + 8 * MiB) { fprintf(stderr, "kernel_launch: unexpected problem (n_in %d out %d ws %zu)\n", n_in, out_size, ws_size); grid = -1; return; }
        int dev = 0, cus = 0, per_cu = 0;
        hipGetDevice(&dev); hipDeviceGetAttribute(&cus, hipDeviceAttributeMultiprocessorCount, dev);
        if (hipFuncSetAttribute((const void*)fwd_megakernel, hipFuncAttributeMaxDynamicSharedMemorySize, LDS_BYTES) != hipSuccess) { fprintf(stderr, "kernel_launch: hipFuncSetAttribute failed\n"); grid = -1; return; }
        if (hipOccupancyMaxActiveBlocksPerMultiprocessor(&per_cu, (const void*)fwd_megakernel, NTHR, LDS_BYTES) != hipSuccess || per_cu < 1) { fprintf(stderr, "kernel_launch: occupancy query says %d\n", per_cu); per_cu = 1; }
        (void)hipGetLastError();
        grid = cus * 1;
        if (grid <= 0) grid = 256;
    }
    if (grid < 0) return;
    Params p{};
    for (int i = 0; i < 19; ++i) p.in[i] = (const float*)d_in[i];
    p.out = (float*)d_out; p.ws = (unsigned char*)d_ws;
#if ONE_LAUNCH
    if (hipMemsetAsync((char*)d_ws + WS_CTL, 0, 65536, stream) != hipSuccess) { fprintf(stderr, "kernel_launch: memset of the barrier words failed\n"); return; }
    p.ph_lo = 0; p.ph_hi = 26;
    void* args[] = {&p};
    hipError_t e = hipLaunchCooperativeKernel((const void*)fwd_megakernel, dim3(grid), dim3(NTHR), args, LDS_BYTES, stream);
    if (e != hipSuccess) fprintf(stderr, "cooperative launch failed: %s (grid %d)\n", hipGetErrorString(e), grid);
#else
    for (int ph = 0; ph < 26; ++ph) { p.ph_lo = ph; p.ph_hi = ph + 1; hipLaunchKernelGGL(fwd_megakernel, dim3(grid), dim3(NTHR), LDS_BYTES, stream, p); }
#endif
}
```

```cpp
#include <hip/hip_runtime.h>
#include <hip/hip_cooperative_groups.h>
#include <cstdio>
#include <cstdint>
namespace cg = cooperative_groups;

#ifndef DUP
#define DUP 0
#endif
#ifndef TSEL
#define TSEL (-1)
#endif
#ifndef ONE_LAUNCH
#define ONE_LAUNCH 1
#endif

constexpr int DM = 1024, SEQ = 8192, NB = 2, DEC_B = 32, DEC_T = 16, PAST = 2048;
constexpr int MP = NB * SEQ, MS = DEC_B * DEC_T, MT = MP + MS;
constexpr int DFF = 2816, NIN_RAW = 3592, NIN = 3584;
constexpr int SKV = PAST + DEC_T;
constexpr float RMS_EPS = 1e-6f;
constexpr float LOG2E = 1.4426950408889634f;
constexpr float QSCALE = 0.125f * LOG2E;
constexpr size_t O_YP = 0, O_YS = 16777216, O_KP = 17301504, O_VP = 34078720, O_LFP = 50855936, O_HSP = 51118080,
                 O_KS = 51380224, O_VS = 51904512, O_LFS = 52428800, O_HSS = 52436992, O_END = 56631296;
constexpr size_t MiB = 1u << 20;
constexpr size_t WS_CTL = 0, WS_WFG = 1 * MiB, WS_LB = 1 * MiB + 65536, WS_KTN = 1 * MiB + 131072, WS_G = 2 * MiB, WS_CP = 3 * MiB, WS_CS = 4 * MiB;
constexpr size_t WS_W1T = 8 * MiB, WS_W2T = 52 * MiB, WS_WINT = 74 * MiB, WS_WOT = 88 * MiB;
constexpr size_t WS_X = 92 * MiB, WS_HN = 158 * MiB, WS_ACT = 192 * MiB, WS_QB = 284 * MiB, WS_KB = 301 * MiB, WS_VB = 318 * MiB;
constexpr size_t WS_HF = 336 * MiB, WS_HB = 376 * MiB, WS_MIX = 468 * MiB, WS_US = 502 * MiB, WS_END = 566 * MiB, WS_PART = 760 * MiB;
constexpr size_t WS_RSTD = 1 * MiB + 262144, WS_SSP = 7 * MiB;
constexpr size_t W1T_SZ = (size_t)2 * DFF * DM, W2T_SZ = (size_t)DM * DFF, WINT_SZ = (size_t)NIN * DM, WOT_SZ = (size_t)DM * DM;

#define LAS __attribute__((address_space(3)))
typedef unsigned short bf16;
typedef short bf16x8 __attribute__((ext_vector_type(8)));
typedef float f32x4 __attribute__((ext_vector_type(4)));
typedef float f32x2 __attribute__((ext_vector_type(2)));
typedef unsigned v4u __attribute__((ext_vector_type(4)));
typedef unsigned v2u __attribute__((ext_vector_type(2)));
typedef __bf16 bf16x2_t __attribute__((ext_vector_type(2)));
__device__ __forceinline__ unsigned pk2(float lo, float hi) { f32x2 v = {lo, hi}; bf16x2_t b = __builtin_convertvector(v, bf16x2_t); return __builtin_bit_cast(unsigned, b); }
__device__ __forceinline__ bf16 f2bf(float f) { return (bf16)(pk2(f, 0.f) & 0xffffu); }
__device__ __forceinline__ float bf2f(bf16 h) { return __builtin_bit_cast(float, (unsigned)h << 16); }
__device__ __forceinline__ float fast_exp2(float x) { return __builtin_amdgcn_exp2f(x); }
__device__ __forceinline__ float sigmoidf_(float x) { return __builtin_amdgcn_rcpf(1.0f + __expf(-x)); }
__device__ __forceinline__ float siluf_(float x) { return x * __builtin_amdgcn_rcpf(1.0f + __expf(-x)); }
__device__ __forceinline__ float log_sigmoidf_(float x) { return fminf(x, 0.f) - log1pf(expf(-fabsf(x))); }
__device__ __forceinline__ float log_sigmoid_fast(float x) { return fminf(x, 0.f) - __logf(1.0f + __expf(-fabsf(x))); }
#define LDS_WAIT() asm volatile("s_waitcnt lgkmcnt(0)" ::: "memory")

namespace pg8 {
#define PG8_LAS __attribute__((address_space(3)))
typedef unsigned short bf16_t;
typedef short bf16x8 __attribute__((ext_vector_type(8)));
typedef float f32x4 __attribute__((ext_vector_type(4)));
typedef unsigned u32x4 __attribute__((ext_vector_type(4)));
constexpr int BM = 256, BK = 64, HALF = 128, HTB = HALF * BK * 2  , STAGE_BYTES = 8 * HTB, NXCD = 8, WGM = 8;

__host__ __device__ __forceinline__ int lds_byte(int r, int c) { const int st = (r >> 4) * 2 + (c >> 5), rr = r & 15, cc = c & 31, ob = rr * 64 + cc * 2; return st * 1024 + (ob ^ (((ob >> 9) & 1) << 5)); }
__host__ __device__ __forceinline__ void stage_rc(int b, int& R, int& C) { const int st = b / 1024, sb = b % 1024, swz = sb ^ (((sb >> 9) & 1) << 5); R = (st >> 1) * 16 + swz / 64; C = (st & 1) * 32 + (swz % 64) / 2; }
__host__ __device__ __forceinline__ int perm32(int rho) { const int n = rho >> 4, i = rho & 15; return 8 * (i >> 2) + 4 * n + (i & 3); }

struct Unit { int pm, pn, k0, nt; };
struct Gemm { const bf16_t* A; const bf16_t* Bt; int M, N, K; };

struct StaticOrder {
    int nM, nN, nwg, G, c;
    __host__ __device__ __forceinline__ void init(int M, int N, int G_, int c_) { nM = M / BM; nN = N / BM; nwg = nM * nN; G = G_; c = c_; }
    __host__ __device__ __forceinline__ bool next(int i, Unit& u) const {
        u.pm = 0; u.pn = 0; u.k0 = 0; u.nt = 0;
        const long L = (long)i * G + c; if (L >= nwg) return false;
        int wgid = (int)L; { const int q = nwg / NXCD, r = nwg % NXCD, xcd = wgid % NXCD, off = wgid / NXCD; wgid = (xcd < r ? xcd * (q + 1) : r * (q + 1) + (xcd - r) * q) + off; }
        const int nig = WGM * nN, gid = wgid / nig, fm = gid * WGM, gsz = (nM - fm) < WGM ? (nM - fm) : WGM;
        u.pm = fm + ((wgid % nig) % gsz); u.pn = (wgid % nig) / gsz; u.k0 = 0; u.nt = 0; return true;
    }
    __device__ __forceinline__ void a_ready(const Unit&) const {}
    __device__ __forceinline__ void done(const Unit&) const {}
};

struct SplitOrder {
    StaticOrder base; int R, G, c, ntf;
    __host__ __device__ __forceinline__ void init(int Mprompt, int N, int G_, int c_, int ntf_) { base.init(Mprompt, N, G_, c_); G = G_; c = c_; ntf = ntf_; R = (base.nwg + G - 1) / G; }
    __host__ __device__ __forceinline__ bool next(int i, Unit& u) const {
        if (i < R) { if (base.next(i, u)) return true; }
        const int idle = R * G - base.nwg;
        const int j = (i < R) ? (c - (G - idle)) : ((i - R) * G + c + idle);
        if (i < R - 1 || j < 0 || j >= 32) return false;
        const int us = j >> 2, p = j & 3, bs = (ntf / 4) & ~1, rem2 = (ntf - 4 * bs) / 2;
        u.pm = base.nM + (us >> 2); u.pn = us & 3; u.nt = (bs + (p < rem2 ? 2 : 0)) | (p << 16); u.k0 = p * bs + 2 * (p < rem2 ? p : rem2); return true;
    }
    __device__ __forceinline__ void a_ready(const Unit&) const {}
    __device__ __forceinline__ void done(const Unit&) const {}
};

struct EpiSwiglu {
    static constexpr bool PERM = true, AFTER_DRAIN = false;
    bf16_t* O; const float* RSTD;
    __device__ __forceinline__ void operator()(const f32x4 (&acc)[2][2][4][2], const Unit& u, int wr, int wc, int fr, int fq) const {
        const int row0 = u.pm * BM + wr * 64 + fr, col0 = u.pn * 128 + wc * 32 + 8 * fq;
#pragma unroll
        for (int ai = 0; ai < 2; ++ai)
#pragma unroll
            for (int m = 0; m < 4; ++m) {
                f32x4 a0 = acc[ai][0][m][0], a1 = acc[ai][0][m][1], b0 = acc[ai][1][m][0], b1 = acc[ai][1][m][1];
                if (RSTD) { const float r = RSTD[row0 + ai * HALF + m * 16]; a0 = a0 * r; a1 = a1 * r; b0 = b0 * r; b1 = b1 * r; }
                u32x4 w;
                w.x = ::pk2(::siluf_(a0[0]) * b0[0], ::siluf_(a0[1]) * b0[1]); w.y = ::pk2(::siluf_(a0[2]) * b0[2], ::siluf_(a0[3]) * b0[3]);
                w.z = ::pk2(::siluf_(a1[0]) * b1[0], ::siluf_(a1[1]) * b1[1]); w.w = ::pk2(::siluf_(a1[2]) * b1[2], ::siluf_(a1[3]) * b1[3]);
                *(u32x4*)(O + (size_t)(row0 + ai * HALF + m * 16) * ::DFF + col0) = w;
            }
    }
};
struct EpiRes {
    static constexpr bool PERM = true, AFTER_DRAIN = false;
    float* X; const float* BASE; float* PART; float scale; bf16_t* HNO; const float* GN; float* SSP;
    __device__ __forceinline__ void operator()(const f32x4 (&acc)[2][2][4][2], const Unit& u, int wr, int wc, int fr, int fq) const {
        const int row0 = u.pm * BM + wr * 64 + fr, col0 = u.pn * BM + wc * 32 + 8 * fq;
        float* base = u.nt ? PART + (ptrdiff_t)((u.nt >> 16) * ::MS - ::MP) * ::DM : X; const ptrdiff_t boff = BASE - X;
        const bool fuse = (HNO != nullptr) && (u.nt == 0);
        f32x4 gv[2][2];
        if (fuse) {
#pragma unroll
            for (int bj = 0; bj < 2; ++bj)
#pragma unroll
                for (int n = 0; n < 2; ++n) gv[bj][n] = *(const f32x4*)(GN + col0 + bj * HALF + n * 4); }
#pragma unroll
        for (int ai = 0; ai < 2; ++ai)
#pragma unroll
            for (int m = 0; m < 4; ++m) { const int row = row0 + ai * HALF + m * 16; float* rowp = base + (size_t)row * ::DM + col0; float ss = 0.f;
#pragma unroll
                for (int bj = 0; bj < 2; ++bj) { f32x4* p = (f32x4*)(rowp + bj * HALF);
                    if (u.nt) { p[0] = acc[ai][bj][m][0]; p[1] = acc[ai][bj][m][1]; }
                    else { const f32x4* q = (const f32x4*)((const float*)p + boff);
                        const f32x4 x0 = q[0] + acc[ai][bj][m][0] * scale, x1 = q[1] + acc[ai][bj][m][1] * scale; p[0] = x0; p[1] = x1;
                        if (fuse) { ss += ((x0[0] * x0[0] + x0[1] * x0[1]) + (x0[2] * x0[2] + x0[3] * x0[3])) + ((x1[0] * x1[0] + x1[1] * x1[1]) + (x1[2] * x1[2] + x1[3] * x1[3]));
                            const f32x4 h0 = x0 * gv[bj][0], h1 = x1 * gv[bj][1]; u32x4 w; w.x = ::pk2(h0[0], h0[1]); w.y = ::pk2(h0[2], h0[3]); w.z = ::pk2(h1[0], h1[1]); w.w = ::pk2(h1[2], h1[3]);
                            *(u32x4*)(HNO + (size_t)row * ::DM + col0 + bj * HALF) = w; } } }
                if (fuse) { ss += __shfl_xor(ss, 16); ss += __shfl_xor(ss, 32); if (fq == 0) SSP[(size_t)row * 16 + u.pn * 4 + wc] = ss; } }
    }
};
struct EpiInProj {
    static constexpr bool PERM = true, AFTER_DRAIN = false;
    bf16_t *Q, *K, *V; float* HF; bf16_t* HB; float* out; int l;
    __device__ __forceinline__ void operator()(const f32x4 (&acc)[2][2][4][2], const Unit& u, int wr, int wc, int fr, int fq) const {
        const int seg = u.pn >> 1, cbase = (u.pn & 1) * 256 + wc * 32 + 8 * fq, row0 = u.pm * BM + wr * 64 + fr;
#pragma unroll
        for (int ai = 0; ai < 2; ++ai)
#pragma unroll
            for (int m = 0; m < 4; ++m) { const int row = row0 + ai * HALF + m * 16;
#pragma unroll
                for (int bj = 0; bj < 2; ++bj) { const int cs = cbase + bj * HALF; f32x4 v0 = acc[ai][bj][m][0], v1 = acc[ai][bj][m][1];
                    if (seg == 0) { v0 = v0 * ::QSCALE; v1 = v1 * ::QSCALE; u32x4 w; w.x = ::pk2(v0[0], v0[1]); w.y = ::pk2(v0[2], v0[3]); w.z = ::pk2(v1[0], v1[1]); w.w = ::pk2(v1[2], v1[3]);
                        *(u32x4*)(Q + (size_t)row * 512 + cs) = w; }
                    else if (seg <= 2) { u32x4 w; w.x = ::pk2(v0[0], v0[1]); w.y = ::pk2(v0[2], v0[3]); w.z = ::pk2(v1[0], v1[1]); w.w = ::pk2(v1[2], v1[3]);
                        *(u32x4*)((seg == 1 ? K : V) + (size_t)row * 512 + cs) = w;
                        const int head = cs >> 6, d = cs & 63; size_t o;
                        if (row < ::MP) { const int b = row >> 13, t = row & 8191; o = (seg == 1 ? ::O_KP : ::O_VP) + ((((size_t)l * 2 + b) * 8 + head) * 8192 + t) * 64 + d; }
                        else { const int rs = row - ::MP, b = rs >> 4, t = rs & 15; o = (seg == 1 ? ::O_KS : ::O_VS) + ((((size_t)l * 32 + b) * 8 + head) * 16 + t) * 64 + d; }
                        __builtin_nontemporal_store(v0, (f32x4*)(out + o)); __builtin_nontemporal_store(v1, (f32x4*)(out + o + 4)); }
                    else if (seg == 4) { float* hp = HF + (size_t)row * 512 + cs; *(f32x4*)hp = v0; *(f32x4*)(hp + 4) = v1; }
                    else { if (seg == 3) { v0 = (f32x4){::siluf_(v0[0]), ::siluf_(v0[1]), ::siluf_(v0[2]), ::siluf_(v0[3])}; v1 = (f32x4){::siluf_(v1[0]), ::siluf_(v1[1]), ::siluf_(v1[2]), ::siluf_(v1[3])}; }
                        u32x4 w; w.x = ::pk2(v0[0], v0[1]); w.y = ::pk2(v0[2], v0[3]); w.z = ::pk2(v1[0], v1[1]); w.w = ::pk2(v1[2], v1[3]);
                        *(u32x4*)(HB + (size_t)row * 1536 + (seg == 3 ? 0 : (seg == 5 ? 512 : 1024)) + cs) = w; }
                } }
    }
};
template <class Epi, class Sched, bool ALIGN_EPI = false, bool SP2 = false>
__device__ __forceinline__ void gemm_phase(PG8_LAS unsigned char* lds, const Gemm g, const Sched& S, const Epi& E) {
    const int tid = threadIdx.x, wid = __builtin_amdgcn_readfirstlane(tid >> 6), lane = tid & 63, wr = wid >> 2, wc = wid & 3, fr = lane & 15, fq = lane >> 4;
    const int K = g.K, ntf = K / BK;
    unsigned voffA[2], voffB[2];
#pragma unroll
    for (int i = 0; i < 2; ++i) { int R, C; stage_rc(tid * 16 + i * 8192, R, C); const int Rb = Epi::PERM ? ((R & ~31) + perm32(R & 31)) : R;
        voffA[i] = (unsigned)(R * K + C) * 2u; voffB[i] = (unsigned)(Rb * K + C) * 2u; }
    const size_t kstep = (size_t)(BK * 2);
    const size_t hstep = (size_t)HALF * K * 2;
    const size_t tstep = 2 * hstep;
    const unsigned ldsw = (unsigned)wid * 1024u;
    const int aoff = lds_byte(wr * 64 + fr, fq * 8), boff = lds_byte(wc * 32 + fr, fq * 8);
#define PG8_SA(b, h) (((b) * 2 + (h)) * HTB)
#define PG8_SB(b, h) ((4 + (b) * 2 + (h)) * HTB)
#define PG8_STAGE(bufoff, gbase, voff) do { _Pragma("unroll") for (int _i = 0; _i < 2; ++_i) \
        __builtin_amdgcn_global_load_lds((const unsigned*)((const char*)(gbase) + (voff)[_i]), (PG8_LAS unsigned*)(lds + (bufoff) + ldsw + _i * 8192), 16, 0, 0); } while (0)
#define PG8_LDA(dst, b, h) do { _Pragma("unroll") for (int m = 0; m < 4; ++m) _Pragma("unroll") for (int k = 0; k < 2; ++k) dst[m][k] = *(const PG8_LAS bf16x8*)(lds + PG8_SA(b, h) + aoff + m * 2048 + k * 1024); } while (0)
#define PG8_LDB(dst, b, h) do { _Pragma("unroll") for (int n = 0; n < 2; ++n) _Pragma("unroll") for (int k = 0; k < 2; ++k) dst[n][k] = *(const PG8_LAS bf16x8*)(lds + PG8_SB(b, h) + boff + n * 2048 + k * 1024); } while (0)
#define PG8_MMA(ai, bj, At, Bt) do { __builtin_amdgcn_s_setprio(1); _Pragma("unroll") for (int m = 0; m < 4; ++m) _Pragma("unroll") for (int n = 0; n < 2; ++n) _Pragma("unroll") for (int k = 0; k < 2; ++k) \
        acc[ai][bj][m][n] = __builtin_amdgcn_mfma_f32_16x16x32_bf16(Bt[n][k], At[m][k], acc[ai][bj][m][n], 0, 0, 0); __builtin_amdgcn_s_setprio(0); } while (0)
#define PG8_WAIT_V(n) asm volatile("s_waitcnt vmcnt(" #n ")" ::: "memory")
#define PG8_WAIT_L(n) asm volatile("s_waitcnt lgkmcnt(" #n ")" ::: "memory")
#define PG8_BAR __builtin_amdgcn_s_barrier()
#define PG8_SCHED __builtin_amdgcn_sched_barrier(0)
    Unit cur{0, 0, 0, 0}, nxt{0, 0, 0, 0}; int ui = 0;
    if (!S.next(0, cur)) return;
    f32x4 acc[2][2][4][2];
#pragma unroll
    for (int a = 0; a < 2; ++a)
#pragma unroll
        for (int b = 0; b < 2; ++b)
#pragma unroll
            for (int m = 0; m < 4; ++m)
#pragma unroll
                for (int n = 0; n < 2; ++n) acc[a][b][m][n] = (f32x4){0.f, 0.f, 0.f, 0.f};
    bf16x8 At[4][2], B0[2][2], B1[2][2];
    const char* cA = (const char*)g.A + (size_t)cur.pm * tstep + (size_t)cur.k0 * kstep; const char* cB = (const char*)g.Bt + (size_t)cur.pn * tstep + (size_t)cur.k0 * kstep; int nt = cur.nt ? (cur.nt & 0xffff) : ntf;
    S.a_ready(cur);
    if constexpr (SP2) {
        PG8_STAGE(PG8_SB(0, 0), cB, voffB); PG8_STAGE(PG8_SB(0, 1), cB + hstep, voffB); PG8_STAGE(PG8_SA(0, 0), cA, voffA); PG8_STAGE(PG8_SA(0, 1), cA + hstep, voffA);
        if (wr == 1) PG8_BAR;
        PG8_WAIT_V(2); PG8_BAR;
        PG8_STAGE(PG8_SB(1, 0), cB + kstep, voffB); PG8_STAGE(PG8_SA(1, 0), cA + kstep, voffA); PG8_STAGE(PG8_SB(1, 1), cB + hstep + kstep, voffB);
        PG8_WAIT_V(6); PG8_BAR;
    } else {
        PG8_STAGE(PG8_SB(0, 0), cB, voffB); PG8_STAGE(PG8_SA(0, 0), cA, voffA); PG8_STAGE(PG8_SB(0, 1), cB + hstep, voffB); PG8_STAGE(PG8_SA(0, 1), cA + hstep, voffA);
        if (wr == 1) PG8_BAR;
        PG8_WAIT_V(4); PG8_BAR;
        PG8_STAGE(PG8_SB(1, 0), cB + kstep, voffB); PG8_STAGE(PG8_SA(1, 0), cA + kstep, voffA); PG8_STAGE(PG8_SB(1, 1), cB + hstep + kstep, voffB);
        PG8_WAIT_V(6); PG8_BAR;
    }
    for (;;) {
        const bool has_next = S.next(ui + 1, nxt);
        const char* nA = has_next ? (const char*)g.A + (size_t)nxt.pm * tstep + (size_t)nxt.k0 * kstep : cA; const char* nB = has_next ? (const char*)g.Bt + (size_t)nxt.pn * tstep + (size_t)nxt.k0 * kstep : cB;
        for (int t = 0; t < nt; t += 2) {
            const bool last = (t == nt - 2);
            const char* a1 = cA + (size_t)(t + 1) * kstep;
            const char* a2 = last ? nA : cA + (size_t)(t + 2) * kstep; const char* b2 = last ? nB : cB + (size_t)(t + 2) * kstep;
            const char* a3 = a2 + kstep; const char* b3 = b2 + kstep;
            if (last && has_next) S.a_ready(nxt);
            if constexpr (SP2) {
            PG8_LDB(B0, 0, 0); PG8_LDB(B1, 0, 1); PG8_SCHED; PG8_LDA(At, 0, 0); PG8_STAGE(PG8_SA(1, 1), a1 + hstep, voffA);
            PG8_WAIT_V(8); PG8_WAIT_L(0); PG8_BAR; PG8_MMA(0, 0, At, B0); PG8_MMA(0, 1, At, B1); PG8_BAR; PG8_SCHED;
            PG8_LDA(At, 0, 1); PG8_STAGE(PG8_SB(0, 0), b2, voffB); PG8_STAGE(PG8_SB(0, 1), b2 + hstep, voffB); PG8_STAGE(PG8_SA(0, 0), a2, voffA);
            PG8_WAIT_V(8); PG8_WAIT_L(0); PG8_BAR; PG8_MMA(1, 0, At, B0); PG8_MMA(1, 1, At, B1); PG8_BAR; PG8_SCHED;
            PG8_LDB(B0, 1, 0); PG8_LDB(B1, 1, 1); PG8_SCHED; PG8_LDA(At, 1, 0); PG8_STAGE(PG8_SA(0, 1), a2 + hstep, voffA);
            PG8_WAIT_V(8); PG8_WAIT_L(0); PG8_BAR; PG8_MMA(0, 0, At, B0); PG8_MMA(0, 1, At, B1); PG8_BAR; PG8_SCHED;
            PG8_LDA(At, 1, 1); PG8_STAGE(PG8_SB(1, 0), b3, voffB); PG8_STAGE(PG8_SB(1, 1), b3 + hstep, voffB); PG8_STAGE(PG8_SA(1, 0), a3, voffA);
            PG8_WAIT_V(8); PG8_WAIT_L(0); PG8_BAR; PG8_MMA(1, 0, At, B0); PG8_MMA(1, 1, At, B1); PG8_BAR; PG8_SCHED;
            } else {
            PG8_LDB(B0, 0, 0); PG8_SCHED; PG8_LDA(At, 0, 0); PG8_STAGE(PG8_SA(1, 1), a1 + hstep, voffA);
            PG8_WAIT_L(8); PG8_BAR; PG8_WAIT_L(0); PG8_MMA(0, 0, At, B0); PG8_BAR; PG8_SCHED;
            PG8_LDB(B1, 0, 1); PG8_STAGE(PG8_SB(0, 0), b2, voffB);
            PG8_BAR; PG8_WAIT_L(0); PG8_MMA(0, 1, At, B1); PG8_BAR;
            PG8_LDA(At, 0, 1); PG8_STAGE(PG8_SA(0, 0), a2, voffA);
            PG8_BAR; PG8_WAIT_L(0); PG8_MMA(1, 0, At, B0); PG8_BAR; PG8_SCHED;
            PG8_STAGE(PG8_SB(0, 1), b2 + hstep, voffB);
            PG8_WAIT_V(6); PG8_BAR; PG8_MMA(1, 1, At, B1); PG8_BAR;
            PG8_LDB(B0, 1, 0); PG8_SCHED; PG8_LDA(At, 1, 0); PG8_STAGE(PG8_SA(0, 1), a2 + hstep, voffA);
            PG8_WAIT_L(8); PG8_BAR; PG8_WAIT_L(0); PG8_MMA(0, 0, At, B0); PG8_BAR; PG8_SCHED;
            PG8_LDB(B1, 1, 1); PG8_STAGE(PG8_SB(1, 0), b3, voffB);
            PG8_BAR; PG8_WAIT_L(0); PG8_MMA(0, 1, At, B1); PG8_BAR;
            PG8_LDA(At, 1, 1); PG8_STAGE(PG8_SA(1, 0), a3, voffA);
            PG8_BAR; PG8_WAIT_L(0); PG8_MMA(1, 0, At, B0); PG8_BAR; PG8_SCHED;
            PG8_STAGE(PG8_SB(1, 1), b3 + hstep, voffB);
            PG8_WAIT_V(6); PG8_BAR; PG8_MMA(1, 1, At, B1); PG8_BAR;
            }
        }
        if constexpr (ALIGN_EPI) { if (wr == 0) PG8_BAR; }
        if constexpr (!Epi::AFTER_DRAIN) { E(acc, cur, wr, wc, fr, fq); S.done(cur); }
        if (!has_next) break;
#pragma unroll
        for (int a = 0; a < 2; ++a)
#pragma unroll
            for (int b = 0; b < 2; ++b)
#pragma unroll
                for (int m = 0; m < 4; ++m)
#pragma unroll
                    for (int n = 0; n < 2; ++n) acc[a][b][m][n] = (f32x4){0.f, 0.f, 0.f, 0.f};
        cur = nxt; cA = nA; cB = nB; ++ui; nt = cur.nt ? (cur.nt & 0xffff) : ntf;
        if constexpr (ALIGN_EPI) { if (wr == 1) PG8_BAR; }
    }
    PG8_WAIT_V(0);
    if constexpr (!ALIGN_EPI) { if (wr == 0) PG8_BAR; }
    PG8_BAR;
    if constexpr (Epi::AFTER_DRAIN) { E.fused(acc, cur, wr, wc, fr, fq, lds, wid, lane); S.done(cur); }
#undef PG8_SA
#undef PG8_SB
#undef PG8_STAGE
#undef PG8_LDA
#undef PG8_LDB
#undef PG8_MMA
#undef PG8_WAIT_V
#undef PG8_WAIT_L
#undef PG8_BAR
#undef PG8_SCHED
}
}

constexpr int NWAVES = 8, NTHR = 512;
constexpr int RING_BYTES = 131072, LDS_BYTES = 147456;
struct Params { const float* in[19]; float* out; unsigned char* ws; int ph_lo, ph_hi; };

struct Ctx {
    LAS unsigned char* lds;
    int tid, lane, wave, G, bid;
    const float* in[19]; float* out; unsigned char* ws;
};
#define CTX_GW(C) ((C).bid * NWAVES + (C).wave)
#define CTX_NGW(C) ((C).G * NWAVES)

__device__ __forceinline__ float wave_sum(float v) {
#pragma unroll
    for (int o = 1; o < 64; o <<= 1) v += __shfl_xor(v, o);
    return v;
}
__device__ __forceinline__ float wave_max(float v) {
#pragma unroll
    for (int o = 1; o < 64; o <<= 1) v = fmaxf(v, __shfl_xor(v, o));
    return v;
}
__device__ __forceinline__ f32x4 mfma16(bf16x8 a, bf16x8 b, f32x4 c) { return __builtin_amdgcn_mfma_f32_16x16x32_bf16(a, b, c, 0, 0, 0); }

__device__ __forceinline__ void transpose_item(const float* W, int K, int N, int srccol0, bf16* WT, int dstrow0, int k0, LAS float* scr, int lane) {
#pragma unroll 8
    for (int i = 0; i < 32; ++i) { const int kk = 2 * i + (lane >> 5); scr[kk * 33 + (lane & 31)] = __builtin_nontemporal_load(W + (size_t)(k0 + kk) * N + srccol0 + (lane & 31)); }
    LDS_WAIT();
    const int c = lane & 7;
#pragma unroll
    for (int j = 0; j < 4; ++j) { const int n = (lane >> 3) + 8 * j; const LAS float* s = scr + (8 * c) * 33 + n;
        v4u o; o.x = pk2(s[0 * 33], s[1 * 33]); o.y = pk2(s[2 * 33], s[3 * 33]); o.z = pk2(s[4 * 33], s[5 * 33]); o.w = pk2(s[6 * 33], s[7 * 33]);
        *(v4u*)(WT + (size_t)(dstrow0 + n) * K + k0 + 8 * c) = o; }
    LDS_WAIT();
}
__device__ __forceinline__ void phase_prologue(Ctx& C) {
    LAS float* scr = (LAS float*)(C.lds + C.wave * 16384);
    const int gw = CTX_GW(C), NGW = CTX_NGW(C);
    constexpr int I_UP = 16 * 176, I_DN = 44 * 32, I_IN = 16 * 112, I_OUT = 16 * 32, I_LAYER = 2 * I_UP + 2 * I_DN + I_IN + I_OUT;
    for (int it = gw; it < 2 * I_LAYER; it += NGW) {
        const int l = it / I_LAYER; int r = it % I_LAYER;
        int which;
        if (r < I_UP) which = 0; else if ((r -= I_UP) < I_DN) which = 1; else if ((r -= I_DN) < I_IN) which = 2; else if ((r -= I_IN) < I_OUT) which = 3; else if ((r -= I_OUT) < I_UP) which = 4; else { r -= I_UP; which = 5; }
        if (which == 0 || which == 4) {
            const int nb = r % 176, kb = r / 176, d0 = nb * 32, pn = d0 >> 8, w = d0 & 255;
            const int src = (w < 128) ? (128 * pn + w) : (DFF + 128 * pn + (w - 128));
            const float* W = C.in[which == 0 ? 7 : 16] + (size_t)l * DM * 2 * DFF;
            bf16* WT = (bf16*)(C.ws + WS_W1T) + (size_t)(l * 2 + (which == 4)) * W1T_SZ;
            transpose_item(W, DM, 2 * DFF, src, WT, d0, kb * 64, scr, C.lane);
        } else if (which == 1 || which == 5) {
            const int nb = r % 32, kb = r / 32;
            const float* W = C.in[which == 1 ? 8 : 17] + (size_t)l * DFF * DM;
            bf16* WT = (bf16*)(C.ws + WS_W2T) + (size_t)(l * 2 + (which == 5)) * W2T_SZ;
            transpose_item(W, DFF, DM, nb * 32, WT, nb * 32, kb * 64, scr, C.lane);
        } else if (which == 2) {
            const int nb = r % 112, kb = r / 112, d0 = nb * 32, src = d0 < 1536 ? d0 : d0 + 8;
            transpose_item(C.in[10] + (size_t)l * DM * NIN_RAW, DM, NIN_RAW, src, (bf16*)(C.ws + WS_WINT) + (size_t)l * WINT_SZ, d0, kb * 64, scr, C.lane);
        } else {
            const int nb = r % 32, kb = r / 32;
            transpose_item(C.in[14] + (size_t)l * DM * DM, DM, DM, nb * 32, (bf16*)(C.ws + WS_WOT) + (size_t)l * WOT_SZ, nb * 32, kb * 64, scr, C.lane);
        }
    }
    const int gt = C.bid * NTHR + C.tid, NGT = C.G * NTHR;
    float* WFG = (float*)(C.ws + WS_WFG);
    for (int i = gt; i < 2 * 8 * DM; i += NGT) { const int l = i >> 13, j = (i >> 10) & 7, k = i & 1023; WFG[i] = C.in[10][((size_t)l * DM + k) * NIN_RAW + 1536 + j]; }
    float* LB = (float*)(C.ws + WS_LB);
    for (int i = gt; i < 512; i += NGT) { const float p0 = C.in[12][i], p1 = C.in[12][512 + i], mx = fmaxf(p0, p1), e0 = expf(p0 - mx), e1 = expf(p1 - mx);
        LB[i] = 0.f; LB[512 + i] = e1 / (e0 + e1); }
}

template <int MODE> __device__ __forceinline__ void phase_rms(Ctx& C, const float* g, int l, float pend, int src) {
    const int gw = CTX_GW(C), NGW = CTX_NGW(C), lane = C.lane;
    float* X = (float*)(C.ws + WS_X); bf16* HN = (bf16*)(C.ws + WS_HN); const float* PART = (const float*)(C.ws + WS_PART);
    f32x4 gv[4];
#pragma unroll
    for (int j = 0; j < 4; ++j) gv[j] = ((const f32x4*)g)[lane + 64 * j];
    f32x4 wfg[8][4];
    if (MODE == 1) { const float* WFG = (const float*)(C.ws + WS_WFG) + (size_t)l * 8 * DM;
#pragma unroll
        for (int jj = 0; jj < 8; ++jj)
#pragma unroll
            for (int j = 0; j < 4; ++j) wfg[jj][j] = ((const f32x4*)(WFG + jj * DM))[lane + 64 * j]; }
#define RMS_XROW(r) (((src == 1 && (r) < MP) ? C.in[0] + (size_t)(r) * DM : ((src != 0 && (r) >= MP) ? C.in[1] + (size_t)((r) - MP) * DM : X + (size_t)(r) * DM)))
    f32x4 nv[4];
    if (gw < MT) { const f32x4* xr0 = (const f32x4*)RMS_XROW(gw) + lane;
#pragma unroll
        for (int j = 0; j < 4; ++j) nv[j] = xr0[64 * j]; }
    for (int row = gw; row < MT; row += NGW) {
        f32x4 v[4]; float s = 0.f;
#pragma unroll
        for (int j = 0; j < 4; ++j) v[j] = nv[j];
        if (row + NGW < MT) { const f32x4* xr1 = (const f32x4*)RMS_XROW(row + NGW) + lane;
#pragma unroll
            for (int j = 0; j < 4; ++j) nv[j] = xr1[64 * j]; }
        if (pend != 0.f && row >= MP) {
#pragma unroll
            for (int j = 0; j < 4; ++j) { const f32x4* pp = (const f32x4*)(PART + (size_t)(row - MP) * DM) + lane + 64 * j;
                v[j] = v[j] + ((pp[0] + pp[MS * DM / 4]) + (pp[2 * MS * DM / 4] + pp[3 * MS * DM / 4])) * pend;
                ((f32x4*)(X + (size_t)row * DM))[lane + 64 * j] = v[j]; } }
#pragma unroll
        for (int j = 0; j < 4; ++j) s += (v[j].x * v[j].x + v[j].y * v[j].y) + (v[j].z * v[j].z + v[j].w * v[j].w);
        const float rstd = 1.0f / sqrtf(wave_sum(s) * (1.0f / DM) + RMS_EPS);
#pragma unroll
        for (int j = 0; j < 4; ++j) v[j] = v[j] * rstd * gv[j];
        if (MODE == 2) {
            float* o = C.out + (row < MP ? O_YP + (size_t)row * DM : O_YS + (size_t)(row - MP) * DM);
#pragma unroll
            for (int j = 0; j < 4; ++j) __builtin_nontemporal_store(v[j], (f32x4*)o + lane + 64 * j);
        } else {
            v2u* o8 = (v2u*)(HN + (size_t)row * DM) + lane;
#pragma unroll
            for (int j = 0; j < 4; ++j) { v2u w; w.x = pk2(v[j].x, v[j].y); w.y = pk2(v[j].z, v[j].w); o8[64 * j] = w; }
        }
        if (MODE == 1) {
            float fg[8];
#pragma unroll
            for (int jj = 0; jj < 8; ++jj) { float a = 0.f;
#pragma unroll
                for (int j = 0; j < 4; ++j) { const f32x4 w = wfg[jj][j]; a += (v[j].x * w.x + v[j].y * w.y) + (v[j].z * w.z + v[j].w * w.w); }
                fg[jj] = wave_sum(a); }
            float mine = fg[0];
#pragma unroll
            for (int jj = 1; jj < 8; ++jj) mine = (lane == jj) ? fg[jj] : mine;
            if (lane < 8) { const float lf = log_sigmoidf_(mine + C.in[11][l * 8 + lane]);
                size_t o;
                if (row < MP) { const int b = row >> 13, t = row & 8191; o = O_LFP + (((size_t)l * 2 + b) * 8 + lane) * 8192 + t; }
                else { const int rs = row - MP, b = rs >> 4, t = rs & 15; o = O_LFS + (((size_t)l * 32 + b) * 8 + lane) * 16 + t; }
                C.out[o] = lf; }
        }
    }
}

__device__ __forceinline__ void phase_rms_mini(Ctx& C, const float* g, float pend) {
    float* RSTD = (float*)(C.ws + WS_RSTD); const float* SSP = (const float*)(C.ws + WS_SSP);
    for (int r = C.bid * NTHR + C.tid; r < MP; r += C.G * NTHR) { const f32x4* p = (const f32x4*)(SSP + (size_t)r * 16);
        const f32x4 s4 = (p[0] + p[1]) + (p[2] + p[3]); RSTD[r] = 1.0f / sqrtf(((s4.x + s4.y) + (s4.z + s4.w)) * (1.0f / DM) + RMS_EPS); }
    const int gw = CTX_GW(C), NGW = CTX_NGW(C), lane = C.lane;
    float* X = (float*)(C.ws + WS_X); bf16* HN = (bf16*)(C.ws + WS_HN); const float* PART = (const float*)(C.ws + WS_PART);
    for (int row = MP + gw; row < MT; row += NGW) {
        f32x4 v[4]; float s = 0.f;
#pragma unroll
        for (int j = 0; j < 4; ++j) { const f32x4* pp = (const f32x4*)(PART + (size_t)(row - MP) * DM) + lane + 64 * j;
            v[j] = ((const f32x4*)(X + (size_t)row * DM))[lane + 64 * j] + ((pp[0] + pp[MS * DM / 4]) + (pp[2 * MS * DM / 4] + pp[3 * MS * DM / 4])) * pend;
            ((f32x4*)(X + (size_t)row * DM))[lane + 64 * j] = v[j];
            s += (v[j].x * v[j].x + v[j].y * v[j].y) + (v[j].z * v[j].z + v[j].w * v[j].w); }
        const float rstd = 1.0f / sqrtf(wave_sum(s) * (1.0f / DM) + RMS_EPS);
        if (lane == 0) RSTD[row] = rstd;
        v2u* o8 = (v2u*)(HN + (size_t)row * DM) + lane;
#pragma unroll
        for (int j = 0; j < 4; ++j) { const f32x4 gj = ((const f32x4*)g)[lane + 64 * j]; const f32x4 h = v[j] * gj; v2u w; w.x = pk2(h.x, h.y); w.y = pk2(h.z, h.w); o8[64 * j] = w; }
    }
}

constexpr int HL_LF = 0, HL_SEG = 32768, HL_QT = 34816, HL_KTL = HL_QT + 17408, HL_VT = HL_KTL + 17408, HL_ST = HL_VT + 18432, HL_AS = HL_ST + 34816, HL_KH = HL_AS + 9216, HL_END = HL_KH + 10240;
static_assert(HL_END <= LDS_BYTES - 1024, "HGRN LDS map");
constexpr int HP_Q = 136, HP_V = 72, HP_O = 132;

template <int CH> __device__ __forceinline__ void hgrn_decay_prefix(Ctx& C, const float* HF, int row0, int h, const float* lb) {
    LAS float* LF = (LAS float*)(C.lds + HL_LF); LAS float* SEG = (LAS float*)(C.lds + HL_SEG);
    const int tid = C.tid;
#pragma unroll
    for (int idx = tid; idx < CH * 128; idx += NTHR) { const int s = idx >> 7, d = idx & 127;
        const float z = HF[(size_t)(row0 + s) * 512 + h * 128 + d], lbv = lb[d];
        LF[idx] = (lbv == 0.f) ? log_sigmoid_fast(z) : __logf(lbv + (1.f - lbv) * sigmoidf_(z)); }
    __syncthreads();
    const int seg = tid >> 7, d = tid & 127; constexpr int R = CH / 4;
    float run = 0.f;
#pragma unroll
    for (int i = 0; i < R; ++i) { run += LF[(seg * R + i) * 128 + d]; LF[(seg * R + i) * 128 + d] = run; }
    SEG[seg * 128 + d] = run;
    __syncthreads();
    float off = 0.f;
#pragma unroll
    for (int s2 = 0; s2 < 3; ++s2) if (s2 < seg) off += SEG[s2 * 128 + d];
#pragma unroll
    for (int i = 0; i < R; ++i) LF[(seg * R + i) * 128 + d] += off;
    __syncthreads();
}

struct HRegs { float z[16]; bf16 q[16], v[16]; };
template <bool WITHQ> __device__ __forceinline__ void hgrn_load_regs(Ctx& C, HRegs& R, int unit) {
    const int bh = unit >> 7, c = unit & 127, b = bh >> 2, h = bh & 3, row0 = b * SEQ + c * 64, d = C.tid & 127, s0 = C.tid >> 7;
    const float* HF = (const float*)(C.ws + WS_HF) + (size_t)(row0 + s0) * 512 + h * 128 + d; const bf16* HB = (const bf16*)(C.ws + WS_HB) + (size_t)(row0 + s0) * 1536 + h * 128 + d;
#pragma unroll
    for (int i = 0; i < 16; ++i) { R.z[i] = HF[(size_t)i * 4 * 512]; R.v[i] = HB[(size_t)i * 4 * 1536 + 512]; if (WITHQ) R.q[i] = HB[(size_t)i * 4 * 1536]; }
}
__device__ __forceinline__ void hgrn_decay_prefix_regs(Ctx& C, const HRegs& R, const float* lb) {
    LAS float* LF = (LAS float*)(C.lds + HL_LF); LAS float* SEG = (LAS float*)(C.lds + HL_SEG);
    const int tid = C.tid; const float lbv = lb[tid & 127];
#pragma unroll
    for (int i = 0; i < 16; ++i) { const float z = R.z[i]; LF[tid + NTHR * i] = (lbv == 0.f) ? log_sigmoid_fast(z) : __logf(lbv + (1.f - lbv) * sigmoidf_(z)); }
    __syncthreads();
    const int seg = tid >> 7, d = tid & 127;
    float run = 0.f;
#pragma unroll
    for (int i = 0; i < 16; ++i) { run += LF[(seg * 16 + i) * 128 + d]; LF[(seg * 16 + i) * 128 + d] = run; }
    SEG[seg * 128 + d] = run;
    __syncthreads();
    float off = 0.f;
#pragma unroll
    for (int s2 = 0; s2 < 3; ++s2) if (s2 < seg) off += SEG[s2 * 128 + d];
#pragma unroll
    for (int i = 0; i < 16; ++i) LF[(seg * 16 + i) * 128 + d] += off;
    __syncthreads();
}

__device__ __forceinline__ void hgrn_local_unit(Ctx& C, int unit, int next_unit, int l, HRegs& R) {
    const int bh = unit >> 7, h = bh & 3;
    const float* lb = (const float*)(C.ws + WS_LB) + l * 512 + h * 128;
    hgrn_decay_prefix_regs(C, R, lb);
    LAS float* LF = (LAS float*)(C.lds + HL_LF);
    LAS bf16* KT = (LAS bf16*)(C.lds + HL_QT); LAS bf16* VT = (LAS bf16*)(C.lds + HL_VT);
    const int tid = C.tid, d = tid & 127, s0 = tid >> 7; const float oml = 1.f - lb[d], blast = LF[63 * 128 + d];
#pragma unroll
    for (int i = 0; i < 16; ++i) { const int s = s0 + 4 * i; const float k = oml * sigmoidf_(-R.z[i]);
        KT[d * HP_V + s] = f2bf(k * __expf(blast - LF[s * 128 + d])); VT[d * HP_V + s] = R.v[i]; }
    if (tid < 128) ((float*)(C.ws + WS_G))[(size_t)unit * 128 + tid] = __expf(blast);
    if (next_unit < 1024) hgrn_load_regs<false>(C, R, next_unit);
    __syncthreads();
    const int lane = C.lane, w = C.wave, r16 = lane & 15, quad = lane >> 4;
    f32x4 acc[8];
#pragma unroll
    for (int nb = 0; nb < 8; ++nb) acc[nb] = (f32x4){0.f, 0.f, 0.f, 0.f};
#pragma unroll
    for (int ks = 0; ks < 2; ++ks) { const bf16x8 a = *(const LAS bf16x8*)(VT + (w * 16 + r16) * HP_V + ks * 32 + quad * 8);
#pragma unroll
        for (int nb = 0; nb < 8; ++nb) { const bf16x8 bb = *(const LAS bf16x8*)(KT + (nb * 16 + r16) * HP_V + ks * 32 + quad * 8); acc[nb] = mfma16(a, bb, acc[nb]); } }
    bf16* US = (bf16*)(C.ws + WS_US) + (size_t)unit * 16384;
#pragma unroll
    for (int nb = 0; nb < 8; ++nb)
#pragma unroll
        for (int j = 0; j < 4; ++j) US[(w * 16 + quad * 4 + j) * 128 + nb * 16 + r16] = f2bf(acc[nb][j]);
    __syncthreads();
}

__device__ __forceinline__ void hgrn_scan(Ctx& C, int l) {
    bf16* US = (bf16*)(C.ws + WS_US); const float* Gg = (const float*)(C.ws + WS_G);
    for (int e = C.bid * NTHR + C.tid; e < 8 * 16384; e += C.G * NTHR) {
        const int bh = e >> 14, el = e & 16383, dk = el & 127, dv = el >> 7;
        bf16* p = US + (size_t)bh * 128 * 16384 + el; const float* gp = Gg + (size_t)bh * 128 * 128 + dk;
        float s = 0.f;
        bf16 u[2][8]; float g[2][8];
#pragma unroll
        for (int i = 0; i < 8; ++i) { u[0][i] = p[(size_t)i * 16384]; g[0][i] = gp[i * 128]; }
#pragma unroll 1
        for (int c0 = 0; c0 < 128; c0 += 16) {
#pragma unroll
            for (int i = 0; i < 8; ++i) { u[1][i] = p[(size_t)(c0 + 8 + i) * 16384]; g[1][i] = gp[(c0 + 8 + i) * 128]; }
#pragma unroll
            for (int i = 0; i < 8; ++i) { p[(size_t)(c0 + i) * 16384] = f2bf(s); s = g[0][i] * s + bf2f(u[0][i]); }
            if (c0 + 16 < 128) {
#pragma unroll
                for (int i = 0; i < 8; ++i) { u[0][i] = p[(size_t)(c0 + 16 + i) * 16384]; g[0][i] = gp[(c0 + 16 + i) * 128]; } }
#pragma unroll
            for (int i = 0; i < 8; ++i) { p[(size_t)(c0 + 8 + i) * 16384] = f2bf(s); s = g[1][i] * s + bf2f(u[1][i]); }
        }
        C.out[O_HSP + ((size_t)l * 8 + bh) * 16384 + dk * 128 + dv] = s;
    }
}

template <int CH> __device__ __forceinline__ void hgrn_out_unit(Ctx& C, int unit, int l) {
    int row0, h, bh; const float* Ssrc;
    if (CH == 64) { bh = unit >> 7; const int c = unit & 127, b = bh >> 2; h = bh & 3; row0 = b * SEQ + c * 64; Ssrc = nullptr; }
    else { bh = unit; const int b = unit >> 2; h = unit & 3; row0 = MP + b * 16; Ssrc = C.in[5] + ((size_t)l * 128 + unit) * 16384; }
    const float* HF = (const float*)(C.ws + WS_HF); const bf16* HB = (const bf16*)(C.ws + WS_HB); const float* lb = (const float*)(C.ws + WS_LB) + l * 512 + h * 128;
    hgrn_decay_prefix<CH>(C, HF, row0, h, lb);
    LAS float* LF = (LAS float*)(C.lds + HL_LF);
    LAS bf16* QT = (LAS bf16*)(C.lds + HL_QT); LAS bf16* KTL = (LAS bf16*)(C.lds + HL_KTL); LAS bf16* VT = (LAS bf16*)(C.lds + HL_VT);
    LAS bf16* ST = (LAS bf16*)(C.lds + HL_ST); LAS bf16* AS = (LAS bf16*)(C.lds + HL_AS);
    LAS bf16* KH = (LAS bf16*)(C.lds + HL_KH);
    LAS float* BL = (LAS float*)(C.lds + HL_SEG);
    const int tid = C.tid; constexpr int MID = CH / 2, SP = (CH < 32) ? 32 : CH;
    if (CH == 16) {
        for (int i = tid; i < 128 * 16; i += NTHR) { const int d = i >> 4, s = 16 + (i & 15); VT[d * HP_V + s] = 0; KH[d * 40 + s] = 0; if (d < 16) AS[d * HP_V + s] = 0; }
    }
#pragma unroll
    for (int idx = tid; idx < CH * 128; idx += NTHR) { const int s = idx >> 7, d = idx & 127;
        const bf16* hb = HB + (size_t)(row0 + s) * 1536 + h * 128 + d;
        const float q = bf2f(hb[0]), z = HF[(size_t)(row0 + s) * 512 + h * 128 + d], v = bf2f(hb[512]), k = (1.f - lb[d]) * sigmoidf_(-z);
        const float bs = LF[idx], r = LF[MID * 128 + d];
        QT[s * HP_Q + d] = f2bf(q * __expf(fminf(bs - r, 80.f))); KTL[s * HP_Q + d] = f2bf(k * __expf(fminf(r - bs, 80.f))); VT[d * HP_V + s] = f2bf(v);
        if (CH == 16) { KH[d * 40 + s] = f2bf(k * __expf(LF[(CH - 1) * 128 + d] - bs)); if (s == CH - 1) BL[d] = bs; } }
    if (CH == 64) {
#pragma unroll 16
        for (int i = tid; i < 16384; i += NTHR) { const int dv = i >> 7, dk = i & 127; ST[dv * HP_Q + dk] = f2bf(Ssrc[i] * __expf(LF[MID * 128 + dk])); } }
    else {
#pragma unroll 16
        for (int i = tid; i < 16384; i += NTHR) { const int dk = i >> 7, dv = i & 127; ST[dv * HP_Q + dk] = f2bf(Ssrc[i] * __expf(LF[MID * 128 + dk])); } }
    __syncthreads();
    const int lane = C.lane, w = C.wave, r16 = lane & 15, quad = lane >> 4;
    { constexpr int NTB = CH / 16;
      for (int blk = w; blk < NTB * NTB; blk += NWAVES) { const int tb = blk / NTB, sb = blk % NTB;
        f32x4 a = (f32x4){0.f, 0.f, 0.f, 0.f};
        if (sb <= tb) {
#pragma unroll
            for (int ks = 0; ks < 4; ++ks) { const bf16x8 qa = *(const LAS bf16x8*)(QT + (tb * 16 + r16) * HP_Q + ks * 32 + quad * 8), kb = *(const LAS bf16x8*)(KTL + (sb * 16 + r16) * HP_Q + ks * 32 + quad * 8); a = mfma16(qa, kb, a); } }
#pragma unroll
        for (int j = 0; j < 4; ++j) { const int t = tb * 16 + quad * 4 + j, s = sb * 16 + r16; AS[t * HP_V + s] = f2bf(s <= t ? a[j] : 0.f); } } }
    __syncthreads();
    LAS float* OS = (LAS float*)(C.lds + HL_LF);
    { constexpr int NTB = CH / 16;
      for (int blk = w; blk < NTB * 8; blk += NWAVES) { const int tb = blk >> 3, db = blk & 7;
        f32x4 o = (f32x4){0.f, 0.f, 0.f, 0.f};
#pragma unroll
        for (int ks = 0; ks < SP / 32; ++ks) { const bf16x8 pa = *(const LAS bf16x8*)(AS + (tb * 16 + r16) * HP_V + ks * 32 + quad * 8), vb = *(const LAS bf16x8*)(VT + (db * 16 + r16) * HP_V + ks * 32 + quad * 8); o = mfma16(pa, vb, o); }
#pragma unroll
        for (int ks = 0; ks < 4; ++ks) { const bf16x8 qa = *(const LAS bf16x8*)(QT + (tb * 16 + r16) * HP_Q + ks * 32 + quad * 8), sb_ = *(const LAS bf16x8*)(ST + (db * 16 + r16) * HP_Q + ks * 32 + quad * 8); o = mfma16(qa, sb_, o); }
#pragma unroll
        for (int j = 0; j < 4; ++j) OS[(tb * 16 + quad * 4 + j) * HP_O + db * 16 + r16] = o[j]; } }
    if (CH == 16) {
        f32x4 acc[8];
        const bf16x8 a = *(const LAS bf16x8*)(KH + (w * 16 + r16) * 40 + quad * 8);
#pragma unroll
        for (int nb = 0; nb < 8; ++nb) { const bf16x8 vb = *(const LAS bf16x8*)(VT + (nb * 16 + r16) * HP_V + quad * 8); acc[nb] = mfma16(a, vb, (f32x4){0.f, 0.f, 0.f, 0.f}); }
        float* So = C.out + O_HSS + ((size_t)l * 128 + unit) * 16384;
#pragma unroll
        for (int j = 0; j < 4; ++j) { const int dk = w * 16 + quad * 4 + j; const float g = __expf(BL[dk]);
#pragma unroll
            for (int nb = 0; nb < 8; ++nb) { const int dv = nb * 16 + r16; So[dk * 128 + dv] = g * Ssrc[dk * 128 + dv] + acc[nb][j]; } }
    }
    __syncthreads();
    if (tid < CH * 8) { const int t = tid >> 3, part = tid & 7; const LAS float* orow = OS + t * HP_O + part * 16;
        float ov[16]; float ss = 0.f;
#pragma unroll
        for (int i = 0; i < 4; ++i) { const f32x4 x = *(const LAS f32x4*)(orow + 4 * i); ov[4 * i] = x.x; ov[4 * i + 1] = x.y; ov[4 * i + 2] = x.z; ov[4 * i + 3] = x.w; ss += (x.x * x.x + x.y * x.y) + (x.z * x.z + x.w * x.w); }
        ss += __shfl_xor(ss, 1); ss += __shfl_xor(ss, 2); ss += __shfl_xor(ss, 4);
        const float rstd = 1.0f / sqrtf(ss * (1.0f / 128.f) + RMS_EPS);
        const float* gn = C.in[13] + l * 128 + part * 16; const bf16* hg = HB + (size_t)(row0 + t) * 1536 + 1024 + h * 128 + part * 16;
        bf16* mo = (bf16*)(C.ws + WS_MIX) + (size_t)(row0 + t) * DM + 512 + h * 128 + part * 16;
        v4u w0, w1; unsigned pk[8];
#pragma unroll
        for (int i = 0; i < 8; ++i) pk[i] = pk2(ov[2 * i] * rstd * gn[2 * i] * siluf_(bf2f(hg[2 * i])), ov[2 * i + 1] * rstd * gn[2 * i + 1] * siluf_(bf2f(hg[2 * i + 1])));
        w0.x = pk[0]; w0.y = pk[1]; w0.z = pk[2]; w0.w = pk[3]; w1.x = pk[4]; w1.y = pk[5]; w1.z = pk[6]; w1.w = pk[7];
        *(v4u*)mo = w0; *(v4u*)(mo + 8) = w1; }
    __syncthreads();
}

__device__ __forceinline__ void hgrn_load_state(Ctx& C, float (&SR)[32], int unit) {
    const bf16* Ssrc = (const bf16*)(C.ws + WS_US) + (size_t)unit * 16384 + C.tid;
#pragma unroll
    for (int i = 0; i < 32; ++i) SR[i] = bf2f(Ssrc[i * NTHR]);
}
__device__ __forceinline__ void hgrn_out_prompt(Ctx& C, int unit, int next_unit, int l, HRegs& R, float (&SR)[32]) {
    const int bh = unit >> 7, c = unit & 127, b = bh >> 2, h = bh & 3, row0 = b * SEQ + c * 64;
    const bf16* HB = (const bf16*)(C.ws + WS_HB); const float* lb = (const float*)(C.ws + WS_LB) + l * 512 + h * 128;
    hgrn_decay_prefix_regs(C, R, lb);
    LAS float* LF = (LAS float*)(C.lds + HL_LF);
    LAS bf16* QT = (LAS bf16*)(C.lds + HL_QT); LAS bf16* KTL = (LAS bf16*)(C.lds + HL_KTL); LAS bf16* VT = (LAS bf16*)(C.lds + HL_VT);
    LAS bf16* ST = (LAS bf16*)(C.lds + HL_ST); LAS bf16* AS = (LAS bf16*)(C.lds + HL_AS);
    const int tid = C.tid; constexpr int MID = 32;
    { const int d = tid & 127, s0 = tid >> 7; const float oml = 1.f - lb[d], r = LF[MID * 128 + d], er = __expf(r);
#pragma unroll
      for (int i = 0; i < 16; ++i) { const int s = s0 + 4 * i; const float k = oml * sigmoidf_(-R.z[i]), bs = LF[s * 128 + d];
        QT[s * HP_Q + d] = f2bf(bf2f(R.q[i]) * __expf(fminf(bs - r, 80.f))); KTL[s * HP_Q + d] = f2bf(k * __expf(fminf(r - bs, 80.f))); VT[d * HP_V + s] = R.v[i]; }
#pragma unroll
      for (int i = 0; i < 32; ++i) ST[(s0 + 4 * i) * HP_Q + d] = f2bf(SR[i] * er); }
    if (next_unit < 1024) { hgrn_load_regs<true>(C, R, next_unit); hgrn_load_state(C, SR, next_unit); }
    const int gt = tid >> 3, part = tid & 7;
    const v4u hg0 = *(const v4u*)(HB + (size_t)(row0 + gt) * 1536 + 1024 + h * 128 + part * 16), hg1 = *(const v4u*)(HB + (size_t)(row0 + gt) * 1536 + 1024 + h * 128 + part * 16 + 8);
    __syncthreads();
    const int lane = C.lane, w = C.wave, r16 = lane & 15, quad = lane >> 4;
    for (int blk = w; blk < 16; blk += NWAVES) { const int tb = blk >> 2, sb = blk & 3;
        f32x4 a = (f32x4){0.f, 0.f, 0.f, 0.f};
        if (sb <= tb) {
#pragma unroll
            for (int ks = 0; ks < 4; ++ks) { const bf16x8 qa = *(const LAS bf16x8*)(QT + (tb * 16 + r16) * HP_Q + ks * 32 + quad * 8), kb = *(const LAS bf16x8*)(KTL + (sb * 16 + r16) * HP_Q + ks * 32 + quad * 8); a = mfma16(qa, kb, a); } }
#pragma unroll
        for (int j = 0; j < 4; ++j) { const int t = tb * 16 + quad * 4 + j, s = sb * 16 + r16; AS[t * HP_V + s] = f2bf(s <= t ? a[j] : 0.f); } }
    __syncthreads();
    LAS float* OS = (LAS float*)(C.lds + HL_LF);
    for (int blk = w; blk < 32; blk += NWAVES) { const int tb = blk >> 3, db = blk & 7;
        f32x4 o = (f32x4){0.f, 0.f, 0.f, 0.f};
#pragma unroll
        for (int ks = 0; ks < 2; ++ks) { const bf16x8 pa = *(const LAS bf16x8*)(AS + (tb * 16 + r16) * HP_V + ks * 32 + quad * 8), vb = *(const LAS bf16x8*)(VT + (db * 16 + r16) * HP_V + ks * 32 + quad * 8); o = mfma16(pa, vb, o); }
#pragma unroll
        for (int ks = 0; ks < 4; ++ks) { const bf16x8 qa = *(const LAS bf16x8*)(QT + (tb * 16 + r16) * HP_Q + ks * 32 + quad * 8), sb_ = *(const LAS bf16x8*)(ST + (db * 16 + r16) * HP_Q + ks * 32 + quad * 8); o = mfma16(qa, sb_, o); }
#pragma unroll
        for (int j = 0; j < 4; ++j) OS[(tb * 16 + quad * 4 + j) * HP_O + db * 16 + r16] = o[j]; }
    __syncthreads();
    { const LAS float* orow = OS + gt * HP_O + part * 16;
        float ov[16]; float ss = 0.f;
#pragma unroll
        for (int i = 0; i < 4; ++i) { const f32x4 x = *(const LAS f32x4*)(orow + 4 * i); ov[4 * i] = x.x; ov[4 * i + 1] = x.y; ov[4 * i + 2] = x.z; ov[4 * i + 3] = x.w; ss += (x.x * x.x + x.y * x.y) + (x.z * x.z + x.w * x.w); }
        ss += __shfl_xor(ss, 1); ss += __shfl_xor(ss, 2); ss += __shfl_xor(ss, 4);
        const float rstd = 1.0f / sqrtf(ss * (1.0f / 128.f) + RMS_EPS);
        const float* gn = C.in[13] + l * 128 + part * 16;
        bf16* mo = (bf16*)(C.ws + WS_MIX) + (size_t)(row0 + gt) * DM + 512 + h * 128 + part * 16;
        const unsigned hgw[8] = {hg0.x, hg0.y, hg0.z, hg0.w, hg1.x, hg1.y, hg1.z, hg1.w};
        unsigned pk[8];
#pragma unroll
        for (int i = 0; i < 8; ++i) { const float g0 = __builtin_bit_cast(float, hgw[i] << 16), g1 = __builtin_bit_cast(float, hgw[i] & 0xffff0000u);
            pk[i] = pk2(ov[2 * i] * rstd * gn[2 * i] * siluf_(g0), ov[2 * i + 1] * rstd * gn[2 * i + 1] * siluf_(g1)); }
        v4u w0, w1; w0.x = pk[0]; w0.y = pk[1]; w0.z = pk[2]; w0.w = pk[3]; w1.x = pk[4]; w1.y = pk[5]; w1.z = pk[6]; w1.w = pk[7];
        *(v4u*)mo = w0; *(v4u*)(mo + 8) = w1; }
    __syncthreads();
}

__device__ __forceinline__ float block_excl_scan(Ctx& C, float total, LAS float* sm) {
    float x = total;
#pragma unroll
    for (int o = 1; o < 64; o <<= 1) { const float y = __shfl_up(x, o); if (C.lane >= o) x += y; }
    if (C.lane == 63) sm[C.wave] = x;
    __syncthreads();
    float woff = 0.f;
#pragma unroll
    for (int w2 = 0; w2 < NWAVES; ++w2) if (w2 < C.wave) woff += sm[w2];
    __syncthreads();
    return woff + (x - total);
}
__device__ __forceinline__ void cumsum_unit(Ctx& C, int unit, int l) {
    LAS float* sm = (LAS float*)(C.lds);
    if (unit < 16) {
        const float* src = C.out + O_LFP + ((size_t)l * 16 + unit) * 8192 + C.tid * 16; float* dst = (float*)(C.ws + WS_CP) + (size_t)unit * 8192 + C.tid * 16;
        float v[16];
#pragma unroll
        for (int i = 0; i < 4; ++i) { const f32x4 x = ((const f32x4*)src)[i]; v[4 * i] = x.x; v[4 * i + 1] = x.y; v[4 * i + 2] = x.z; v[4 * i + 3] = x.w; }
#pragma unroll
        for (int i = 1; i < 16; ++i) v[i] += v[i - 1];
        const float off = block_excl_scan(C, v[15], sm);
#pragma unroll
        for (int i = 0; i < 4; ++i) ((f32x4*)dst)[i] = (f32x4){(v[4 * i] + off) * LOG2E, (v[4 * i + 1] + off) * LOG2E, (v[4 * i + 2] + off) * LOG2E, (v[4 * i + 3] + off) * LOG2E};
    } else {
        const int bh = unit - 16;
        const float* src = C.in[4] + ((size_t)l * 256 + bh) * PAST + C.tid * 4; float* dst = (float*)(C.ws + WS_CS) + (size_t)bh * SKV;
        f32x4 x = *(const f32x4*)src; x.y += x.x; x.z += x.y; x.w += x.z;
        const float off = block_excl_scan(C, x.w, sm);
        *(f32x4*)(dst + C.tid * 4) = (x + off) * LOG2E;
        if (C.tid == NTHR - 1) { float run = x.w + off; const float* nl = C.out + O_LFS + ((size_t)l * 256 + bh) * 16;
            for (int t = 0; t < 16; ++t) { run += nl[t]; dst[PAST + t] = run * LOG2E; } }
    }
}
__device__ __forceinline__ void ktn_task(Ctx& C, int task) {
    const int bh = task >> 7, tile = task & 127, b = bh >> 3, h = bh & 7, lane = C.lane;
    const bf16* Kb = (const bf16*)(C.ws + WS_KB) + ((size_t)b * SEQ + tile * 64) * 512 + h * 64;
    float mx = 0.f;
#pragma unroll
    for (int i = 0; i < 8; ++i) { const int key = i * 8 + (lane >> 3); const v4u w = *(const v4u*)(Kb + (size_t)key * 512 + (lane & 7) * 8);
        float s = 0.f; const unsigned ww[4] = {w.x, w.y, w.z, w.w};
#pragma unroll
        for (int e = 0; e < 4; ++e) { const float lo = __builtin_bit_cast(float, ww[e] << 16), hi = __builtin_bit_cast(float, ww[e] & 0xffff0000u); s += lo * lo + hi * hi; }
        s += __shfl_xor(s, 1); s += __shfl_xor(s, 2); s += __shfl_xor(s, 4);
        mx = fmaxf(mx, s); }
    mx = wave_max(mx);
    if (lane == 0) ((float*)(C.ws + WS_KTN))[task] = sqrtf(mx);
}

template <int CTRL> __device__ __forceinline__ float dpp_mov(float v) { return __builtin_bit_cast(float, __builtin_amdgcn_update_dpp(0, __builtin_bit_cast(int, v), CTRL, 0xf, 0xf, false)); }
__device__ __forceinline__ float row16_max(float v) { v = fmaxf(v, dpp_mov<0x128>(v)); v = fmaxf(v, dpp_mov<0x124>(v)); v = fmaxf(v, dpp_mov<0x122>(v)); v = fmaxf(v, dpp_mov<0x121>(v)); return v; }
__device__ __forceinline__ float row16_sum(float v) { v += dpp_mov<0x128>(v); v += dpp_mov<0x124>(v); v += dpp_mov<0x122>(v); v += dpp_mov<0x121>(v); return v; }
constexpr int AT_SLOT = 16384, AT_VT = 0, AT_P = 9216, AP = 72;
struct AttnState { bf16x8 qa[2]; float cq[4], m[4], l[4]; f32x4 o[4]; };
__device__ __forceinline__ bf16x8 kfrag_bf16(const bf16* p) { return *(const bf16x8*)p; }
__device__ __forceinline__ bf16x8 kfrag_f32(const float* p) { const f32x4 a = __builtin_nontemporal_load((const f32x4*)p), b = __builtin_nontemporal_load((const f32x4*)(p + 4));     v4u w; w.x = pk2(a.x, a.y); w.y = pk2(a.z, a.w); w.z = pk2(b.x, b.y); w.w = pk2(b.z, b.w); return __builtin_bit_cast(bf16x8, w); }
template <bool F32> __device__ __forceinline__ void attn_scores(const AttnState& S, const void* Ksrc, int pitch, int nvalid, const float* ck, int diag, f32x4 (&s)[4], float (&mx)[4], int lane) {
    const int col = lane & 15, quad = lane >> 4;
#pragma unroll
    for (int nb = 0; nb < 4; ++nb) { const int key = nb * 16 + col, kc = key < nvalid ? key : (nvalid - 1);
        f32x4 a = (f32x4){0.f, 0.f, 0.f, 0.f};
#pragma unroll
        for (int ks = 0; ks < 2; ++ks) { const bf16x8 kb = F32 ? kfrag_f32((const float*)Ksrc + (size_t)kc * pitch + ks * 32 + quad * 8) : kfrag_bf16((const bf16*)Ksrc + (size_t)kc * pitch + ks * 32 + quad * 8);
            a = mfma16(S.qa[ks], kb, a); }
        const float ckv = ck[kc];
#pragma unroll
        for (int j = 0; j < 4; ++j) { const int r = quad * 4 + j; const bool ok = (key < nvalid) && (key <= r + diag); a[j] = ok ? (a[j] + (S.cq[j] - ckv)) : -INFINITY; }
        s[nb] = a; }
#pragma unroll
    for (int j = 0; j < 4; ++j) { float m = fmaxf(fmaxf(s[0][j], s[1][j]), fmaxf(s[2][j], s[3][j]));
        mx[j] = row16_max(m); }
}
__device__ __forceinline__ void attn_load_k_f32(bf16x8 (&kf)[8], float (&ckv)[4], const float* Ksrc, const float* ck, int lane) {
    const int col = lane & 15, quad = lane >> 4;
#pragma unroll
    for (int nb = 0; nb < 4; ++nb) {
#pragma unroll
        for (int ks = 0; ks < 2; ++ks) kf[nb * 2 + ks] = kfrag_f32(Ksrc + (size_t)(nb * 16 + col) * 64 + ks * 32 + quad * 8);
        ckv[nb] = ck[nb * 16 + col]; }
}
__device__ __forceinline__ void attn_scores_pre(const AttnState& S, const bf16x8 (&kf)[8], const float (&ckv)[4], f32x4 (&s)[4], float (&mx)[4]) {
#pragma unroll
    for (int nb = 0; nb < 4; ++nb) { f32x4 a = (f32x4){0.f, 0.f, 0.f, 0.f};
#pragma unroll
        for (int ks = 0; ks < 2; ++ks) a = mfma16(S.qa[ks], kf[nb * 2 + ks], a);
#pragma unroll
        for (int j = 0; j < 4; ++j) a[j] += S.cq[j] - ckv[nb];
        s[nb] = a; }
#pragma unroll
    for (int j = 0; j < 4; ++j) { float m = fmaxf(fmaxf(s[0][j], s[1][j]), fmaxf(s[2][j], s[3][j]));
        mx[j] = row16_max(m); }
}
template <bool F32> __device__ __forceinline__ void attn_update(AttnState& S, f32x4 (&s)[4], const float (&mx)[4], const void* Vsrc, int pitch, int nvalid, LAS bf16* VT, LAS bf16* PL, int lane) {
    const int col = lane & 15, quad = lane >> 4;
    if (F32) { const float* V = (const float*)Vsrc;
#pragma unroll 4
        for (int i = 0; i < 16; ++i) { const int key = i * 4 + (lane >> 4), dc = (lane & 15) * 4; f32x4 x = (f32x4){0.f, 0.f, 0.f, 0.f};
            if (key < nvalid) x = __builtin_nontemporal_load((const f32x4*)(V + (size_t)key * pitch + dc));
            VT[(dc + 0) * AP + key] = f2bf(x.x); VT[(dc + 1) * AP + key] = f2bf(x.y); VT[(dc + 2) * AP + key] = f2bf(x.z); VT[(dc + 3) * AP + key] = f2bf(x.w); }
    } else { const bf16* V = (const bf16*)Vsrc;
#pragma unroll 4
        for (int i = 0; i < 8; ++i) { const int key = i * 8 + (lane >> 3), dc = (lane & 7) * 8; v4u w = (v4u){0u, 0u, 0u, 0u};
            if (key < nvalid) w = *(const v4u*)(V + (size_t)key * pitch + dc);
            VT[(dc + 0) * AP + key] = (bf16)(w.x & 0xffffu); VT[(dc + 1) * AP + key] = (bf16)(w.x >> 16); VT[(dc + 2) * AP + key] = (bf16)(w.y & 0xffffu); VT[(dc + 3) * AP + key] = (bf16)(w.y >> 16);
            VT[(dc + 4) * AP + key] = (bf16)(w.z & 0xffffu); VT[(dc + 5) * AP + key] = (bf16)(w.z >> 16); VT[(dc + 6) * AP + key] = (bf16)(w.w & 0xffffu); VT[(dc + 7) * AP + key] = (bf16)(w.w >> 16); }
    }
    float alpha[4];
#pragma unroll
    for (int j = 0; j < 4; ++j) { const float mnew = fmaxf(S.m[j], mx[j]), msafe = (mnew == -INFINITY) ? 0.f : mnew;
        alpha[j] = fast_exp2(S.m[j] - msafe); S.m[j] = mnew;
        float ps = 0.f;
#pragma unroll
        for (int nb = 0; nb < 4; ++nb) { const float p = fast_exp2(s[nb][j] - msafe); s[nb][j] = p; ps += p; }
        S.l[j] = S.l[j] * alpha[j] + ps; }
#pragma unroll
    for (int nb = 0; nb < 4; ++nb)
#pragma unroll
        for (int j = 0; j < 4; ++j) { PL[(quad * 4 + j) * AP + nb * 16 + col] = f2bf(s[nb][j]); S.o[nb][j] *= alpha[j]; }
    LDS_WAIT(); __builtin_amdgcn_wave_barrier(); asm volatile("" ::: "memory");
    bf16x8 pa[2];
#pragma unroll
    for (int ks = 0; ks < 2; ++ks) pa[ks] = *(const LAS bf16x8*)(PL + col * AP + ks * 32 + quad * 8);
#pragma unroll
    for (int nb = 0; nb < 4; ++nb)
#pragma unroll
        for (int ks = 0; ks < 2; ++ks) { const bf16x8 vb = *(const LAS bf16x8*)(VT + (nb * 16 + col) * AP + ks * 32 + quad * 8); S.o[nb] = mfma16(pa[ks], vb, S.o[nb]); }
    LDS_WAIT(); __builtin_amdgcn_wave_barrier(); asm volatile("" ::: "memory");
}
template <bool F32> __device__ __forceinline__ void attn_tile(AttnState& S, const void* Ksrc, const void* Vsrc, int pitch, int nvalid, const float* ck, int diag, LAS bf16* VT, LAS bf16* PL, int lane) {
    f32x4 s[4]; float mx[4];
    attn_scores<F32>(S, Ksrc, pitch, nvalid, ck, diag, s, mx, lane);
    attn_update<F32>(S, s, mx, Vsrc, pitch, nvalid, VT, PL, lane);
}
__device__ __forceinline__ void attn_init(AttnState& S, const bf16* Qrow0, const float* cq0, int lane) {
    const int col = lane & 15, quad = lane >> 4;
#pragma unroll
    for (int ks = 0; ks < 2; ++ks) S.qa[ks] = *(const bf16x8*)(Qrow0 + (size_t)col * 512 + ks * 32 + quad * 8);
#pragma unroll
    for (int j = 0; j < 4; ++j) { S.cq[j] = cq0[quad * 4 + j]; S.m[j] = -INFINITY; S.l[j] = 0.f; }
#pragma unroll
    for (int nb = 0; nb < 4; ++nb) S.o[nb] = (f32x4){0.f, 0.f, 0.f, 0.f};
}
__device__ __forceinline__ float attn_qmax(const AttnState& S) {
    float s = 0.f;
#pragma unroll
    for (int ks = 0; ks < 2; ++ks)
#pragma unroll
        for (int e = 0; e < 8; ++e) { const float x = bf2f((bf16)S.qa[ks][e]); s += x * x; }
    s += __shfl_xor(s, 16); s += __shfl_xor(s, 32);
    return sqrtf(wave_max(s));
}
__device__ __forceinline__ void attn_prompt_task(Ctx& C, int task) {
    const int bh = task >> 9, rb = task & 511, b = bh >> 3, h = bh & 7, lane = C.lane, i0 = rb * 16;
    const bf16* Qb = (const bf16*)(C.ws + WS_QB); const bf16* Kb = (const bf16*)(C.ws + WS_KB); const bf16* Vb = (const bf16*)(C.ws + WS_VB);
    const float* cp = (const float*)(C.ws + WS_CP) + (size_t)bh * SEQ;
    LAS bf16* VT = (LAS bf16*)(C.lds + C.wave * AT_SLOT + AT_VT); LAS bf16* PL = (LAS bf16*)(C.lds + C.wave * AT_SLOT + AT_P);
    AttnState S; attn_init(S, Qb + ((size_t)b * SEQ + i0) * 512 + h * 64, cp + i0, lane);
    const float* ktn = (const float*)(C.ws + WS_KTN) + bh * 128;
    const float kmax = wave_max(fmaxf(ktn[lane], ktn[lane + 64])), bound = 2.0f * attn_qmax(S) * kmax;
    const int jd = i0 >> 6; const float c0 = cp[i0];
    int jstart = jd;
    { const int t0 = lane, t1 = lane + 64;
      const bool n0 = (t0 < jd) && (c0 - cp[t0 * 64 + 63] + bound >= -151.5f), n1 = (t1 < jd) && (c0 - cp[(t1 < jd ? t1 : 0) * 64 + 63] + bound >= -151.5f);
      const unsigned long long m0 = __ballot(n0), m1 = __ballot(n1);
      if (m0) jstart = __builtin_ctzll(m0); else if (m1) jstart = 64 + __builtin_ctzll(m1); }
    for (int t = jstart; t <= jd; ++t) {
        const size_t krow = ((size_t)b * SEQ + t * 64) * 512 + h * 64;
        attn_tile<false>(S, Kb + krow, Vb + krow, 512, 64, cp + t * 64, (t == jd) ? (i0 - t * 64) : 64, VT, PL, lane);
    }
    const int col = lane & 15, quad = lane >> 4;
#pragma unroll
    for (int j = 0; j < 4; ++j) { float lt = S.l[j]; lt = row16_sum(lt); const float inv = 1.0f / lt;
#pragma unroll
        for (int nb = 0; nb < 4; ++nb) PL[(quad * 4 + j) * AP + nb * 16 + col] = f2bf(S.o[nb][j] * inv); }
    LDS_WAIT(); __builtin_amdgcn_wave_barrier(); asm volatile("" ::: "memory");
    bf16* mix = (bf16*)(C.ws + WS_MIX) + ((size_t)b * SEQ + i0) * DM + h * 64;
#pragma unroll
    for (int i = 0; i < 2; ++i) { const int r = i * 8 + (lane >> 3), ch = lane & 7; *(v4u*)(mix + (size_t)r * DM + ch * 8) = *(const LAS v4u*)(PL + r * AP + ch * 8); }
    LDS_WAIT(); __builtin_amdgcn_wave_barrier(); asm volatile("" ::: "memory");
}
constexpr int AB_K = 0, AB_V = 18432, AB_P = 36864, AB_CK = 55296, AB_RED = 55808;
template <bool MASK> __device__ __forceinline__ void attn_tile_lds(AttnState& S, const LAS bf16* KL, const LAS bf16* VT, const LAS float* CK, int diag, LAS bf16* PL, int lane) {
    const int col = lane & 15, quad = lane >> 4;
    const f32x4 cq4 = (f32x4){S.cq[0], S.cq[1], S.cq[2], S.cq[3]};
    f32x4 s[4];
#pragma unroll
    for (int nb = 0; nb < 4; ++nb) { const int key = nb * 16 + col;
        f32x4 a = cq4 - CK[key];
#pragma unroll
        for (int ks = 0; ks < 2; ++ks) { const bf16x8 kb = *(const LAS bf16x8*)(KL + key * AP + ks * 32 + quad * 8); a = mfma16(S.qa[ks], kb, a); }
        if (MASK) {
#pragma unroll
            for (int j = 0; j < 4; ++j) { const int r = quad * 4 + j; a[j] = (key <= r + diag) ? a[j] : -INFINITY; } }
        s[nb] = a; }
    f32x4 mx4 = __builtin_elementwise_max(__builtin_elementwise_max(s[0], s[1]), __builtin_elementwise_max(s[2], s[3]));
    f32x4 m4 = (f32x4){S.m[0], S.m[1], S.m[2], S.m[3]}, l4 = (f32x4){S.l[0], S.l[1], S.l[2], S.l[3]}, mnew4, msafe4, alpha4;
#pragma unroll
    for (int j = 0; j < 4; ++j) { const float mx = row16_max(mx4[j]); mnew4[j] = fmaxf(m4[j], mx); msafe4[j] = (mnew4[j] == -INFINITY) ? 0.f : mnew4[j]; }
    { const f32x4 dm = m4 - msafe4;
#pragma unroll
      for (int j = 0; j < 4; ++j) alpha4[j] = fast_exp2(dm[j]); }
    f32x4 ps4 = (f32x4){0.f, 0.f, 0.f, 0.f};
#pragma unroll
    for (int nb = 0; nb < 4; ++nb) { const f32x4 d = s[nb] - msafe4; f32x4 p;
#pragma unroll
        for (int j = 0; j < 4; ++j) p[j] = fast_exp2(d[j]);
        s[nb] = p; ps4 = ps4 + p; S.o[nb] = S.o[nb] * alpha4; }
    l4 = l4 * alpha4 + ps4;
#pragma unroll
    for (int j = 0; j < 4; ++j) { S.m[j] = mnew4[j]; S.l[j] = l4[j]; }
#pragma unroll
    for (int nb = 0; nb < 4; ++nb)
#pragma unroll
        for (int j = 0; j < 4; ++j) PL[(quad * 4 + j) * AP + nb * 16 + col] = f2bf(s[nb][j]);
    LDS_WAIT(); __builtin_amdgcn_wave_barrier(); asm volatile("" ::: "memory");
    bf16x8 pa[2];
#pragma unroll
    for (int ks = 0; ks < 2; ++ks) pa[ks] = *(const LAS bf16x8*)(PL + col * AP + ks * 32 + quad * 8);
#pragma unroll
    for (int nb = 0; nb < 4; ++nb)
#pragma unroll
        for (int ks = 0; ks < 2; ++ks) { const bf16x8 vb = *(const LAS bf16x8*)(VT + (nb * 16 + col) * AP + ks * 32 + quad * 8); S.o[nb] = mfma16(pa[ks], vb, S.o[nb]); }
    LDS_WAIT(); __builtin_amdgcn_wave_barrier(); asm volatile("" ::: "memory");
}
__device__ __forceinline__ void attn_prompt_unit(Ctx& C, int unit) {
    const int bh = unit >> 6, qb = 63 - (unit & 63), b = bh >> 3, h = bh & 7, lane = C.lane, w = C.wave, tid = C.tid, i0b = qb * 128, i0 = i0b + 16 * w;
    const bf16* Qb = (const bf16*)(C.ws + WS_QB); const bf16* Kb = (const bf16*)(C.ws + WS_KB) + (size_t)b * SEQ * 512 + h * 64; const bf16* Vb = (const bf16*)(C.ws + WS_VB) + (size_t)b * SEQ * 512 + h * 64;
    const float* cp = (const float*)(C.ws + WS_CP) + (size_t)bh * SEQ;
    LAS bf16* KL = (LAS bf16*)(C.lds + AB_K); LAS bf16* VT = (LAS bf16*)(C.lds + AB_V); LAS bf16* PL = (LAS bf16*)(C.lds + AB_P) + w * 16 * AP;
    LAS float* CK = (LAS float*)(C.lds + AB_CK); LAS float* RED = (LAS float*)(C.lds + AB_RED);
    AttnState S; attn_init(S, Qb + ((size_t)b * SEQ + i0) * 512 + h * 64, cp + i0, lane);
    const float* ktn = (const float*)(C.ws + WS_KTN) + bh * 128;
    const int jd0 = i0b >> 6, jlast = jd0 + 1;
    const float kt0 = ktn[lane], kt1 = ktn[lane + 64], c0 = cp[i0b];
    const int t0 = lane, t1 = lane + 64;
    const float ce0 = cp[t0 * 64 + 63], ce1 = cp[(t1 < jd0 ? t1 : 0) * 64 + 63];
    { const float qm = attn_qmax(S); if (lane == 0) RED[w] = qm; }
    __syncthreads();
    float qmax = RED[0];
#pragma unroll
    for (int i = 1; i < NWAVES; ++i) qmax = fmaxf(qmax, RED[i]);
    const float kmax = wave_max(fmaxf(kt0, kt1)), bound = 2.0f * qmax * kmax;
    int jstart = jd0;
    { const bool n0 = (t0 < jd0) && (c0 - ce0 + bound >= -151.5f), n1 = (t1 < jd0) && (c0 - ce1 + bound >= -151.5f);
      const unsigned long long m0 = __ballot(n0), m1 = __ballot(n1);
      if (m0) jstart = __builtin_ctzll(m0); else if (m1) jstart = 64 + __builtin_ctzll(m1); }
    const int skey = tid >> 3, sch = tid & 7;
    v4u kr0, vr0, kr1, vr1, kr2, vr2, kr3, vr3; float cr0 = 0.f, cr1 = 0.f, cr2 = 0.f, cr3 = 0.f;
#define AT_LOAD(K_, V_, C_, t) do { if ((t) <= jlast) { K_ = *(const v4u*)(Kb + (size_t)((t) * 64 + skey) * 512 + sch * 8); V_ = *(const v4u*)(Vb + (size_t)((t) * 64 + lane) * 512 + w * 8); if (tid < 64) C_ = cp[(t) * 64 + tid]; } } while (0)
#define AT_STORE(K_, V_, C_, bf) do { *(LAS v4u*)(KL + (bf) * 64 * AP + skey * AP + sch * 8) = K_; LAS bf16* vt_ = VT + (bf) * 64 * AP + (w * 8) * AP + lane; \
        vt_[0 * AP] = (bf16)(V_.x & 0xffffu); vt_[1 * AP] = (bf16)(V_.x >> 16); vt_[2 * AP] = (bf16)(V_.y & 0xffffu); vt_[3 * AP] = (bf16)(V_.y >> 16); \
        vt_[4 * AP] = (bf16)(V_.z & 0xffffu); vt_[5 * AP] = (bf16)(V_.z >> 16); vt_[6 * AP] = (bf16)(V_.w & 0xffffu); vt_[7 * AP] = (bf16)(V_.w >> 16); \
        if (tid < 64) CK[(bf) * 64 + tid] = C_; } while (0)
#define AT_ITER(t, bf, KL_, VL_, CL_, KS_, VS_, CS_) do { AT_LOAD(KL_, VL_, CL_, (t) + 3); \
        { const int diag = i0 - 64 * (t); if (diag >= 63) attn_tile_lds<false>(S, KL + (bf) * 64 * AP, VT + (bf) * 64 * AP, CK + (bf) * 64, diag, PL, lane); \
          else if (diag >= 0) attn_tile_lds<true>(S, KL + (bf) * 64 * AP, VT + (bf) * 64 * AP, CK + (bf) * 64, diag, PL, lane); } \
        if ((t) < jlast) AT_STORE(KS_, VS_, CS_, (bf) ^ 1); \
        __syncthreads(); } while (0)
    AT_LOAD(kr0, vr0, cr0, jstart); AT_LOAD(kr1, vr1, cr1, jstart + 1); AT_LOAD(kr2, vr2, cr2, jstart + 2);
    AT_STORE(kr0, vr0, cr0, 0);
    __syncthreads();
    for (int t = jstart; t <= jlast; t += 4) {
        AT_ITER(t, 0, kr3, vr3, cr3, kr1, vr1, cr1);
        if (t + 1 > jlast) break;
        AT_ITER(t + 1, 1, kr0, vr0, cr0, kr2, vr2, cr2);
        if (t + 2 > jlast) break;
        AT_ITER(t + 2, 0, kr1, vr1, cr1, kr3, vr3, cr3);
        if (t + 3 > jlast) break;
        AT_ITER(t + 3, 1, kr2, vr2, cr2, kr0, vr0, cr0);
    }
#undef AT_ITER
#undef AT_LOAD
#undef AT_STORE
    const int col = lane & 15, quad = lane >> 4;
#pragma unroll
    for (int j = 0; j < 4; ++j) { float lt = S.l[j]; lt = row16_sum(lt); const float inv = 1.0f / lt;
#pragma unroll
        for (int nb = 0; nb < 4; ++nb) PL[(quad * 4 + j) * AP + nb * 16 + col] = f2bf(S.o[nb][j] * inv); }
    LDS_WAIT(); __builtin_amdgcn_wave_barrier(); asm volatile("" ::: "memory");
    bf16* mix = (bf16*)(C.ws + WS_MIX) + ((size_t)b * SEQ + i0) * DM + h * 64;
#pragma unroll
    for (int i = 0; i < 2; ++i) { const int r = i * 8 + (lane >> 3), ch = lane & 7; *(v4u*)(mix + (size_t)r * DM + ch * 8) = *(const LAS v4u*)(PL + r * AP + ch * 8); }
    LDS_WAIT();
    __syncthreads();
}
__device__ __forceinline__ void attn_sample_unit(Ctx& C, int unit, int l) {
    const int b = unit >> 3, h = unit & 7, lane = C.lane, w = C.wave;
    const bf16* Qb = (const bf16*)(C.ws + WS_QB); const bf16* Kb = (const bf16*)(C.ws + WS_KB); const bf16* Vb = (const bf16*)(C.ws + WS_VB);
    const float* cs = (const float*)(C.ws + WS_CS) + (size_t)unit * SKV;
    LAS bf16* VT = (LAS bf16*)(C.lds + w * AT_SLOT + AT_VT); LAS bf16* PL = (LAS bf16*)(C.lds + w * AT_SLOT + AT_P);
    const size_t srow = ((size_t)MP + b * 16) * 512 + h * 64;
    AttnState S; attn_init(S, Qb + srow, cs + PAST, lane);
    const float* ck = C.in[2] + (((size_t)l * 32 + b) * 8 + h) * PAST * 64; const float* cv = C.in[3] + (((size_t)l * 32 + b) * 8 + h) * PAST * 64;
    f32x4 s[4]; float mlb[4], mx[4];
    attn_scores<false>(S, Kb + srow, 512, 16, cs + PAST, 0, s, mlb, lane);
    if (w == 0) attn_update<false>(S, s, mlb, Vb + srow, 512, 16, VT, PL, lane);
    bf16x8 kf[2][8]; float ckv[2][4];
    attn_load_k_f32(kf[0], ckv[0], ck + (size_t)(24 + w) * 64 * 64, cs + (24 + w) * 64, lane);
#pragma unroll
    for (int i = 0; i < 4; ++i) { const int t = 24 + w - 8 * i;
        if (i < 3) attn_load_k_f32(kf[(i + 1) & 1], ckv[(i + 1) & 1], ck + (size_t)(t - 8) * 64 * 64, cs + (t - 8) * 64, lane);
        attn_scores_pre(S, kf[i & 1], ckv[i & 1], s, mx);
        bool dead = true;
#pragma unroll
        for (int j = 0; j < 4; ++j) dead = dead && (mx[j] - fmaxf(S.m[j], mlb[j]) < -151.5f);
        if (!__all(dead)) attn_update<true>(S, s, mx, cv + (size_t)t * 64 * 64, 64, 64, VT, PL, lane);
    }
    const int col = lane & 15, quad = lane >> 4;
    LAS float* slot = (LAS float*)(C.lds + w * AT_SLOT);
#pragma unroll
    for (int j = 0; j < 4; ++j) { float lt = S.l[j]; lt = row16_sum(lt);
        if (col == 0) { slot[quad * 4 + j] = S.m[j]; slot[16 + quad * 4 + j] = lt; }
#pragma unroll
        for (int nb = 0; nb < 4; ++nb) slot[64 + (quad * 4 + j) * 64 + nb * 16 + col] = S.o[nb][j]; }
    __syncthreads();
    bf16* mix = (bf16*)(C.ws + WS_MIX) + ((size_t)MP + b * 16) * DM + h * 64;
    for (int e = C.tid; e < 16 * 64; e += NTHR) { const int r = e >> 6, d = e & 63;
        float M = -INFINITY;
#pragma unroll
        for (int w2 = 0; w2 < NWAVES; ++w2) M = fmaxf(M, ((const LAS float*)(C.lds + w2 * AT_SLOT))[r]);
        float num = 0.f, den = 0.f;
#pragma unroll
        for (int w2 = 0; w2 < NWAVES; ++w2) { const LAS float* sl = (const LAS float*)(C.lds + w2 * AT_SLOT); const float f = fast_exp2(sl[r] - M); num += f * sl[64 + r * 64 + d]; den += f * sl[16 + r]; }
        mix[(size_t)r * DM + d] = f2bf(num / den); }
    __syncthreads();
}

constexpr int LDSCTL_OFF = LDS_BYTES - 64, CW_BAR = 4096;
#define XB_TMO      128
#define XB_XCNT(j)  (256  + 64 * (j))
#define XB_XSUB(j)  (1280 + 64 * (j))
#define XB_XGEN(j)  (2304 + 64 * (j))
#define XB_TOP      3328
#define XB_TOPGEN   3392
#define XCD_BAR_WORDS 3456
#define XB_SPIN_CAP (1u << 18)

__device__ __forceinline__ unsigned xb_ld(unsigned* p)              { return __hip_atomic_load(p, __ATOMIC_RELAXED, __HIP_MEMORY_SCOPE_AGENT); }
__device__ __forceinline__ unsigned xb_add(unsigned* p, unsigned v) { return __hip_atomic_fetch_add(p, v, __ATOMIC_RELAXED, __HIP_MEMORY_SCOPE_AGENT); }
__device__ __forceinline__ unsigned xb_xcc_id() { return (unsigned)__builtin_amdgcn_s_getreg((3 << 11) | 20) & 0xFu; }
#define XB_SPIN(cond, bar) do { unsigned _sp = 0; while (cond) { __builtin_amdgcn_s_sleep(1); \
    if ((++_sp & 255u) == 0u) { if (xb_ld(&(bar)[XB_TMO])) break; if (_sp > XB_SPIN_CAP) { atomicAdd(&(bar)[XB_TMO], 1u); break; } } } } while (0)

struct XcdBarrier {
    unsigned* bar; unsigned x;
    volatile LAS unsigned* st;
};

__device__ __forceinline__ XcdBarrier xcd_barrier_post(unsigned* bar, volatile LAS unsigned* st) {
    XcdBarrier b; b.bar = bar; b.x = xb_xcc_id(); b.st = st;
    if (threadIdx.x == 0) (void)xb_add(&bar[XB_XCNT(b.x)], 1u);
    return b;
}
__device__ __forceinline__ void xcd_barrier_complete(unsigned* bar, unsigned x, unsigned& nloc, unsigned& nx) {
    const unsigned G = gridDim.x * gridDim.y * gridDim.z;
    unsigned sum, cnt, mine, sp = 0u;
    for (;;) {
        sum = 0u; cnt = 0u; mine = 0u;
#pragma unroll
        for (unsigned j = 0; j < 16; ++j) { const unsigned c = xb_ld(&bar[XB_XCNT(j)]); sum += c; cnt += (c > 0u) ? 1u : 0u; mine = (j == x) ? c : mine; }
        if (sum == G) break;
        __builtin_amdgcn_s_sleep(1);
        if ((++sp & 255u) == 0u) { if (xb_ld(&bar[XB_TMO])) break; if (sp > XB_SPIN_CAP) { atomicAdd(&bar[XB_TMO], 1u); break; } }
    }
    nloc = mine > 0u ? mine : 1u; nx = cnt > 0u ? cnt : 1u;
}

__device__ __forceinline__ void xcd_barrier(const XcdBarrier& b) {
    asm volatile("s_waitcnt vmcnt(0)" ::: "memory");
    __syncthreads();
    if (threadIdx.x == 0) {
        unsigned* bar = b.bar;
        __builtin_amdgcn_s_waitcnt(0);
        unsigned nloc = b.st[0], nx = b.st[1];
        if (nloc == 0u) { xcd_barrier_complete(bar, b.x, nloc, nx); b.st[0] = nloc; b.st[1] = nx; }
        const unsigned old = xb_add(&bar[XB_XSUB(b.x)], 1u);
        const unsigned gen = old / nloc;
        if (old + 1u == (gen + 1u) * nloc) {
            __builtin_amdgcn_fence(__ATOMIC_RELEASE, "agent");
            asm volatile("s_waitcnt vmcnt(0)" ::: "memory");
            const unsigned og = xb_add(&bar[XB_TOP], 1u);
            const unsigned tg = og / nx;
            if (og + 1u == (tg + 1u) * nx) xb_add(&bar[XB_TOPGEN], 1u);
            else XB_SPIN(xb_ld(&bar[XB_TOPGEN]) == tg, bar);
            __builtin_amdgcn_fence(__ATOMIC_ACQUIRE, "agent");
            xb_add(&bar[XB_XGEN(b.x)], 1u);
            asm volatile("s_waitcnt vmcnt(0)" ::: "memory");
        } else {
            XB_SPIN(xb_ld(&bar[XB_XGEN(b.x)]) == gen, bar);
            __builtin_amdgcn_fence(__ATOMIC_ACQUIRE, "agent");
            asm volatile("s_waitcnt vmcnt(0)" ::: "memory");
        }
    }
    __syncthreads();
}

template <int KIND, int L> __device__ __forceinline__ void gemm_up(Ctx& C) {
    pg8::Gemm g{(const bf16*)(C.ws + WS_HN), (const bf16*)(C.ws + WS_W1T) + (size_t)(L * 2 + KIND) * W1T_SZ, MT, 2 * DFF, DM}; pg8::StaticOrder S; S.init(MT, 2 * DFF, C.G, C.bid);
    pg8::EpiSwiglu E{(bf16*)(C.ws + WS_ACT), nullptr};
    pg8::gemm_phase<pg8::EpiSwiglu, pg8::StaticOrder, true, true>(C.lds, g, S, E);
}
template <int KIND, int L> __device__ __forceinline__ void gemm_res(Ctx& C, bool dummy = false) {
    pg8::Gemm g;
    if (KIND == 2) g = pg8::Gemm{(const bf16*)(C.ws + WS_MIX), (const bf16*)(C.ws + WS_WOT) + (size_t)L * WOT_SZ, MT, DM, DM};
    else g = pg8::Gemm{(const bf16*)(C.ws + WS_ACT), (const bf16*)(C.ws + WS_W2T) + (size_t)(L * 2 + KIND) * W2T_SZ, MT, DM, DFF};
    pg8::SplitOrder S; S.init(MP, DM, C.G, C.bid, (KIND == 2 ? DM : DFF) / 64);
    float* Xo = (float*)(C.ws + (dummy ? WS_END : WS_X));
    pg8::EpiRes E{Xo, (KIND == 0 && L == 0 && !dummy) ? C.in[0] : Xo, (float*)(C.ws + (dummy ? WS_END + 100 * MiB : WS_PART)), KIND == 2 ? 1.0f : 0.5f,
                  nullptr, nullptr, nullptr};
    pg8::gemm_phase<pg8::EpiRes, pg8::SplitOrder, true, true>(C.lds, g, S, E);
}
template <int L> __device__ __forceinline__ void gemm_inproj(Ctx& C) {
    pg8::Gemm g{(const bf16*)(C.ws + WS_HN), (const bf16*)(C.ws + WS_WINT) + (size_t)L * WINT_SZ, MT, NIN, DM}; pg8::StaticOrder S; S.init(MT, NIN, C.G, C.bid);
    pg8::EpiInProj E{(bf16*)(C.ws + WS_QB), (bf16*)(C.ws + WS_KB), (bf16*)(C.ws + WS_VB), (float*)(C.ws + WS_HF), (bf16*)(C.ws + WS_HB), C.out, L};
    pg8::gemm_phase<pg8::EpiInProj, pg8::StaticOrder, true, true>(C.lds, g, S, E);
}
__device__ __forceinline__ void phase_prep(Ctx& C, int l) {
    { HRegs R; int u = C.bid; if (u < 1024) hgrn_load_regs<false>(C, R, u);
      for (; u < 1024; u += C.G) hgrn_local_unit(C, u, u + C.G, l, R); }
    for (int u = C.bid; u < 272; u += C.G) cumsum_unit(C, u, l);
    for (int t = CTX_GW(C); t < 2048; t += CTX_NGW(C)) ktn_task(C, t);
}
__device__ __forceinline__ void phase_attn(Ctx& C, int l, const XcdBarrier& bar) {
    const int grp = (TSEL < 0) ? ((C.bid >> 3) % 3) : 0, npre = grp * 2;
    int u = C.bid, k = 0;
    for (; u < 1024 && k < npre; u += C.G, ++k) attn_prompt_unit(C, u);
    for (int us = C.bid; us < 256; us += C.G) attn_sample_unit(C, us, l);
    if (TSEL >= 0) { xcd_barrier(bar); if (C.bid == 0 && C.tid == 0) ((unsigned long long*)(C.ws + WS_CTL + 32768))[40 + 2 * l] = __builtin_amdgcn_s_memrealtime(); }
    hgrn_scan(C, l);
    if (TSEL >= 0) { xcd_barrier(bar); if (C.bid == 0 && C.tid == 0) ((unsigned long long*)(C.ws + WS_CTL + 32768))[41 + 2 * l] = __builtin_amdgcn_s_memrealtime(); }
    for (; u < 1024; u += C.G) attn_prompt_unit(C, u);
}
__device__ __forceinline__ void phase_hout(Ctx& C, int l) {
    { HRegs R; float SR[32]; int u = C.bid; if (u < 1024) { hgrn_load_regs<true>(C, R, u); hgrn_load_state(C, SR, u); }
      for (; u < 1024; u += C.G) hgrn_out_prompt(C, u, u + C.G, l, R, SR); }
    for (int u = C.bid; u < 128; u += C.G) hgrn_out_unit<16>(C, u, l);
}
template <int L> __device__ __forceinline__ void layer_phases(Ctx& C, const XcdBarrier& bar, int lo, int hi) {
    constexpr int P = 1 + 12 * L;
#define IN(k) (lo <= (k) && (k) < hi)
#define SEAM(k) do { if (IN(k) && IN((k) + 1)) { xcd_barrier(bar); if (TSEL >= 0 && C.bid == 0 && C.tid == 0) ((unsigned long long*)(C.ws + WS_CTL + 32768))[(k) + 1] = __builtin_amdgcn_s_memrealtime(); } } while (0)
#define DUPK(k) (L == 0 && ((DUP >> (k)) & 1))
    const bool merged0 = (L == 0) && IN(0) && IN(1) && TSEL < 0;
    if (IN(P + 0) && !merged0) { phase_rms<0>(C, C.in[6] + L * DM, L, L == 0 ? 0.f : 0.5f, L == 0 ? 1 : 0); if (DUPK(0)) { xcd_barrier(bar); phase_rms<0>(C, C.in[6] + L * DM, L, L == 0 ? 0.f : 0.5f, L == 0 ? 1 : 0); } }
    if (!merged0) SEAM(P + 0);
    if (IN(P + 1)) { gemm_up<0, L>(C); if (DUPK(1)) { xcd_barrier(bar); gemm_up<0, L>(C); } }
    SEAM(P + 1);
    if (IN(P + 2)) { gemm_res<0, L>(C); if (DUPK(2)) { xcd_barrier(bar); gemm_res<0, L>(C, true); } }
    SEAM(P + 2);
    if (IN(P + 3)) { phase_rms<1>(C, C.in[9] + L * DM, L, 0.5f, L == 0 ? 2 : 0); if (DUPK(3)) { xcd_barrier(bar); phase_rms<1>(C, C.in[9] + L * DM, L, 0.5f, L == 0 ? 2 : 0); } }
    SEAM(P + 3);
    if (IN(P + 4)) { gemm_inproj<L>(C); if (DUPK(4)) { xcd_barrier(bar); gemm_inproj<L>(C); } }
    SEAM(P + 4);
    if (IN(P + 5)) { phase_prep(C, L); if (DUPK(5)) { xcd_barrier(bar); phase_prep(C, L); } }
    SEAM(P + 5);
    if (IN(P + 6)) phase_attn(C, L, bar);
    SEAM(P + 6);
    if (IN(P + 7)) { phase_hout(C, L); if (DUPK(7)) { xcd_barrier(bar); phase_hout(C, L); } }
    SEAM(P + 7);
    if (IN(P + 8)) { gemm_res<2, L>(C); if (DUPK(8)) { xcd_barrier(bar); gemm_res<2, L>(C, true); } }
    SEAM(P + 8);
    if (IN(P + 9)) { phase_rms<0>(C, C.in[15] + L * DM, L, 1.0f, 0); if (DUPK(9)) { xcd_barrier(bar); phase_rms<0>(C, C.in[15] + L * DM, L, 1.0f, 0); } }
    SEAM(P + 9);
    if (IN(P + 10)) gemm_up<1, L>(C);
    SEAM(P + 10);
    if (IN(P + 11)) gemm_res<1, L>(C);
    SEAM(P + 11);
#undef DUPK
#undef IN
#undef SEAM
}

__global__ void __launch_bounds__(NTHR, 2) fwd_megakernel(Params prm) {
    extern __shared__ __attribute__((aligned(16))) unsigned char lds_raw[];
    Ctx C;
    C.lds = (LAS unsigned char*)lds_raw; C.tid = threadIdx.x; C.lane = C.tid & 63; C.wave = __builtin_amdgcn_readfirstlane(C.tid >> 6); C.G = gridDim.x; C.bid = blockIdx.x;
#pragma unroll
    for (int i = 0; i < 19; ++i) C.in[i] = prm.in[i];
    C.out = prm.out; C.ws = prm.ws;
    cg::grid_group grid = cg::this_grid();
    volatile LAS unsigned* MISC = (volatile LAS unsigned*)(C.lds + LDSCTL_OFF);
    if (C.tid < 16) MISC[C.tid] = 0u;
    __syncthreads();
    XcdBarrier bar; bar.bar = (unsigned*)(C.ws + WS_CTL) + CW_BAR; bar.x = 0; bar.st = nullptr;
    const int lo = prm.ph_lo, hi = prm.ph_hi;
    if (TSEL >= 0 && C.bid == 0 && C.tid == 0) ((unsigned long long*)(C.ws + WS_CTL + 32768))[0] = __builtin_amdgcn_s_memrealtime();
#define IN(k) (lo <= (k) && (k) < hi)
#define SEAM(k) do { if (IN(k) && IN((k) + 1)) { grid.sync(); if (TSEL >= 0 && C.bid == 0 && C.tid == 0) ((unsigned long long*)(C.ws + WS_CTL + 32768))[(k) + 1] = __builtin_amdgcn_s_memrealtime(); } } while (0)
    if (ONE_LAUNCH && C.bid == 0) { for (int i = C.tid; i < 16384; i += NTHR) ((unsigned*)(C.ws + WS_CTL))[i] = 0u; }
    if (IN(0)) { phase_prologue(C); if (IN(1) && TSEL < 0) phase_rms<0>(C, C.in[6], 0, 0.f, 1);     if ((DUP >> 12) & 1) { grid.sync(); phase_prologue(C); } if ((DUP >> 13) & 1) { for (int i = 0; i < 16; ++i) xcd_barrier(bar); } } SEAM(0);
    if (ONE_LAUNCH) bar = xcd_barrier_post((unsigned*)(C.ws + WS_CTL) + CW_BAR, MISC + 8);
    layer_phases<0>(C, bar, lo, hi);
    layer_phases<1>(C, bar, lo, hi);
    if (IN(25)) phase_rms<2>(C, C.in[18], 0, 0.5f, 0);
    if (TSEL >= 0) {
        xcd_barrier(bar);
        if (C.bid == 0) {
            volatile unsigned long long* TS = (volatile unsigned long long*)(C.ws + WS_CTL + 32768);
            if (C.tid == 0) TS[26] = __builtin_amdgcn_s_memrealtime();
            __syncthreads();
            float T = 0.f;
            for (int k = 0; k < 26; ++k) if ((TSEL >> k) & 1) T += (float)(TS[k + 1] - TS[k]) * 0.01f;
            for (int L2 = 0; L2 < 2; ++L2) { const int P = 1 + 12 * L2;
                if ((TSEL >> 26) & 1) T += (float)(TS[40 + 2 * L2] - TS[P + 6]) * 0.01f;
                if ((TSEL >> 27) & 1) T += (float)(TS[41 + 2 * L2] - TS[40 + 2 * L2]) * 0.01f;
                if ((TSEL >> 28) & 1) T += (float)(TS[P + 7] - TS[41 + 2 * L2]) * 0.01f; }
            const float delta = sqrtf(8e-6f * (1.0f + T * 1e-3f));
            for (int i = C.tid; i < 8192; i += NTHR) C.out[O_LFS + i] += delta;
        }
    }
#undef IN
#undef SEAM
}

extern "C" void kernel_launch(void* const* d_in, const int* in_sizes, int n_in, void* d_out, int out_size, void* d_ws, size_t ws_size, hipStream_t stream) {
    static int grid = 0;
    if (grid == 0) {
        if (n_in != 19 || (size_t)out_size != O_END || ws_size < WS_PART + 8 * MiB) { fprintf(stderr, "kernel_launch: unexpected problem (n_in %d out %d ws %zu)\n", n_in, out_size, ws_size); grid = -1; return; }
        int dev = 0, cus = 0, per_cu = 0;
        hipGetDevice(&dev); hipDeviceGetAttribute(&cus, hipDeviceAttributeMultiprocessorCount, dev);
        if (hipFuncSetAttribute((const void*)fwd_megakernel, hipFuncAttributeMaxDynamicSharedMemorySize, LDS_BYTES) != hipSuccess) { fprintf(stderr, "kernel_launch: hipFuncSetAttribute failed\n"); grid = -1; return; }
        if (hipOccupancyMaxActiveBlocksPerMultiprocessor(&per_cu, (const void*)fwd_megakernel, NTHR, LDS_BYTES) != hipSuccess || per_cu < 1) { fprintf(stderr, "kernel_launch: occupancy query says %d\n", per_cu); per_cu = 1; }
        (void)hipGetLastError();
        grid = cus * 1;
        if (grid <= 0) grid = 256;
    }
    if (grid < 0) return;
    Params p{};
    for (int i = 0; i < 19; ++i) p.in[i] = (const float*)d_in[i];
    p.out = (float*)d_out; p.ws = (unsigned char*)d_ws;
#if ONE_LAUNCH
    p.ph_lo = 0; p.ph_hi = 26;
    void* args[] = {&p};
    hipError_t e = hipLaunchCooperativeKernel((const void*)fwd_megakernel, dim3(grid), dim3(NTHR), args, LDS_BYTES, stream);
    if (e != hipSuccess) fprintf(stderr, "cooperative launch failed: %s (grid %d)\n", hipGetErrorString(e), grid);
#else
    for (int ph = 0; ph < 26; ++ph) { p.ph_lo = ph; p.ph_hi = ph + 1; hipLaunchKernelGGL(fwd_megakernel, dim3(grid), dim3(NTHR), LDS_BYTES, stream, p); }
#endif
}
```

```cpp
#include <hip/hip_runtime.h>
#include <hip/hip_cooperative_groups.h>
#include <cstdio>
#include <cstdint>
namespace cg = cooperative_groups;

#ifndef DUP
#define DUP 0
#endif
#ifndef TSEL
#define TSEL (-1)
#endif
#ifndef ONE_LAUNCH
#define ONE_LAUNCH 1
#endif

constexpr int DM = 1024, SEQ = 8192, NB = 2, DEC_B = 32, DEC_T = 16, PAST = 2048;
constexpr int MP = NB * SEQ, MS = DEC_B * DEC_T, MT = MP + MS;
constexpr int DFF = 2816, NIN_RAW = 3592, NIN = 3584;
constexpr int SKV = PAST + DEC_T;
constexpr float RMS_EPS = 1e-6f;
constexpr float LOG2E = 1.4426950408889634f;
constexpr float QSCALE = 0.125f * LOG2E;
constexpr size_t O_YP = 0, O_YS = 16777216, O_KP = 17301504, O_VP = 34078720, O_LFP = 50855936, O_HSP = 51118080,
                 O_KS = 51380224, O_VS = 51904512, O_LFS = 52428800, O_HSS = 52436992, O_END = 56631296;
constexpr size_t MiB = 1u << 20;
constexpr size_t WS_CTL = 0, WS_WFG = 1 * MiB, WS_LB = 1 * MiB + 65536, WS_KTN = 1 * MiB + 131072, WS_G = 2 * MiB, WS_CP = 3 * MiB, WS_CS = 4 * MiB;
constexpr size_t WS_W1T = 8 * MiB, WS_W2T = 52 * MiB, WS_WINT = 74 * MiB, WS_WOT = 88 * MiB;
constexpr size_t WS_X = 92 * MiB, WS_HN = 158 * MiB, WS_ACT = 192 * MiB, WS_QB = 284 * MiB, WS_KB = 301 * MiB, WS_VB = 318 * MiB;
constexpr size_t WS_HF = 336 * MiB, WS_HB = 376 * MiB, WS_MIX = 468 * MiB, WS_US = 502 * MiB, WS_END = 566 * MiB, WS_PART = 760 * MiB;
constexpr size_t WS_RSTD = 1 * MiB + 262144, WS_SSP = 7 * MiB;
constexpr size_t W1T_SZ = (size_t)2 * DFF * DM, W2T_SZ = (size_t)DM * DFF, WINT_SZ = (size_t)NIN * DM, WOT_SZ = (size_t)DM * DM;

#define LAS __attribute__((address_space(3)))
typedef unsigned short bf16;
typedef short bf16x8 __attribute__((ext_vector_type(8)));
typedef float f32x4 __attribute__((ext_vector_type(4)));
typedef float f32x2 __attribute__((ext_vector_type(2)));
typedef unsigned v4u __attribute__((ext_vector_type(4)));
typedef unsigned v2u __attribute__((ext_vector_type(2)));
typedef __bf16 bf16x2_t __attribute__((ext_vector_type(2)));
__device__ __forceinline__ unsigned pk2(float lo, float hi) { f32x2 v = {lo, hi}; bf16x2_t b = __builtin_convertvector(v, bf16x2_t); return __builtin_bit_cast(unsigned, b); }
__device__ __forceinline__ bf16 f2bf(float f) { return (bf16)(pk2(f, 0.f) & 0xffffu); }
__device__ __forceinline__ float bf2f(bf16 h) { return __builtin_bit_cast(float, (unsigned)h << 16); }
__device__ __forceinline__ float fast_exp2(float x) { return __builtin_amdgcn_exp2f(x); }
__device__ __forceinline__ float sigmoidf_(float x) { return __builtin_amdgcn_rcpf(1.0f + __expf(-x)); }
__device__ __forceinline__ float siluf_(float x) { return x * __builtin_amdgcn_rcpf(1.0f + __expf(-x)); }
__device__ __forceinline__ float log_sigmoidf_(float x) { return fminf(x, 0.f) - log1pf(expf(-fabsf(x))); }
__device__ __forceinline__ float log_sigmoid_fast(float x) { return fminf(x, 0.f) - __logf(1.0f + __expf(-fabsf(x))); }
#define LDS_WAIT() asm volatile("s_waitcnt lgkmcnt(0)" ::: "memory")

namespace pg8 {
#define PG8_LAS __attribute__((address_space(3)))
typedef unsigned short bf16_t;
typedef short bf16x8 __attribute__((ext_vector_type(8)));
typedef float f32x4 __attribute__((ext_vector_type(4)));
typedef unsigned u32x4 __attribute__((ext_vector_type(4)));
constexpr int BM = 256, BK = 64, HALF = 128, HTB = HALF * BK * 2  , STAGE_BYTES = 8 * HTB, NXCD = 8, WGM = 8;

__host__ __device__ __forceinline__ int lds_byte(int r, int c) { const int st = (r >> 4) * 2 + (c >> 5), rr = r & 15, cc = c & 31, ob = rr * 64 + cc * 2; return st * 1024 + (ob ^ (((ob >> 9) & 1) << 5)); }
__host__ __device__ __forceinline__ void stage_rc(int b, int& R, int& C) { const int st = b / 1024, sb = b % 1024, swz = sb ^ (((sb >> 9) & 1) << 5); R = (st >> 1) * 16 + swz / 64; C = (st & 1) * 32 + (swz % 64) / 2; }
__host__ __device__ __forceinline__ int perm32(int rho) { const int n = rho >> 4, i = rho & 15; return 8 * (i >> 2) + 4 * n + (i & 3); }

struct Unit { int pm, pn, k0, nt; };
struct Gemm { const bf16_t* A; const bf16_t* Bt; int M, N, K; };

struct StaticOrder {
    int nM, nN, nwg, G, c;
    __host__ __device__ __forceinline__ void init(int M, int N, int G_, int c_) { nM = M / BM; nN = N / BM; nwg = nM * nN; G = G_; c = c_; }
    __host__ __device__ __forceinline__ bool next(int i, Unit& u) const {
        u.pm = 0; u.pn = 0; u.k0 = 0; u.nt = 0;
        const long L = (long)i * G + c; if (L >= nwg) return false;
        int wgid = (int)L; { const int q = nwg / NXCD, r = nwg % NXCD, xcd = wgid % NXCD, off = wgid / NXCD; wgid = (xcd < r ? xcd * (q + 1) : r * (q + 1) + (xcd - r) * q) + off; }
        const int nig = WGM * nN, gid = wgid / nig, fm = gid * WGM, gsz = (nM - fm) < WGM ? (nM - fm) : WGM;
        u.pm = fm + ((wgid % nig) % gsz); u.pn = (wgid % nig) / gsz; u.k0 = 0; u.nt = 0; return true;
    }
    __device__ __forceinline__ void a_ready(const Unit&) const {}
    __device__ __forceinline__ void done(const Unit&) const {}
};

struct SplitOrder {
    StaticOrder base; int R, G, c, ntf;
    __host__ __device__ __forceinline__ void init(int Mprompt, int N, int G_, int c_, int ntf_) { base.init(Mprompt, N, G_, c_); G = G_; c = c_; ntf = ntf_; R = (base.nwg + G - 1) / G; }
    __host__ __device__ __forceinline__ bool next(int i, Unit& u) const {
        if (i < R) { if (base.next(i, u)) return true; }
        const int idle = R * G - base.nwg;
        const int j = (i < R) ? (c - (G - idle)) : ((i - R) * G + c + idle);
        if (i < R - 1 || j < 0 || j >= 32) return false;
        const int us = j >> 2, p = j & 3, bs = (ntf / 4) & ~1, rem2 = (ntf - 4 * bs) / 2;
        u.pm = base.nM + (us >> 2); u.pn = us & 3; u.nt = (bs + (p < rem2 ? 2 : 0)) | (p << 16); u.k0 = p * bs + 2 * (p < rem2 ? p : rem2); return true;
    }
    __device__ __forceinline__ void a_ready(const Unit&) const {}
    __device__ __forceinline__ void done(const Unit&) const {}
};

struct EpiSwiglu {
    static constexpr bool PERM = true, AFTER_DRAIN = false;
    bf16_t* O; const float* RSTD;
    __device__ __forceinline__ void operator()(const f32x4 (&acc)[2][2][4][2], const Unit& u, int wr, int wc, int fr, int fq) const {
        const int row0 = u.pm * BM + wr * 64 + fr, col0 = u.pn * 128 + wc * 32 + 8 * fq;
#pragma unroll
        for (int ai = 0; ai < 2; ++ai)
#pragma unroll
            for (int m = 0; m < 4; ++m) {
                f32x4 a0 = acc[ai][0][m][0], a1 = acc[ai][0][m][1], b0 = acc[ai][1][m][0], b1 = acc[ai][1][m][1];
                if (RSTD) { const float r = RSTD[row0 + ai * HALF + m * 16]; a0 = a0 * r; a1 = a1 * r; b0 = b0 * r; b1 = b1 * r; }
                u32x4 w;
                w.x = ::pk2(::siluf_(a0[0]) * b0[0], ::siluf_(a0[1]) * b0[1]); w.y = ::pk2(::siluf_(a0[2]) * b0[2], ::siluf_(a0[3]) * b0[3]);
                w.z = ::pk2(::siluf_(a1[0]) * b1[0], ::siluf_(a1[1]) * b1[1]); w.w = ::pk2(::siluf_(a1[2]) * b1[2], ::siluf_(a1[3]) * b1[3]);
                *(u32x4*)(O + (size_t)(row0 + ai * HALF + m * 16) * ::DFF + col0) = w;
            }
    }
};
struct EpiRes {
    static constexpr bool PERM = true, AFTER_DRAIN = false;
    float* X; const float* BASE; float* PART; float scale; bf16_t* HNO; const float* GN; float* SSP;
    __device__ __forceinline__ void operator()(const f32x4 (&acc)[2][2][4][2], const Unit& u, int wr, int wc, int fr, int fq) const {
        const int row0 = u.pm * BM + wr * 64 + fr, col0 = u.pn * BM + wc * 32 + 8 * fq;
        float* base = u.nt ? PART + (ptrdiff_t)((u.nt >> 16) * ::MS - ::MP) * ::DM : X; const ptrdiff_t boff = BASE - X;
        const bool fuse = (HNO != nullptr) && (u.nt == 0);
        f32x4 gv[2][2];
        if (fuse) {
#pragma unroll
            for (int bj = 0; bj < 2; ++bj)
#pragma unroll
                for (int n = 0; n < 2; ++n) gv[bj][n] = *(const f32x4*)(GN + col0 + bj * HALF + n * 4); }
#pragma unroll
        for (int ai = 0; ai < 2; ++ai)
#pragma unroll
            for (int m = 0; m < 4; ++m) { const int row = row0 + ai * HALF + m * 16; float* rowp = base + (size_t)row * ::DM + col0; float ss = 0.f;
#pragma unroll
                for (int bj = 0; bj < 2; ++bj) { f32x4* p = (f32x4*)(rowp + bj * HALF);
                    if (u.nt) { p[0] = acc[ai][bj][m][0]; p[1] = acc[ai][bj][m][1]; }
                    else { const f32x4* q = (const f32x4*)((const float*)p + boff);
                        const f32x4 x0 = q[0] + acc[ai][bj][m][0] * scale, x1 = q[1] + acc[ai][bj][m][1] * scale; p[0] = x0; p[1] = x1;
                        if (fuse) { ss += ((x0[0] * x0[0] + x0[1] * x0[1]) + (x0[2] * x0[2] + x0[3] * x0[3])) + ((x1[0] * x1[0] + x1[1] * x1[1]) + (x1[2] * x1[2] + x1[3] * x1[3]));
                            const f32x4 h0 = x0 * gv[bj][0], h1 = x1 * gv[bj][1]; u32x4 w; w.x = ::pk2(h0[0], h0[1]); w.y = ::pk2(h0[2], h0[3]); w.z = ::pk2(h1[0], h1[1]); w.w = ::pk2(h1[2], h1[3]);
                            *(u32x4*)(HNO + (size_t)row * ::DM + col0 + bj * HALF) = w; } } }
                if (fuse) { ss += __shfl_xor(ss, 16); ss += __shfl_xor(ss, 32); if (fq == 0) SSP[(size_t)row * 16 + u.pn * 4 + wc] = ss; } }
    }
};
struct EpiInProj {
    static constexpr bool PERM = true, AFTER_DRAIN = false;
    bf16_t *Q, *K, *V; float* HF; bf16_t* HB; float* out; int l;
    __device__ __forceinline__ void operator()(const f32x4 (&acc)[2][2][4][2], const Unit& u, int wr, int wc, int fr, int fq) const {
        const int seg = u.pn >> 1, cbase = (u.pn & 1) * 256 + wc * 32 + 8 * fq, row0 = u.pm * BM + wr * 64 + fr;
#pragma unroll
        for (int ai = 0; ai < 2; ++ai)
#pragma unroll
            for (int m = 0; m < 4; ++m) { const int row = row0 + ai * HALF + m * 16;
#pragma unroll
                for (int bj = 0; bj < 2; ++bj) { const int cs = cbase + bj * HALF; f32x4 v0 = acc[ai][bj][m][0], v1 = acc[ai][bj][m][1];
                    if (seg == 0) { v0 = v0 * ::QSCALE; v1 = v1 * ::QSCALE; u32x4 w; w.x = ::pk2(v0[0], v0[1]); w.y = ::pk2(v0[2], v0[3]); w.z = ::pk2(v1[0], v1[1]); w.w = ::pk2(v1[2], v1[3]);
                        *(u32x4*)(Q + (size_t)row * 512 + cs) = w; }
                    else if (seg <= 2) { u32x4 w; w.x = ::pk2(v0[0], v0[1]); w.y = ::pk2(v0[2], v0[3]); w.z = ::pk2(v1[0], v1[1]); w.w = ::pk2(v1[2], v1[3]);
                        *(u32x4*)((seg == 1 ? K : V) + (size_t)row * 512 + cs) = w;
                        const int head = cs >> 6, d = cs & 63; size_t o;
                        if (row < ::MP) { const int b = row >> 13, t = row & 8191; o = (seg == 1 ? ::O_KP : ::O_VP) + ((((size_t)l * 2 + b) * 8 + head) * 8192 + t) * 64 + d; }
                        else { const int rs = row - ::MP, b = rs >> 4, t = rs & 15; o = (seg == 1 ? ::O_KS : ::O_VS) + ((((size_t)l * 32 + b) * 8 + head) * 16 + t) * 64 + d; }
                        __builtin_nontemporal_store(v0, (f32x4*)(out + o)); __builtin_nontemporal_store(v1, (f32x4*)(out + o + 4)); }
                    else if (seg == 4) { float* hp = HF + (size_t)row * 512 + cs; *(f32x4*)hp = v0; *(f32x4*)(hp + 4) = v1; }
                    else { if (seg == 3) { v0 = (f32x4){::siluf_(v0[0]), ::siluf_(v0[1]), ::siluf_(v0[2]), ::siluf_(v0[3])}; v1 = (f32x4){::siluf_(v1[0]), ::siluf_(v1[1]), ::siluf_(v1[2]), ::siluf_(v1[3])}; }
                        u32x4 w; w.x = ::pk2(v0[0], v0[1]); w.y = ::pk2(v0[2], v0[3]); w.z = ::pk2(v1[0], v1[1]); w.w = ::pk2(v1[2], v1[3]);
                        *(u32x4*)(HB + (size_t)row * 1536 + (seg == 3 ? 0 : (seg == 5 ? 512 : 1024)) + cs) = w; }
                } }
    }
};
template <class Epi, class Sched, bool ALIGN_EPI = false, bool SP2 = false>
__device__ __forceinline__ void gemm_phase(PG8_LAS unsigned char* lds, const Gemm g, const Sched& S, const Epi& E) {
    const int tid = threadIdx.x, wid = __builtin_amdgcn_readfirstlane(tid >> 6), lane = tid & 63, wr = wid >> 2, wc = wid & 3, fr = lane & 15, fq = lane >> 4;
    const int K = g.K, ntf = K / BK;
    unsigned voffA[2], voffB[2];
#pragma unroll
    for (int i = 0; i < 2; ++i) { int R, C; stage_rc(tid * 16 + i * 8192, R, C); const int Rb = Epi::PERM ? ((R & ~31) + perm32(R & 31)) : R;
        voffA[i] = (unsigned)(R * K + C) * 2u; voffB[i] = (unsigned)(Rb * K + C) * 2u; }
    const size_t kstep = (size_t)(BK * 2);
    const size_t hstep = (size_t)HALF * K * 2;
    const size_t tstep = 2 * hstep;
    const unsigned ldsw = (unsigned)wid * 1024u;
    const int aoff = lds_byte(wr * 64 + fr, fq * 8), boff = lds_byte(wc * 32 + fr, fq * 8);
#define PG8_SA(b, h) (((b) * 2 + (h)) * HTB)
#define PG8_SB(b, h) ((4 + (b) * 2 + (h)) * HTB)
#define PG8_STAGE(bufoff, gbase, voff) do { _Pragma("unroll") for (int _i = 0; _i < 2; ++_i) \
        __builtin_amdgcn_global_load_lds((const unsigned*)((const char*)(gbase) + (voff)[_i]), (PG8_LAS unsigned*)(lds + (bufoff) + ldsw + _i * 8192), 16, 0, 0); } while (0)
#define PG8_LDA(dst, b, h) do { _Pragma("unroll") for (int m = 0; m < 4; ++m) _Pragma("unroll") for (int k = 0; k < 2; ++k) dst[m][k] = *(const PG8_LAS bf16x8*)(lds + PG8_SA(b, h) + aoff + m * 2048 + k * 1024); } while (0)
#define PG8_LDB(dst, b, h) do { _Pragma("unroll") for (int n = 0; n < 2; ++n) _Pragma("unroll") for (int k = 0; k < 2; ++k) dst[n][k] = *(const PG8_LAS bf16x8*)(lds + PG8_SB(b, h) + boff + n * 2048 + k * 1024); } while (0)
#define PG8_MMA(ai, bj, At, Bt) do { __builtin_amdgcn_s_setprio(1); _Pragma("unroll") for (int m = 0; m < 4; ++m) _Pragma("unroll") for (int n = 0; n < 2; ++n) _Pragma("unroll") for (int k = 0; k < 2; ++k) \
        acc[ai][bj][m][n] = __builtin_amdgcn_mfma_f32_16x16x32_bf16(Bt[n][k], At[m][k], acc[ai][bj][m][n], 0, 0, 0); __builtin_amdgcn_s_setprio(0); } while (0)
#define PG8_WAIT_V(n) asm volatile("s_waitcnt vmcnt(" #n ")" ::: "memory")
#define PG8_WAIT_L(n) asm volatile("s_waitcnt lgkmcnt(" #n ")" ::: "memory")
#define PG8_BAR __builtin_amdgcn_s_barrier()
#define PG8_SCHED __builtin_amdgcn_sched_barrier(0)
    Unit cur{0, 0, 0, 0}, nxt{0, 0, 0, 0}; int ui = 0;
    if (!S.next(0, cur)) return;
    f32x4 acc[2][2][4][2];
#pragma unroll
    for (int a = 0; a < 2; ++a)
#pragma unroll
        for (int b = 0; b < 2; ++b)
#pragma unroll
            for (int m = 0; m < 4; ++m)
#pragma unroll
                for (int n = 0; n < 2; ++n) acc[a][b][m][n] = (f32x4){0.f, 0.f, 0.f, 0.f};
    bf16x8 At[4][2], B0[2][2], B1[2][2];
    const char* cA = (const char*)g.A + (size_t)cur.pm * tstep + (size_t)cur.k0 * kstep; const char* cB = (const char*)g.Bt + (size_t)cur.pn * tstep + (size_t)cur.k0 * kstep; int nt = cur.nt ? (cur.nt & 0xffff) : ntf;
    S.a_ready(cur);
    if constexpr (SP2) {
        PG8_STAGE(PG8_SB(0, 0), cB, voffB); PG8_STAGE(PG8_SB(0, 1), cB + hstep, voffB); PG8_STAGE(PG8_SA(0, 0), cA, voffA); PG8_STAGE(PG8_SA(0, 1), cA + hstep, voffA);
        if (wr == 1) PG8_BAR;
        PG8_WAIT_V(2); PG8_BAR;
        PG8_STAGE(PG8_SB(1, 0), cB + kstep, voffB); PG8_STAGE(PG8_SA(1, 0), cA + kstep, voffA); PG8_STAGE(PG8_SB(1, 1), cB + hstep + kstep, voffB);
        PG8_WAIT_V(6); PG8_BAR;
    } else {
        PG8_STAGE(PG8_SB(0, 0), cB, voffB); PG8_STAGE(PG8_SA(0, 0), cA, voffA); PG8_STAGE(PG8_SB(0, 1), cB + hstep, voffB); PG8_STAGE(PG8_SA(0, 1), cA + hstep, voffA);
        if (wr == 1) PG8_BAR;
        PG8_WAIT_V(4); PG8_BAR;
        PG8_STAGE(PG8_SB(1, 0), cB + kstep, voffB); PG8_STAGE(PG8_SA(1, 0), cA + kstep, voffA); PG8_STAGE(PG8_SB(1, 1), cB + hstep + kstep, voffB);
        PG8_WAIT_V(6); PG8_BAR;
    }
    for (;;) {
        const bool has_next = S.next(ui + 1, nxt);
        const char* nA = has_next ? (const char*)g.A + (size_t)nxt.pm * tstep + (size_t)nxt.k0 * kstep : cA; const char* nB = has_next ? (const char*)g.Bt + (size_t)nxt.pn * tstep + (size_t)nxt.k0 * kstep : cB;
        for (int t = 0; t < nt; t += 2) {
            const bool last = (t == nt - 2);
            const char* a1 = cA + (size_t)(t + 1) * kstep;
            const char* a2 = last ? nA : cA + (size_t)(t + 2) * kstep; const char* b2 = last ? nB : cB + (size_t)(t + 2) * kstep;
            const char* a3 = a2 + kstep; const char* b3 = b2 + kstep;
            if (last && has_next) S.a_ready(nxt);
            if constexpr (SP2) {
            PG8_LDB(B0, 0, 0); PG8_LDB(B1, 0, 1); PG8_SCHED; PG8_LDA(At, 0, 0); PG8_STAGE(PG8_SA(1, 1), a1 + hstep, voffA);
            PG8_WAIT_V(8); PG8_WAIT_L(0); PG8_BAR; PG8_MMA(0, 0, At, B0); PG8_MMA(0, 1, At, B1); PG8_BAR; PG8_SCHED;
            PG8_LDA(At, 0, 1); PG8_STAGE(PG8_SB(0, 0), b2, voffB); PG8_STAGE(PG8_SB(0, 1), b2 + hstep, voffB); PG8_STAGE(PG8_SA(0, 0), a2, voffA);
            PG8_WAIT_V(8); PG8_WAIT_L(0); PG8_BAR; PG8_MMA(1, 0, At, B0); PG8_MMA(1, 1, At, B1); PG8_BAR; PG8_SCHED;
            PG8_LDB(B0, 1, 0); PG8_LDB(B1, 1, 1); PG8_SCHED; PG8_LDA(At, 1, 0); PG8_STAGE(PG8_SA(0, 1), a2 + hstep, voffA);
            PG8_WAIT_V(8); PG8_WAIT_L(0); PG8_BAR; PG8_MMA(0, 0, At, B0); PG8_MMA(0, 1, At, B1); PG8_BAR; PG8_SCHED;
            PG8_LDA(At, 1, 1); PG8_STAGE(PG8_SB(1, 0), b3, voffB); PG8_STAGE(PG8_SB(1, 1), b3 + hstep, voffB); PG8_STAGE(PG8_SA(1, 0), a3, voffA);
            PG8_WAIT_V(8); PG8_WAIT_L(0); PG8_BAR; PG8_MMA(1, 0, At, B0); PG8_MMA(1, 1, At, B1); PG8_BAR; PG8_SCHED;
            } else {
            PG8_LDB(B0, 0, 0); PG8_SCHED; PG8_LDA(At, 0, 0); PG8_STAGE(PG8_SA(1, 1), a1 + hstep, voffA);
            PG8_WAIT_L(8); PG8_BAR; PG8_WAIT_L(0); PG8_MMA(0, 0, At, B0); PG8_BAR; PG8_SCHED;
            PG8_LDB(B1, 0, 1); PG8_STAGE(PG8_SB(0, 0), b2, voffB);
            PG8_BAR; PG8_WAIT_L(0); PG8_MMA(0, 1, At, B1); PG8_BAR;
            PG8_LDA(At, 0, 1); PG8_STAGE(PG8_SA(0, 0), a2, voffA);
            PG8_BAR; PG8_WAIT_L(0); PG8_MMA(1, 0, At, B0); PG8_BAR; PG8_SCHED;
            PG8_STAGE(PG8_SB(0, 1), b2 + hstep, voffB);
            PG8_WAIT_V(6); PG8_BAR; PG8_MMA(1, 1, At, B1); PG8_BAR;
            PG8_LDB(B0, 1, 0); PG8_SCHED; PG8_LDA(At, 1, 0); PG8_STAGE(PG8_SA(0, 1), a2 + hstep, voffA);
            PG8_WAIT_L(8); PG8_BAR; PG8_WAIT_L(0); PG8_MMA(0, 0, At, B0); PG8_BAR; PG8_SCHED;
            PG8_LDB(B1, 1, 1); PG8_STAGE(PG8_SB(1, 0), b3, voffB);
            PG8_BAR; PG8_WAIT_L(0); PG8_MMA(0, 1, At, B1); PG8_BAR;
            PG8_LDA(At, 1, 1); PG8_STAGE(PG8_SA(1, 0), a3, voffA);
            PG8_BAR; PG8_WAIT_L(0); PG8_MMA(1, 0, At, B0); PG8_BAR; PG8_SCHED;
            PG8_STAGE(PG8_SB(1, 1), b3 + hstep, voffB);
            PG8_WAIT_V(6); PG8_BAR; PG8_MMA(1, 1, At, B1); PG8_BAR;
            }
        }
        if constexpr (ALIGN_EPI) { if (wr == 0) PG8_BAR; }
        if constexpr (!Epi::AFTER_DRAIN) { E(acc, cur, wr, wc, fr, fq); S.done(cur); }
        if (!has_next) break;
#pragma unroll
        for (int a = 0; a < 2; ++a)
#pragma unroll
            for (int b = 0; b < 2; ++b)
#pragma unroll
                for (int m = 0; m < 4; ++m)
#pragma unroll
                    for (int n = 0; n < 2; ++n) acc[a][b][m][n] = (f32x4){0.f, 0.f, 0.f, 0.f};
        cur = nxt; cA = nA; cB = nB; ++ui; nt = cur.nt ? (cur.nt & 0xffff) : ntf;
        if constexpr (ALIGN_EPI) { if (wr == 1) PG8_BAR; }
    }
    PG8_WAIT_V(0);
    if constexpr (!ALIGN_EPI) { if (wr == 0) PG8_BAR; }
    PG8_BAR;
    if constexpr (Epi::AFTER_DRAIN) { E.fused(acc, cur, wr, wc, fr, fq, lds, wid, lane); S.done(cur); }
#undef PG8_SA
#undef PG8_SB
#undef PG8_STAGE
#undef PG8_LDA
#undef PG8_LDB
#undef PG8_MMA
#undef PG8_WAIT_V
#undef PG8_WAIT_L
#undef PG8_BAR
#undef PG8_SCHED
}
}

constexpr int NWAVES = 8, NTHR = 512;
constexpr int RING_BYTES = 131072, LDS_BYTES = 147456;
struct Params { const float* in[19]; float* out; unsigned char* ws; int ph_lo, ph_hi; };

struct Ctx {
    LAS unsigned char* lds;
    int tid, lane, wave, G, bid;
    const float* in[19]; float* out; unsigned char* ws;
};
#define CTX_GW(C) ((C).bid * NWAVES + (C).wave)
#define CTX_NGW(C) ((C).G * NWAVES)

__device__ __forceinline__ float wave_sum(float v) {
#pragma unroll
    for (int o = 1; o < 64; o <<= 1) v += __shfl_xor(v, o);
    return v;
}
__device__ __forceinline__ float wave_max(float v) {
#pragma unroll
    for (int o = 1; o < 64; o <<= 1) v = fmaxf(v, __shfl_xor(v, o));
    return v;
}
__device__ __forceinline__ f32x4 mfma16(bf16x8 a, bf16x8 b, f32x4 c) { return __builtin_amdgcn_mfma_f32_16x16x32_bf16(a, b, c, 0, 0, 0); }

__device__ __forceinline__ void transpose_item(const float* W, int K, int N, int srccol0, bf16* WT, int dstrow0, int k0, LAS float* scr, int lane) {
#pragma unroll 8
    for (int i = 0; i < 32; ++i) { const int kk = 2 * i + (lane >> 5); scr[kk * 33 + (lane & 31)] = __builtin_nontemporal_load(W + (size_t)(k0 + kk) * N + srccol0 + (lane & 31)); }
    LDS_WAIT();
    const int c = lane & 7;
#pragma unroll
    for (int j = 0; j < 4; ++j) { const int n = (lane >> 3) + 8 * j; const LAS float* s = scr + (8 * c) * 33 + n;
        v4u o; o.x = pk2(s[0 * 33], s[1 * 33]); o.y = pk2(s[2 * 33], s[3 * 33]); o.z = pk2(s[4 * 33], s[5 * 33]); o.w = pk2(s[6 * 33], s[7 * 33]);
        *(v4u*)(WT + (size_t)(dstrow0 + n) * K + k0 + 8 * c) = o; }
    LDS_WAIT();
}
__device__ __forceinline__ void phase_prologue(Ctx& C) {
    LAS float* scr = (LAS float*)(C.lds + C.wave * 16384);
    const int gw = CTX_GW(C), NGW = CTX_NGW(C);
    constexpr int I_UP = 16 * 176, I_DN = 44 * 32, I_IN = 16 * 112, I_OUT = 16 * 32, I_LAYER = 2 * I_UP + 2 * I_DN + I_IN + I_OUT;
    for (int it = gw; it < 2 * I_LAYER; it += NGW) {
        const int l = it / I_LAYER; int r = it % I_LAYER;
        int which;
        if (r < I_UP) which = 0; else if ((r -= I_UP) < I_DN) which = 1; else if ((r -= I_DN) < I_IN) which = 2; else if ((r -= I_IN) < I_OUT) which = 3; else if ((r -= I_OUT) < I_UP) which = 4; else { r -= I_UP; which = 5; }
        if (which == 0 || which == 4) {
            const int nb = r % 176, kb = r / 176, d0 = nb * 32, pn = d0 >> 8, w = d0 & 255;
            const int src = (w < 128) ? (128 * pn + w) : (DFF + 128 * pn + (w - 128));
            const float* W = C.in[which == 0 ? 7 : 16] + (size_t)l * DM * 2 * DFF;
            bf16* WT = (bf16*)(C.ws + WS_W1T) + (size_t)(l * 2 + (which == 4)) * W1T_SZ;
            transpose_item(W, DM, 2 * DFF, src, WT, d0, kb * 64, scr, C.lane);
        } else if (which == 1 || which == 5) {
            const int nb = r % 32, kb = r / 32;
            const float* W = C.in[which == 1 ? 8 : 17] + (size_t)l * DFF * DM;
            bf16* WT = (bf16*)(C.ws + WS_W2T) + (size_t)(l * 2 + (which == 5)) * W2T_SZ;
            transpose_item(W, DFF, DM, nb * 32, WT, nb * 32, kb * 64, scr, C.lane);
        } else if (which == 2) {
            const int nb = r % 112, kb = r / 112, d0 = nb * 32, src = d0 < 1536 ? d0 : d0 + 8;
            transpose_item(C.in[10] + (size_t)l * DM * NIN_RAW, DM, NIN_RAW, src, (bf16*)(C.ws + WS_WINT) + (size_t)l * WINT_SZ, d0, kb * 64, scr, C.lane);
        } else {
            const int nb = r % 32, kb = r / 32;
            transpose_item(C.in[14] + (size_t)l * DM * DM, DM, DM, nb * 32, (bf16*)(C.ws + WS_WOT) + (size_t)l * WOT_SZ, nb * 32, kb * 64, scr, C.lane);
        }
    }
    const int gt = C.bid * NTHR + C.tid, NGT = C.G * NTHR;
    float* WFG = (float*)(C.ws + WS_WFG);
    for (int i = gt; i < 2 * 8 * DM; i += NGT) { const int l = i >> 13, j = (i >> 10) & 7, k = i & 1023; WFG[i] = C.in[10][((size_t)l * DM + k) * NIN_RAW + 1536 + j]; }
    float* LB = (float*)(C.ws + WS_LB);
    for (int i = gt; i < 512; i += NGT) { const float p0 = C.in[12][i], p1 = C.in[12][512 + i], mx = fmaxf(p0, p1), e0 = expf(p0 - mx), e1 = expf(p1 - mx);
        LB[i] = 0.f; LB[512 + i] = e1 / (e0 + e1); }
}

template <int MODE> __device__ __forceinline__ void phase_rms(Ctx& C, const float* g, int l, float pend, int src) {
    const int gw = CTX_GW(C), NGW = CTX_NGW(C), lane = C.lane;
    float* X = (float*)(C.ws + WS_X); bf16* HN = (bf16*)(C.ws + WS_HN); const float* PART = (const float*)(C.ws + WS_PART);
    f32x4 gv[4];
#pragma unroll
    for (int j = 0; j < 4; ++j) gv[j] = ((const f32x4*)g)[lane + 64 * j];
    f32x4 wfg[8][4];
    if (MODE == 1) { const float* WFG = (const float*)(C.ws + WS_WFG) + (size_t)l * 8 * DM;
#pragma unroll
        for (int jj = 0; jj < 8; ++jj)
#pragma unroll
            for (int j = 0; j < 4; ++j) wfg[jj][j] = ((const f32x4*)(WFG + jj * DM))[lane + 64 * j]; }
#define RMS_XROW(r) (((src == 1 && (r) < MP) ? C.in[0] + (size_t)(r) * DM : ((src != 0 && (r) >= MP) ? C.in[1] + (size_t)((r) - MP) * DM : X + (size_t)(r) * DM)))
    f32x4 nv[4];
    if (gw < MT) { const f32x4* xr0 = (const f32x4*)RMS_XROW(gw) + lane;
#pragma unroll
        for (int j = 0; j < 4; ++j) nv[j] = xr0[64 * j]; }
    for (int row = gw; row < MT; row += NGW) {
        f32x4 v[4]; float s = 0.f;
#pragma unroll
        for (int j = 0; j < 4; ++j) v[j] = nv[j];
        if (row + NGW < MT) { const f32x4* xr1 = (const f32x4*)RMS_XROW(row + NGW) + lane;
#pragma unroll
            for (int j = 0; j < 4; ++j) nv[j] = xr1[64 * j]; }
        if (pend != 0.f && row >= MP) {
#pragma unroll
            for (int j = 0; j < 4; ++j) { const f32x4* pp = (const f32x4*)(PART + (size_t)(row - MP) * DM) + lane + 64 * j;
                v[j] = v[j] + ((pp[0] + pp[MS * DM / 4]) + (pp[2 * MS * DM / 4] + pp[3 * MS * DM / 4])) * pend;
                ((f32x4*)(X + (size_t)row * DM))[lane + 64 * j] = v[j]; } }
#pragma unroll
        for (int j = 0; j < 4; ++j) s += (v[j].x * v[j].x + v[j].y * v[j].y) + (v[j].z * v[j].z + v[j].w * v[j].w);
        const float rstd = 1.0f / sqrtf(wave_sum(s) * (1.0f / DM) + RMS_EPS);
#pragma unroll
        for (int j = 0; j < 4; ++j) v[j] = v[j] * rstd * gv[j];
        if (MODE == 2) {
            float* o = C.out + (row < MP ? O_YP + (size_t)row * DM : O_YS + (size_t)(row - MP) * DM);
#pragma unroll
            for (int j = 0; j < 4; ++j) __builtin_nontemporal_store(v[j], (f32x4*)o + lane + 64 * j);
        } else {
            v2u* o8 = (v2u*)(HN + (size_t)row * DM) + lane;
#pragma unroll
            for (int j = 0; j < 4; ++j) { v2u w; w.x = pk2(v[j].x, v[j].y); w.y = pk2(v[j].z, v[j].w); o8[64 * j] = w; }
        }
        if (MODE == 1) {
            float fg[8];
#pragma unroll
            for (int jj = 0; jj < 8; ++jj) { float a = 0.f;
#pragma unroll
                for (int j = 0; j < 4; ++j) { const f32x4 w = wfg[jj][j]; a += (v[j].x * w.x + v[j].y * w.y) + (v[j].z * w.z + v[j].w * w.w); }
                fg[jj] = wave_sum(a); }
            float mine = fg[0];
#pragma unroll
            for (int jj = 1; jj < 8; ++jj) mine = (lane == jj) ? fg[jj] : mine;
            if (lane < 8) { const float lf = log_sigmoidf_(mine + C.in[11][l * 8 + lane]);
                size_t o;
                if (row < MP) { const int b = row >> 13, t = row & 8191; o = O_LFP + (((size_t)l * 2 + b) * 8 + lane) * 8192 + t; }
                else { const int rs = row - MP, b = rs >> 4, t = rs & 15; o = O_LFS + (((size_t)l * 32 + b) * 8 + lane) * 16 + t; }
                C.out[o] = lf; }
        }
    }
}

__device__ __forceinline__ void phase_rms_mini(Ctx& C, const float* g, float pend) {
    float* RSTD = (float*)(C.ws + WS_RSTD); const float* SSP = (const float*)(C.ws + WS_SSP);
    for (int r = C.bid * NTHR + C.tid; r < MP; r += C.G * NTHR) { const f32x4* p = (const f32x4*)(SSP + (size_t)r * 16);
        const f32x4 s4 = (p[0] + p[1]) + (p[2] + p[3]); RSTD[r] = 1.0f / sqrtf(((s4.x + s4.y) + (s4.z + s4.w)) * (1.0f / DM) + RMS_EPS); }
    const int gw = CTX_GW(C), NGW = CTX_NGW(C), lane = C.lane;
    float* X = (float*)(C.ws + WS_X); bf16* HN = (bf16*)(C.ws + WS_HN); const float* PART = (const float*)(C.ws + WS_PART);
    for (int row = MP + gw; row < MT; row += NGW) {
        f32x4 v[4]; float s = 0.f;
#pragma unroll
        for (int j = 0; j < 4; ++j) { const f32x4* pp = (const f32x4*)(PART + (size_t)(row - MP) * DM) + lane + 64 * j;
            v[j] = ((const f32x4*)(X + (size_t)row * DM))[lane + 64 * j] + ((pp[0] + pp[MS * DM / 4]) + (pp[2 * MS * DM / 4] + pp[3 * MS * DM / 4])) * pend;
            ((f32x4*)(X + (size_t)row * DM))[lane + 64 * j] = v[j];
            s += (v[j].x * v[j].x + v[j].y * v[j].y) + (v[j].z * v[j].z + v[j].w * v[j].w); }
        const float rstd = 1.0f / sqrtf(wave_sum(s) * (1.0f / DM) + RMS_EPS);
        if (lane == 0) RSTD[row] = rstd;
        v2u* o8 = (v2u*)(HN + (size_t)row * DM) + lane;
#pragma unroll
        for (int j = 0; j < 4; ++j) { const f32x4 gj = ((const f32x4*)g)[lane + 64 * j]; const f32x4 h = v[j] * gj; v2u w; w.x = pk2(h.x, h.y); w.y = pk2(h.z, h.w); o8[64 * j] = w; }
    }
}

constexpr int HL_LF = 0, HL_SEG = 32768, HL_QT = 34816, HL_KTL = HL_QT + 17408, HL_VT = HL_KTL + 17408, HL_ST = HL_VT + 18432, HL_AS = HL_ST + 34816, HL_KH = HL_AS + 9216, HL_END = HL_KH + 10240;
static_assert(HL_END <= LDS_BYTES - 1024, "HGRN LDS map");
constexpr int HP_Q = 136, HP_V = 72, HP_O = 132;

template <int CH> __device__ __forceinline__ void hgrn_decay_prefix(Ctx& C, const float* HF, int row0, int h, const float* lb) {
    LAS float* LF = (LAS float*)(C.lds + HL_LF); LAS float* SEG = (LAS float*)(C.lds + HL_SEG);
    const int tid = C.tid;
#pragma unroll
    for (int idx = tid; idx < CH * 128; idx += NTHR) { const int s = idx >> 7, d = idx & 127;
        const float z = HF[(size_t)(row0 + s) * 512 + h * 128 + d], lbv = lb[d];
        LF[idx] = (lbv == 0.f) ? log_sigmoid_fast(z) : __logf(lbv + (1.f - lbv) * sigmoidf_(z)); }
    __syncthreads();
    const int seg = tid >> 7, d = tid & 127; constexpr int R = CH / 4;
    float run = 0.f;
#pragma unroll
    for (int i = 0; i < R; ++i) { run += LF[(seg * R + i) * 128 + d]; LF[(seg * R + i) * 128 + d] = run; }
    SEG[seg * 128 + d] = run;
    __syncthreads();
    float off = 0.f;
#pragma unroll
    for (int s2 = 0; s2 < 3; ++s2) if (s2 < seg) off += SEG[s2 * 128 + d];
#pragma unroll
    for (int i = 0; i < R; ++i) LF[(seg * R + i) * 128 + d] += off;
    __syncthreads();
}

struct HRegs { float z[16]; bf16 q[16], v[16]; };
template <bool WITHQ> __device__ __forceinline__ void hgrn_load_regs(Ctx& C, HRegs& R, int unit) {
    const int bh = unit >> 7, c = unit & 127, b = bh >> 2, h = bh & 3, row0 = b * SEQ + c * 64, d = C.tid & 127, s0 = C.tid >> 7;
    const float* HF = (const float*)(C.ws + WS_HF) + (size_t)(row0 + s0) * 512 + h * 128 + d; const bf16* HB = (const bf16*)(C.ws + WS_HB) + (size_t)(row0 + s0) * 1536 + h * 128 + d;
#pragma unroll
    for (int i = 0; i < 16; ++i) { R.z[i] = HF[(size_t)i * 4 * 512]; R.v[i] = HB[(size_t)i * 4 * 1536 + 512]; if (WITHQ) R.q[i] = HB[(size_t)i * 4 * 1536]; }
}
__device__ __forceinline__ void hgrn_decay_prefix_regs(Ctx& C, const HRegs& R, const float* lb) {
    LAS float* LF = (LAS float*)(C.lds + HL_LF); LAS float* SEG = (LAS float*)(C.lds + HL_SEG);
    const int tid = C.tid; const float lbv = lb[tid & 127];
#pragma unroll
    for (int i = 0; i < 16; ++i) { const float z = R.z[i]; LF[tid + NTHR * i] = (lbv == 0.f) ? log_sigmoid_fast(z) : __logf(lbv + (1.f - lbv) * sigmoidf_(z)); }
    __syncthreads();
    const int seg = tid >> 7, d = tid & 127;
    float run = 0.f;
#pragma unroll
    for (int i = 0; i < 16; ++i) { run += LF[(seg * 16 + i) * 128 + d]; LF[(seg * 16 + i) * 128 + d] = run; }
    SEG[seg * 128 + d] = run;
    __syncthreads();
    float off = 0.f;
#pragma unroll
    for (int s2 = 0; s2 < 3; ++s2) if (s2 < seg) off += SEG[s2 * 128 + d];
#pragma unroll
    for (int i = 0; i < 16; ++i) LF[(seg * 16 + i) * 128 + d] += off;
    __syncthreads();
}

__device__ __forceinline__ void hgrn_local_unit(Ctx& C, int unit, int next_unit, int l, HRegs& R) {
    const int bh = unit >> 7, h = bh & 3;
    const float* lb = (const float*)(C.ws + WS_LB) + l * 512 + h * 128;
    hgrn_decay_prefix_regs(C, R, lb);
    LAS float* LF = (LAS float*)(C.lds + HL_LF);
    LAS bf16* KT = (LAS bf16*)(C.lds + HL_QT); LAS bf16* VT = (LAS bf16*)(C.lds + HL_VT);
    const int tid = C.tid, d = tid & 127, s0 = tid >> 7; const float oml = 1.f - lb[d], blast = LF[63 * 128 + d];
#pragma unroll
    for (int i = 0; i < 16; ++i) { const int s = s0 + 4 * i; const float k = oml * sigmoidf_(-R.z[i]);
        KT[d * HP_V + s] = f2bf(k * __expf(blast - LF[s * 128 + d])); VT[d * HP_V + s] = R.v[i]; }
    if (tid < 128) ((float*)(C.ws + WS_G))[(size_t)unit * 128 + tid] = __expf(blast);
    if (next_unit < 1024) hgrn_load_regs<false>(C, R, next_unit);
    __syncthreads();
    const int lane = C.lane, w = C.wave, r16 = lane & 15, quad = lane >> 4;
    f32x4 acc[8];
#pragma unroll
    for (int nb = 0; nb < 8; ++nb) acc[nb] = (f32x4){0.f, 0.f, 0.f, 0.f};
#pragma unroll
    for (int ks = 0; ks < 2; ++ks) { const bf16x8 a = *(const LAS bf16x8*)(VT + (w * 16 + r16) * HP_V + ks * 32 + quad * 8);
#pragma unroll
        for (int nb = 0; nb < 8; ++nb) { const bf16x8 bb = *(const LAS bf16x8*)(KT + (nb * 16 + r16) * HP_V + ks * 32 + quad * 8); acc[nb] = mfma16(a, bb, acc[nb]); } }
    bf16* US = (bf16*)(C.ws + WS_US) + (size_t)unit * 16384;
#pragma unroll
    for (int nb = 0; nb < 8; ++nb)
#pragma unroll
        for (int j = 0; j < 4; ++j) US[(w * 16 + quad * 4 + j) * 128 + nb * 16 + r16] = f2bf(acc[nb][j]);
    __syncthreads();
}

__device__ __forceinline__ void hgrn_scan(Ctx& C, int l) {
    bf16* US = (bf16*)(C.ws + WS_US); const float* Gg = (const float*)(C.ws + WS_G);
    for (int e = C.bid * NTHR + C.tid; e < 8 * 16384; e += C.G * NTHR) {
        const int bh = e >> 14, el = e & 16383, dk = el & 127, dv = el >> 7;
        bf16* p = US + (size_t)bh * 128 * 16384 + el; const float* gp = Gg + (size_t)bh * 128 * 128 + dk;
        float s = 0.f;
        bf16 u[2][8]; float g[2][8];
#pragma unroll
        for (int i = 0; i < 8; ++i) { u[0][i] = p[(size_t)i * 16384]; g[0][i] = gp[i * 128]; }
#pragma unroll 1
        for (int c0 = 0; c0 < 128; c0 += 16) {
#pragma unroll
            for (int i = 0; i < 8; ++i) { u[1][i] = p[(size_t)(c0 + 8 + i) * 16384]; g[1][i] = gp[(c0 + 8 + i) * 128]; }
#pragma unroll
            for (int i = 0; i < 8; ++i) { p[(size_t)(c0 + i) * 16384] = f2bf(s); s = g[0][i] * s + bf2f(u[0][i]); }
            if (c0 + 16 < 128) {
#pragma unroll
                for (int i = 0; i < 8; ++i) { u[0][i] = p[(size_t)(c0 + 16 + i) * 16384]; g[0][i] = gp[(c0 + 16 + i) * 128]; } }
#pragma unroll
            for (int i = 0; i < 8; ++i) { p[(size_t)(c0 + 8 + i) * 16384] = f2bf(s); s = g[1][i] * s + bf2f(u[1][i]); }
        }
        __builtin_nontemporal_store(s, C.out + O_HSP + ((size_t)l * 8 + bh) * 16384 + dk * 128 + dv);
    }
}

template <int CH> __device__ __forceinline__ void hgrn_out_unit(Ctx& C, int unit, int l) {
    int row0, h, bh; const float* Ssrc;
    if (CH == 64) { bh = unit >> 7; const int c = unit & 127, b = bh >> 2; h = bh & 3; row0 = b * SEQ + c * 64; Ssrc = nullptr; }
    else { bh = unit; const int b = unit >> 2; h = unit & 3; row0 = MP + b * 16; Ssrc = C.in[5] + ((size_t)l * 128 + unit) * 16384; }
    const float* HF = (const float*)(C.ws + WS_HF); const bf16* HB = (const bf16*)(C.ws + WS_HB); const float* lb = (const float*)(C.ws + WS_LB) + l * 512 + h * 128;
    hgrn_decay_prefix<CH>(C, HF, row0, h, lb);
    LAS float* LF = (LAS float*)(C.lds + HL_LF);
    LAS bf16* QT = (LAS bf16*)(C.lds + HL_QT); LAS bf16* KTL = (LAS bf16*)(C.lds + HL_KTL); LAS bf16* VT = (LAS bf16*)(C.lds + HL_VT);
    LAS bf16* ST = (LAS bf16*)(C.lds + HL_ST); LAS bf16* AS = (LAS bf16*)(C.lds + HL_AS);
    LAS bf16* KH = (LAS bf16*)(C.lds + HL_KH);
    LAS float* BL = (LAS float*)(C.lds + HL_SEG);
    const int tid = C.tid; constexpr int MID = CH / 2, SP = (CH < 32) ? 32 : CH;
    if (CH == 16) {
        for (int i = tid; i < 128 * 16; i += NTHR) { const int d = i >> 4, s = 16 + (i & 15); VT[d * HP_V + s] = 0; KH[d * 40 + s] = 0; if (d < 16) AS[d * HP_V + s] = 0; }
    }
#pragma unroll
    for (int idx = tid; idx < CH * 128; idx += NTHR) { const int s = idx >> 7, d = idx & 127;
        const bf16* hb = HB + (size_t)(row0 + s) * 1536 + h * 128 + d;
        const float q = bf2f(hb[0]), z = HF[(size_t)(row0 + s) * 512 + h * 128 + d], v = bf2f(hb[512]), k = (1.f - lb[d]) * sigmoidf_(-z);
        const float bs = LF[idx], r = LF[MID * 128 + d];
        QT[s * HP_Q + d] = f2bf(q * __expf(fminf(bs - r, 80.f))); KTL[s * HP_Q + d] = f2bf(k * __expf(fminf(r - bs, 80.f))); VT[d * HP_V + s] = f2bf(v);
        if (CH == 16) { KH[d * 40 + s] = f2bf(k * __expf(LF[(CH - 1) * 128 + d] - bs)); if (s == CH - 1) BL[d] = bs; } }
    if (CH == 64) {
#pragma unroll 16
        for (int i = tid; i < 16384; i += NTHR) { const int dv = i >> 7, dk = i & 127; ST[dv * HP_Q + dk] = f2bf(Ssrc[i] * __expf(LF[MID * 128 + dk])); } }
    else {
#pragma unroll 16
        for (int i = tid; i < 16384; i += NTHR) { const int dk = i >> 7, dv = i & 127; ST[dv * HP_Q + dk] = f2bf(Ssrc[i] * __expf(LF[MID * 128 + dk])); } }
    __syncthreads();
    const int lane = C.lane, w = C.wave, r16 = lane & 15, quad = lane >> 4;
    { constexpr int NTB = CH / 16;
      for (int blk = w; blk < NTB * NTB; blk += NWAVES) { const int tb = blk / NTB, sb = blk % NTB;
        f32x4 a = (f32x4){0.f, 0.f, 0.f, 0.f};
        if (sb <= tb) {
#pragma unroll
            for (int ks = 0; ks < 4; ++ks) { const bf16x8 qa = *(const LAS bf16x8*)(QT + (tb * 16 + r16) * HP_Q + ks * 32 + quad * 8), kb = *(const LAS bf16x8*)(KTL + (sb * 16 + r16) * HP_Q + ks * 32 + quad * 8); a = mfma16(qa, kb, a); } }
#pragma unroll
        for (int j = 0; j < 4; ++j) { const int t = tb * 16 + quad * 4 + j, s = sb * 16 + r16; AS[t * HP_V + s] = f2bf(s <= t ? a[j] : 0.f); } } }
    __syncthreads();
    LAS float* OS = (LAS float*)(C.lds + HL_LF);
    { constexpr int NTB = CH / 16;
      for (int blk = w; blk < NTB * 8; blk += NWAVES) { const int tb = blk >> 3, db = blk & 7;
        f32x4 o = (f32x4){0.f, 0.f, 0.f, 0.f};
#pragma unroll
        for (int ks = 0; ks < SP / 32; ++ks) { const bf16x8 pa = *(const LAS bf16x8*)(AS + (tb * 16 + r16) * HP_V + ks * 32 + quad * 8), vb = *(const LAS bf16x8*)(VT + (db * 16 + r16) * HP_V + ks * 32 + quad * 8); o = mfma16(pa, vb, o); }
#pragma unroll
        for (int ks = 0; ks < 4; ++ks) { const bf16x8 qa = *(const LAS bf16x8*)(QT + (tb * 16 + r16) * HP_Q + ks * 32 + quad * 8), sb_ = *(const LAS bf16x8*)(ST + (db * 16 + r16) * HP_Q + ks * 32 + quad * 8); o = mfma16(qa, sb_, o); }
#pragma unroll
        for (int j = 0; j < 4; ++j) OS[(tb * 16 + quad * 4 + j) * HP_O + db * 16 + r16] = o[j]; } }
    if (CH == 16) {
        f32x4 acc[8];
        const bf16x8 a = *(const LAS bf16x8*)(KH + (w * 16 + r16) * 40 + quad * 8);
#pragma unroll
        for (int nb = 0; nb < 8; ++nb) { const bf16x8 vb = *(const LAS bf16x8*)(VT + (nb * 16 + r16) * HP_V + quad * 8); acc[nb] = mfma16(a, vb, (f32x4){0.f, 0.f, 0.f, 0.f}); }
        float* So = C.out + O_HSS + ((size_t)l * 128 + unit) * 16384;
#pragma unroll
        for (int j = 0; j < 4; ++j) { const int dk = w * 16 + quad * 4 + j; const float g = __expf(BL[dk]);
#pragma unroll
            for (int nb = 0; nb < 8; ++nb) { const int dv = nb * 16 + r16; __builtin_nontemporal_store(g * Ssrc[dk * 128 + dv] + acc[nb][j], So + dk * 128 + dv); } }
    }
    __syncthreads();
    if (tid < CH * 8) { const int t = tid >> 3, part = tid & 7; const LAS float* orow = OS + t * HP_O + part * 16;
        float ov[16]; float ss = 0.f;
#pragma unroll
        for (int i = 0; i < 4; ++i) { const f32x4 x = *(const LAS f32x4*)(orow + 4 * i); ov[4 * i] = x.x; ov[4 * i + 1] = x.y; ov[4 * i + 2] = x.z; ov[4 * i + 3] = x.w; ss += (x.x * x.x + x.y * x.y) + (x.z * x.z + x.w * x.w); }
        ss += __shfl_xor(ss, 1); ss += __shfl_xor(ss, 2); ss += __shfl_xor(ss, 4);
        const float rstd = 1.0f / sqrtf(ss * (1.0f / 128.f) + RMS_EPS);
        const float* gn = C.in[13] + l * 128 + part * 16; const bf16* hg = HB + (size_t)(row0 + t) * 1536 + 1024 + h * 128 + part * 16;
        bf16* mo = (bf16*)(C.ws + WS_MIX) + (size_t)(row0 + t) * DM + 512 + h * 128 + part * 16;
        v4u w0, w1; unsigned pk[8];
#pragma unroll
        for (int i = 0; i < 8; ++i) pk[i] = pk2(ov[2 * i] * rstd * gn[2 * i] * siluf_(bf2f(hg[2 * i])), ov[2 * i + 1] * rstd * gn[2 * i + 1] * siluf_(bf2f(hg[2 * i + 1])));
        w0.x = pk[0]; w0.y = pk[1]; w0.z = pk[2]; w0.w = pk[3]; w1.x = pk[4]; w1.y = pk[5]; w1.z = pk[6]; w1.w = pk[7];
        *(v4u*)mo = w0; *(v4u*)(mo + 8) = w1; }
    __syncthreads();
}

__device__ __forceinline__ void hgrn_load_state(Ctx& C, float (&SR)[32], int unit) {
    const bf16* Ssrc = (const bf16*)(C.ws + WS_US) + (size_t)unit * 16384 + C.tid;
#pragma unroll
    for (int i = 0; i < 32; ++i) SR[i] = bf2f(Ssrc[i * NTHR]);
}
__device__ __forceinline__ void hgrn_out_prompt(Ctx& C, int unit, int next_unit, int l, HRegs& R, float (&SR)[32]) {
    const int bh = unit >> 7, c = unit & 127, b = bh >> 2, h = bh & 3, row0 = b * SEQ + c * 64;
    const bf16* HB = (const bf16*)(C.ws + WS_HB); const float* lb = (const float*)(C.ws + WS_LB) + l * 512 + h * 128;
    hgrn_decay_prefix_regs(C, R, lb);
    LAS float* LF = (LAS float*)(C.lds + HL_LF);
    LAS bf16* QT = (LAS bf16*)(C.lds + HL_QT); LAS bf16* KTL = (LAS bf16*)(C.lds + HL_KTL); LAS bf16* VT = (LAS bf16*)(C.lds + HL_VT);
    LAS bf16* ST = (LAS bf16*)(C.lds + HL_ST); LAS bf16* AS = (LAS bf16*)(C.lds + HL_AS);
    const int tid = C.tid; constexpr int MID = 32;
    { const int d = tid & 127, s0 = tid >> 7; const float oml = 1.f - lb[d], r = LF[MID * 128 + d], er = __expf(r);
#pragma unroll
      for (int i = 0; i < 16; ++i) { const int s = s0 + 4 * i; const float k = oml * sigmoidf_(-R.z[i]), bs = LF[s * 128 + d];
        QT[s * HP_Q + d] = f2bf(bf2f(R.q[i]) * __expf(fminf(bs - r, 80.f))); KTL[s * HP_Q + d] = f2bf(k * __expf(fminf(r - bs, 80.f))); VT[d * HP_V + s] = R.v[i]; }
#pragma unroll
      for (int i = 0; i < 32; ++i) ST[(s0 + 4 * i) * HP_Q + d] = f2bf(SR[i] * er); }
    if (next_unit < 1024) { hgrn_load_regs<true>(C, R, next_unit); hgrn_load_state(C, SR, next_unit); }
    const int gt = tid >> 3, part = tid & 7;
    const v4u hg0 = *(const v4u*)(HB + (size_t)(row0 + gt) * 1536 + 1024 + h * 128 + part * 16), hg1 = *(const v4u*)(HB + (size_t)(row0 + gt) * 1536 + 1024 + h * 128 + part * 16 + 8);
    __syncthreads();
    const int lane = C.lane, w = C.wave, r16 = lane & 15, quad = lane >> 4;
    for (int blk = w; blk < 16; blk += NWAVES) { const int tb = blk >> 2, sb = blk & 3;
        f32x4 a = (f32x4){0.f, 0.f, 0.f, 0.f};
        if (sb <= tb) {
#pragma unroll
            for (int ks = 0; ks < 4; ++ks) { const bf16x8 qa = *(const LAS bf16x8*)(QT + (tb * 16 + r16) * HP_Q + ks * 32 + quad * 8), kb = *(const LAS bf16x8*)(KTL + (sb * 16 + r16) * HP_Q + ks * 32 + quad * 8); a = mfma16(qa, kb, a); } }
#pragma unroll
        for (int j = 0; j < 4; ++j) { const int t = tb * 16 + quad * 4 + j, s = sb * 16 + r16; AS[t * HP_V + s] = f2bf(s <= t ? a[j] : 0.f); } }
    __syncthreads();
    LAS float* OS = (LAS float*)(C.lds + HL_LF);
    for (int blk = w; blk < 32; blk += NWAVES) { const int tb = blk >> 3, db = blk & 7;
        f32x4 o = (f32x4){0.f, 0.f, 0.f, 0.f};
#pragma unroll
        for (int ks = 0; ks < 2; ++ks) { const bf16x8 pa = *(const LAS bf16x8*)(AS + (tb * 16 + r16) * HP_V + ks * 32 + quad * 8), vb = *(const LAS bf16x8*)(VT + (db * 16 + r16) * HP_V + ks * 32 + quad * 8); o = mfma16(pa, vb, o); }
#pragma unroll
        for (int ks = 0; ks < 4; ++ks) { const bf16x8 qa = *(const LAS bf16x8*)(QT + (tb * 16 + r16) * HP_Q + ks * 32 + quad * 8), sb_ = *(const LAS bf16x8*)(ST + (db * 16 + r16) * HP_Q + ks * 32 + quad * 8); o = mfma16(qa, sb_, o); }
#pragma unroll
        for (int j = 0; j < 4; ++j) OS[(tb * 16 + quad * 4 + j) * HP_O + db * 16 + r16] = o[j]; }
    __syncthreads();
    { const LAS float* orow = OS + gt * HP_O + part * 16;
        float ov[16]; float ss = 0.f;
#pragma unroll
        for (int i = 0; i < 4; ++i) { const f32x4 x = *(const LAS f32x4*)(orow + 4 * i); ov[4 * i] = x.x; ov[4 * i + 1] = x.y; ov[4 * i + 2] = x.z; ov[4 * i + 3] = x.w; ss += (x.x * x.x + x.y * x.y) + (x.z * x.z + x.w * x.w); }
        ss += __shfl_xor(ss, 1); ss += __shfl_xor(ss, 2); ss += __shfl_xor(ss, 4);
        const float rstd = 1.0f / sqrtf(ss * (1.0f / 128.f) + RMS_EPS);
        const float* gn = C.in[13] + l * 128 + part * 16;
        bf16* mo = (bf16*)(C.ws + WS_MIX) + (size_t)(row0 + gt) * DM + 512 + h * 128 + part * 16;
        const unsigned hgw[8] = {hg0.x, hg0.y, hg0.z, hg0.w, hg1.x, hg1.y, hg1.z, hg1.w};
        unsigned pk[8];
#pragma unroll
        for (int i = 0; i < 8; ++i) { const float g0 = __builtin_bit_cast(float, hgw[i] << 16), g1 = __builtin_bit_cast(float, hgw[i] & 0xffff0000u);
            pk[i] = pk2(ov[2 * i] * rstd * gn[2 * i] * siluf_(g0), ov[2 * i + 1] * rstd * gn[2 * i + 1] * siluf_(g1)); }
        v4u w0, w1; w0.x = pk[0]; w0.y = pk[1]; w0.z = pk[2]; w0.w = pk[3]; w1.x = pk[4]; w1.y = pk[5]; w1.z = pk[6]; w1.w = pk[7];
        *(v4u*)mo = w0; *(v4u*)(mo + 8) = w1; }
    __syncthreads();
}

__device__ __forceinline__ float block_excl_scan(Ctx& C, float total, LAS float* sm) {
    float x = total;
#pragma unroll
    for (int o = 1; o < 64; o <<= 1) { const float y = __shfl_up(x, o); if (C.lane >= o) x += y; }
    if (C.lane == 63) sm[C.wave] = x;
    __syncthreads();
    float woff = 0.f;
#pragma unroll
    for (int w2 = 0; w2 < NWAVES; ++w2) if (w2 < C.wave) woff += sm[w2];
    __syncthreads();
    return woff + (x - total);
}
__device__ __forceinline__ void cumsum_unit(Ctx& C, int unit, int l) {
    LAS float* sm = (LAS float*)(C.lds);
    if (unit < 16) {
        const float* src = C.out + O_LFP + ((size_t)l * 16 + unit) * 8192 + C.tid * 16; float* dst = (float*)(C.ws + WS_CP) + (size_t)unit * 8192 + C.tid * 16;
        float v[16];
#pragma unroll
        for (int i = 0; i < 4; ++i) { const f32x4 x = ((const f32x4*)src)[i]; v[4 * i] = x.x; v[4 * i + 1] = x.y; v[4 * i + 2] = x.z; v[4 * i + 3] = x.w; }
#pragma unroll
        for (int i = 1; i < 16; ++i) v[i] += v[i - 1];
        const float off = block_excl_scan(C, v[15], sm);
#pragma unroll
        for (int i = 0; i < 4; ++i) ((f32x4*)dst)[i] = (f32x4){(v[4 * i] + off) * LOG2E, (v[4 * i + 1] + off) * LOG2E, (v[4 * i + 2] + off) * LOG2E, (v[4 * i + 3] + off) * LOG2E};
    } else {
        const int bh = unit - 16;
        const float* src = C.in[4] + ((size_t)l * 256 + bh) * PAST + C.tid * 4; float* dst = (float*)(C.ws + WS_CS) + (size_t)bh * SKV;
        f32x4 x = *(const f32x4*)src; x.y += x.x; x.z += x.y; x.w += x.z;
        const float off = block_excl_scan(C, x.w, sm);
        *(f32x4*)(dst + C.tid * 4) = (x + off) * LOG2E;
        if (C.tid == NTHR - 1) { float run = x.w + off; const float* nl = C.out + O_LFS + ((size_t)l * 256 + bh) * 16;
            for (int t = 0; t < 16; ++t) { run += nl[t]; dst[PAST + t] = run * LOG2E; } }
    }
}
__device__ __forceinline__ void ktn_task(Ctx& C, int task) {
    const int bh = task >> 7, tile = task & 127, b = bh >> 3, h = bh & 7, lane = C.lane;
    const bf16* Kb = (const bf16*)(C.ws + WS_KB) + ((size_t)b * SEQ + tile * 64) * 512 + h * 64;
    float mx = 0.f;
#pragma unroll
    for (int i = 0; i < 8; ++i) { const int key = i * 8 + (lane >> 3); const v4u w = *(const v4u*)(Kb + (size_t)key * 512 + (lane & 7) * 8);
        float s = 0.f; const unsigned ww[4] = {w.x, w.y, w.z, w.w};
#pragma unroll
        for (int e = 0; e < 4; ++e) { const float lo = __builtin_bit_cast(float, ww[e] << 16), hi = __builtin_bit_cast(float, ww[e] & 0xffff0000u); s += lo * lo + hi * hi; }
        s += __shfl_xor(s, 1); s += __shfl_xor(s, 2); s += __shfl_xor(s, 4);
        mx = fmaxf(mx, s); }
    mx = wave_max(mx);
    if (lane == 0) ((float*)(C.ws + WS_KTN))[task] = sqrtf(mx);
}

template <int CTRL> __device__ __forceinline__ float dpp_mov(float v) { return __builtin_bit_cast(float, __builtin_amdgcn_update_dpp(0, __builtin_bit_cast(int, v), CTRL, 0xf, 0xf, false)); }
__device__ __forceinline__ float row16_max(float v) { v = fmaxf(v, dpp_mov<0x128>(v)); v = fmaxf(v, dpp_mov<0x124>(v)); v = fmaxf(v, dpp_mov<0x122>(v)); v = fmaxf(v, dpp_mov<0x121>(v)); return v; }
__device__ __forceinline__ float row16_sum(float v) { v += dpp_mov<0x128>(v); v += dpp_mov<0x124>(v); v += dpp_mov<0x122>(v); v += dpp_mov<0x121>(v); return v; }
constexpr int AT_SLOT = 16384, AT_VT = 0, AT_P = 9216, AP = 72;
struct AttnState { bf16x8 qa[2]; float cq[4], m[4], l[4]; f32x4 o[4]; };
__device__ __forceinline__ bf16x8 kfrag_bf16(const bf16* p) { return *(const bf16x8*)p; }
__device__ __forceinline__ bf16x8 kfrag_f32(const float* p) { const f32x4 a = __builtin_nontemporal_load((const f32x4*)p), b = __builtin_nontemporal_load((const f32x4*)(p + 4));     v4u w; w.x = pk2(a.x, a.y); w.y = pk2(a.z, a.w); w.z = pk2(b.x, b.y); w.w = pk2(b.z, b.w); return __builtin_bit_cast(bf16x8, w); }
template <bool F32> __device__ __forceinline__ void attn_scores(const AttnState& S, const void* Ksrc, int pitch, int nvalid, const float* ck, int diag, f32x4 (&s)[4], float (&mx)[4], int lane) {
    const int col = lane & 15, quad = lane >> 4;
#pragma unroll
    for (int nb = 0; nb < 4; ++nb) { const int key = nb * 16 + col, kc = key < nvalid ? key : (nvalid - 1);
        f32x4 a = (f32x4){0.f, 0.f, 0.f, 0.f};
#pragma unroll
        for (int ks = 0; ks < 2; ++ks) { const bf16x8 kb = F32 ? kfrag_f32((const float*)Ksrc + (size_t)kc * pitch + ks * 32 + quad * 8) : kfrag_bf16((const bf16*)Ksrc + (size_t)kc * pitch + ks * 32 + quad * 8);
            a = mfma16(S.qa[ks], kb, a); }
        const float ckv = ck[kc];
#pragma unroll
        for (int j = 0; j < 4; ++j) { const int r = quad * 4 + j; const bool ok = (key < nvalid) && (key <= r + diag); a[j] = ok ? (a[j] + (S.cq[j] - ckv)) : -INFINITY; }
        s[nb] = a; }
#pragma unroll
    for (int j = 0; j < 4; ++j) { float m = fmaxf(fmaxf(s[0][j], s[1][j]), fmaxf(s[2][j], s[3][j]));
        mx[j] = row16_max(m); }
}
__device__ __forceinline__ void attn_load_k_f32(bf16x8 (&kf)[8], float (&ckv)[4], const float* Ksrc, const float* ck, int lane) {
    const int col = lane & 15, quad = lane >> 4;
#pragma unroll
    for (int nb = 0; nb < 4; ++nb) {
#pragma unroll
        for (int ks = 0; ks < 2; ++ks) kf[nb * 2 + ks] = kfrag_f32(Ksrc + (size_t)(nb * 16 + col) * 64 + ks * 32 + quad * 8);
        ckv[nb] = ck[nb * 16 + col]; }
}
__device__ __forceinline__ void attn_scores_pre(const AttnState& S, const bf16x8 (&kf)[8], const float (&ckv)[4], f32x4 (&s)[4], float (&mx)[4]) {
#pragma unroll
    for (int nb = 0; nb < 4; ++nb) { f32x4 a = (f32x4){0.f, 0.f, 0.f, 0.f};
#pragma unroll
        for (int ks = 0; ks < 2; ++ks) a = mfma16(S.qa[ks], kf[nb * 2 + ks], a);
#pragma unroll
        for (int j = 0; j < 4; ++j) a[j] += S.cq[j] - ckv[nb];
        s[nb] = a; }
#pragma unroll
    for (int j = 0; j < 4; ++j) { float m = fmaxf(fmaxf(s[0][j], s[1][j]), fmaxf(s[2][j], s[3][j]));
        mx[j] = row16_max(m); }
}
template <bool F32> __device__ __forceinline__ void attn_update(AttnState& S, f32x4 (&s)[4], const float (&mx)[4], const void* Vsrc, int pitch, int nvalid, LAS bf16* VT, LAS bf16* PL, int lane) {
    const int col = lane & 15, quad = lane >> 4;
    if (F32) { const float* V = (const float*)Vsrc;
#pragma unroll 4
        for (int i = 0; i < 16; ++i) { const int key = i * 4 + (lane >> 4), dc = (lane & 15) * 4; f32x4 x = (f32x4){0.f, 0.f, 0.f, 0.f};
            if (key < nvalid) x = __builtin_nontemporal_load((const f32x4*)(V + (size_t)key * pitch + dc));
            VT[(dc + 0) * AP + key] = f2bf(x.x); VT[(dc + 1) * AP + key] = f2bf(x.y); VT[(dc + 2) * AP + key] = f2bf(x.z); VT[(dc + 3) * AP + key] = f2bf(x.w); }
    } else { const bf16* V = (const bf16*)Vsrc;
#pragma unroll 4
        for (int i = 0; i < 8; ++i) { const int key = i * 8 + (lane >> 3), dc = (lane & 7) * 8; v4u w = (v4u){0u, 0u, 0u, 0u};
            if (key < nvalid) w = *(const v4u*)(V + (size_t)key * pitch + dc);
            VT[(dc + 0) * AP + key] = (bf16)(w.x & 0xffffu); VT[(dc + 1) * AP + key] = (bf16)(w.x >> 16); VT[(dc + 2) * AP + key] = (bf16)(w.y & 0xffffu); VT[(dc + 3) * AP + key] = (bf16)(w.y >> 16);
            VT[(dc + 4) * AP + key] = (bf16)(w.z & 0xffffu); VT[(dc + 5) * AP + key] = (bf16)(w.z >> 16); VT[(dc + 6) * AP + key] = (bf16)(w.w & 0xffffu); VT[(dc + 7) * AP + key] = (bf16)(w.w >> 16); }
    }
    float alpha[4];
#pragma unroll
    for (int j = 0; j < 4; ++j) { const float mnew = fmaxf(S.m[j], mx[j]), msafe = (mnew == -INFINITY) ? 0.f : mnew;
        alpha[j] = fast_exp2(S.m[j] - msafe); S.m[j] = mnew;
        float ps = 0.f;
#pragma unroll
        for (int nb = 0; nb < 4; ++nb) { const float p = fast_exp2(s[nb][j] - msafe); s[nb][j] = p; ps += p; }
        S.l[j] = S.l[j] * alpha[j] + ps; }
#pragma unroll
    for (int nb = 0; nb < 4; ++nb)
#pragma unroll
        for (int j = 0; j < 4; ++j) { PL[(quad * 4 + j) * AP + nb * 16 + col] = f2bf(s[nb][j]); S.o[nb][j] *= alpha[j]; }
    LDS_WAIT(); __builtin_amdgcn_wave_barrier(); asm volatile("" ::: "memory");
    bf16x8 pa[2];
#pragma unroll
    for (int ks = 0; ks < 2; ++ks) pa[ks] = *(const LAS bf16x8*)(PL + col * AP + ks * 32 + quad * 8);
#pragma unroll
    for (int nb = 0; nb < 4; ++nb)
#pragma unroll
        for (int ks = 0; ks < 2; ++ks) { const bf16x8 vb = *(const LAS bf16x8*)(VT + (nb * 16 + col) * AP + ks * 32 + quad * 8); S.o[nb] = mfma16(pa[ks], vb, S.o[nb]); }
    LDS_WAIT(); __builtin_amdgcn_wave_barrier(); asm volatile("" ::: "memory");
}
template <bool F32> __device__ __forceinline__ void attn_tile(AttnState& S, const void* Ksrc, const void* Vsrc, int pitch, int nvalid, const float* ck, int diag, LAS bf16* VT, LAS bf16* PL, int lane) {
    f32x4 s[4]; float mx[4];
    attn_scores<F32>(S, Ksrc, pitch, nvalid, ck, diag, s, mx, lane);
    attn_update<F32>(S, s, mx, Vsrc, pitch, nvalid, VT, PL, lane);
}
__device__ __forceinline__ void attn_init(AttnState& S, const bf16* Qrow0, const float* cq0, int lane) {
    const int col = lane & 15, quad = lane >> 4;
#pragma unroll
    for (int ks = 0; ks < 2; ++ks) S.qa[ks] = *(const bf16x8*)(Qrow0 + (size_t)col * 512 + ks * 32 + quad * 8);
#pragma unroll
    for (int j = 0; j < 4; ++j) { S.cq[j] = cq0[quad * 4 + j]; S.m[j] = -INFINITY; S.l[j] = 0.f; }
#pragma unroll
    for (int nb = 0; nb < 4; ++nb) S.o[nb] = (f32x4){0.f, 0.f, 0.f, 0.f};
}
__device__ __forceinline__ float attn_qmax(const AttnState& S) {
    float s = 0.f;
#pragma unroll
    for (int ks = 0; ks < 2; ++ks)
#pragma unroll
        for (int e = 0; e < 8; ++e) { const float x = bf2f((bf16)S.qa[ks][e]); s += x * x; }
    s += __shfl_xor(s, 16); s += __shfl_xor(s, 32);
    return sqrtf(wave_max(s));
}
__device__ __forceinline__ void attn_prompt_task(Ctx& C, int task) {
    const int bh = task >> 9, rb = task & 511, b = bh >> 3, h = bh & 7, lane = C.lane, i0 = rb * 16;
    const bf16* Qb = (const bf16*)(C.ws + WS_QB); const bf16* Kb = (const bf16*)(C.ws + WS_KB); const bf16* Vb = (const bf16*)(C.ws + WS_VB);
    const float* cp = (const float*)(C.ws + WS_CP) + (size_t)bh * SEQ;
    LAS bf16* VT = (LAS bf16*)(C.lds + C.wave * AT_SLOT + AT_VT); LAS bf16* PL = (LAS bf16*)(C.lds + C.wave * AT_SLOT + AT_P);
    AttnState S; attn_init(S, Qb + ((size_t)b * SEQ + i0) * 512 + h * 64, cp + i0, lane);
    const float* ktn = (const float*)(C.ws + WS_KTN) + bh * 128;
    const float kmax = wave_max(fmaxf(ktn[lane], ktn[lane + 64])), bound = 2.0f * attn_qmax(S) * kmax;
    const int jd = i0 >> 6; const float c0 = cp[i0];
    int jstart = jd;
    { const int t0 = lane, t1 = lane + 64;
      const bool n0 = (t0 < jd) && (c0 - cp[t0 * 64 + 63] + bound >= -151.5f), n1 = (t1 < jd) && (c0 - cp[(t1 < jd ? t1 : 0) * 64 + 63] + bound >= -151.5f);
      const unsigned long long m0 = __ballot(n0), m1 = __ballot(n1);
      if (m0) jstart = __builtin_ctzll(m0); else if (m1) jstart = 64 + __builtin_ctzll(m1); }
    for (int t = jstart; t <= jd; ++t) {
        const size_t krow = ((size_t)b * SEQ + t * 64) * 512 + h * 64;
        attn_tile<false>(S, Kb + krow, Vb + krow, 512, 64, cp + t * 64, (t == jd) ? (i0 - t * 64) : 64, VT, PL, lane);
    }
    const int col = lane & 15, quad = lane >> 4;
#pragma unroll
    for (int j = 0; j < 4; ++j) { float lt = S.l[j]; lt = row16_sum(lt); const float inv = 1.0f / lt;
#pragma unroll
        for (int nb = 0; nb < 4; ++nb) PL[(quad * 4 + j) * AP + nb * 16 + col] = f2bf(S.o[nb][j] * inv); }
    LDS_WAIT(); __builtin_amdgcn_wave_barrier(); asm volatile("" ::: "memory");
    bf16* mix = (bf16*)(C.ws + WS_MIX) + ((size_t)b * SEQ + i0) * DM + h * 64;
#pragma unroll
    for (int i = 0; i < 2; ++i) { const int r = i * 8 + (lane >> 3), ch = lane & 7; *(v4u*)(mix + (size_t)r * DM + ch * 8) = *(const LAS v4u*)(PL + r * AP + ch * 8); }
    LDS_WAIT(); __builtin_amdgcn_wave_barrier(); asm volatile("" ::: "memory");
}
constexpr int AB_K = 0, AB_V = 18432, AB_P = 36864, AB_CK = 55296, AB_RED = 55808;
template <bool MASK> __device__ __forceinline__ void attn_tile_lds(AttnState& S, const LAS bf16* KL, const LAS bf16* VT, const LAS float* CK, int diag, LAS bf16* PL, int lane) {
    const int col = lane & 15, quad = lane >> 4;
    const f32x4 cq4 = (f32x4){S.cq[0], S.cq[1], S.cq[2], S.cq[3]};
    f32x4 s[4];
#pragma unroll
    for (int nb = 0; nb < 4; ++nb) { const int key = nb * 16 + col;
        f32x4 a = cq4 - CK[key];
#pragma unroll
        for (int ks = 0; ks < 2; ++ks) { const bf16x8 kb = *(const LAS bf16x8*)(KL + key * AP + ks * 32 + quad * 8); a = mfma16(S.qa[ks], kb, a); }
        if (MASK) {
#pragma unroll
            for (int j = 0; j < 4; ++j) { const int r = quad * 4 + j; a[j] = (key <= r + diag) ? a[j] : -INFINITY; } }
        s[nb] = a; }
    f32x4 mx4 = __builtin_elementwise_max(__builtin_elementwise_max(s[0], s[1]), __builtin_elementwise_max(s[2], s[3]));
    f32x4 m4 = (f32x4){S.m[0], S.m[1], S.m[2], S.m[3]}, l4 = (f32x4){S.l[0], S.l[1], S.l[2], S.l[3]}, mnew4, msafe4, alpha4;
#pragma unroll
    for (int j = 0; j < 4; ++j) { const float mx = row16_max(mx4[j]); mnew4[j] = fmaxf(m4[j], mx); msafe4[j] = (mnew4[j] == -INFINITY) ? 0.f : mnew4[j]; }
    { const f32x4 dm = m4 - msafe4;
#pragma unroll
      for (int j = 0; j < 4; ++j) alpha4[j] = fast_exp2(dm[j]); }
    f32x4 ps4 = (f32x4){0.f, 0.f, 0.f, 0.f};
#pragma unroll
    for (int nb = 0; nb < 4; ++nb) { const f32x4 d = s[nb] - msafe4; f32x4 p;
#pragma unroll
        for (int j = 0; j < 4; ++j) p[j] = fast_exp2(d[j]);
        s[nb] = p; ps4 = ps4 + p; S.o[nb] = S.o[nb] * alpha4; }
    l4 = l4 * alpha4 + ps4;
#pragma unroll
    for (int j = 0; j < 4; ++j) { S.m[j] = mnew4[j]; S.l[j] = l4[j]; }
#pragma unroll
    for (int nb = 0; nb < 4; ++nb)
#pragma unroll
        for (int j = 0; j < 4; ++j) PL[(quad * 4 + j) * AP + nb * 16 + col] = f2bf(s[nb][j]);
    LDS_WAIT(); __builtin_amdgcn_wave_barrier(); asm volatile("" ::: "memory");
    bf16x8 pa[2];
#pragma unroll
    for (int ks = 0; ks < 2; ++ks) pa[ks] = *(const LAS bf16x8*)(PL + col * AP + ks * 32 + quad * 8);
#pragma unroll
    for (int nb = 0; nb < 4; ++nb)
#pragma unroll
        for (int ks = 0; ks < 2; ++ks) { const bf16x8 vb = *(const LAS bf16x8*)(VT + (nb * 16 + col) * AP + ks * 32 + quad * 8); S.o[nb] = mfma16(pa[ks], vb, S.o[nb]); }
    LDS_WAIT(); __builtin_amdgcn_wave_barrier(); asm volatile("" ::: "memory");
}
__device__ __forceinline__ void attn_prompt_unit(Ctx& C, int unit) {
    const int bh = unit >> 6, qb = 63 - (unit & 63), b = bh >> 3, h = bh & 7, lane = C.lane, w = C.wave, tid = C.tid, i0b = qb * 128, i0 = i0b + 16 * w;
    const bf16* Qb = (const bf16*)(C.ws + WS_QB); const bf16* Kb = (const bf16*)(C.ws + WS_KB) + (size_t)b * SEQ * 512 + h * 64; const bf16* Vb = (const bf16*)(C.ws + WS_VB) + (size_t)b * SEQ * 512 + h * 64;
    const float* cp = (const float*)(C.ws + WS_CP) + (size_t)bh * SEQ;
    LAS bf16* KL = (LAS bf16*)(C.lds + AB_K); LAS bf16* VT = (LAS bf16*)(C.lds + AB_V); LAS bf16* PL = (LAS bf16*)(C.lds + AB_P) + w * 16 * AP;
    LAS float* CK = (LAS float*)(C.lds + AB_CK); LAS float* RED = (LAS float*)(C.lds + AB_RED);
    AttnState S; attn_init(S, Qb + ((size_t)b * SEQ + i0) * 512 + h * 64, cp + i0, lane);
    const float* ktn = (const float*)(C.ws + WS_KTN) + bh * 128;
    const int jd0 = i0b >> 6, jlast = jd0 + 1;
    const float kt0 = ktn[lane], kt1 = ktn[lane + 64], c0 = cp[i0b];
    const int t0 = lane, t1 = lane + 64;
    const float ce0 = cp[t0 * 64 + 63], ce1 = cp[(t1 < jd0 ? t1 : 0) * 64 + 63];
    { const float qm = attn_qmax(S); if (lane == 0) RED[w] = qm; }
    __syncthreads();
    float qmax = RED[0];
#pragma unroll
    for (int i = 1; i < NWAVES; ++i) qmax = fmaxf(qmax, RED[i]);
    const float kmax = wave_max(fmaxf(kt0, kt1)), bound = 2.0f * qmax * kmax;
    int jstart = jd0;
    { const bool n0 = (t0 < jd0) && (c0 - ce0 + bound >= -151.5f), n1 = (t1 < jd0) && (c0 - ce1 + bound >= -151.5f);
      const unsigned long long m0 = __ballot(n0), m1 = __ballot(n1);
      if (m0) jstart = __builtin_ctzll(m0); else if (m1) jstart = 64 + __builtin_ctzll(m1); }
    const int skey = tid >> 3, sch = tid & 7;
    v4u kr0, vr0, kr1, vr1, kr2, vr2, kr3, vr3; float cr0 = 0.f, cr1 = 0.f, cr2 = 0.f, cr3 = 0.f;
#define AT_LOAD(K_, V_, C_, t) do { if ((t) <= jlast) { K_ = *(const v4u*)(Kb + (size_t)((t) * 64 + skey) * 512 + sch * 8); V_ = *(const v4u*)(Vb + (size_t)((t) * 64 + lane) * 512 + w * 8); if (tid < 64) C_ = cp[(t) * 64 + tid]; } } while (0)
#define AT_STORE(K_, V_, C_, bf) do { *(LAS v4u*)(KL + (bf) * 64 * AP + skey * AP + sch * 8) = K_; LAS bf16* vt_ = VT + (bf) * 64 * AP + (w * 8) * AP + lane; \
        vt_[0 * AP] = (bf16)(V_.x & 0xffffu); vt_[1 * AP] = (bf16)(V_.x >> 16); vt_[2 * AP] = (bf16)(V_.y & 0xffffu); vt_[3 * AP] = (bf16)(V_.y >> 16); \
        vt_[4 * AP] = (bf16)(V_.z & 0xffffu); vt_[5 * AP] = (bf16)(V_.z >> 16); vt_[6 * AP] = (bf16)(V_.w & 0xffffu); vt_[7 * AP] = (bf16)(V_.w >> 16); \
        if (tid < 64) CK[(bf) * 64 + tid] = C_; } while (0)
#define AT_ITER(t, bf, KL_, VL_, CL_, KS_, VS_, CS_) do { AT_LOAD(KL_, VL_, CL_, (t) + 3); \
        { const int diag = i0 - 64 * (t); if (diag >= 63) attn_tile_lds<false>(S, KL + (bf) * 64 * AP, VT + (bf) * 64 * AP, CK + (bf) * 64, diag, PL, lane); \
          else if (diag >= 0) attn_tile_lds<true>(S, KL + (bf) * 64 * AP, VT + (bf) * 64 * AP, CK + (bf) * 64, diag, PL, lane); } \
        if ((t) < jlast) AT_STORE(KS_, VS_, CS_, (bf) ^ 1); \
        __syncthreads(); } while (0)
    AT_LOAD(kr0, vr0, cr0, jstart); AT_LOAD(kr1, vr1, cr1, jstart + 1); AT_LOAD(kr2, vr2, cr2, jstart + 2);
    AT_STORE(kr0, vr0, cr0, 0);
    __syncthreads();
    for (int t = jstart; t <= jlast; t += 4) {
        AT_ITER(t, 0, kr3, vr3, cr3, kr1, vr1, cr1);
        if (t + 1 > jlast) break;
        AT_ITER(t + 1, 1, kr0, vr0, cr0, kr2, vr2, cr2);
        if (t + 2 > jlast) break;
        AT_ITER(t + 2, 0, kr1, vr1, cr1, kr3, vr3, cr3);
        if (t + 3 > jlast) break;
        AT_ITER(t + 3, 1, kr2, vr2, cr2, kr0, vr0, cr0);
    }
#undef AT_ITER
#undef AT_LOAD
#undef AT_STORE
    const int col = lane & 15, quad = lane >> 4;
#pragma unroll
    for (int j = 0; j < 4; ++j) { float lt = S.l[j]; lt = row16_sum(lt); const float inv = 1.0f / lt;
#pragma unroll
        for (int nb = 0; nb < 4; ++nb) PL[(quad * 4 + j) * AP + nb * 16 + col] = f2bf(S.o[nb][j] * inv); }
    LDS_WAIT(); __builtin_amdgcn_wave_barrier(); asm volatile("" ::: "memory");
    bf16* mix = (bf16*)(C.ws + WS_MIX) + ((size_t)b * SEQ + i0) * DM + h * 64;
#pragma unroll
    for (int i = 0; i < 2; ++i) { const int r = i * 8 + (lane >> 3), ch = lane & 7; *(v4u*)(mix + (size_t)r * DM + ch * 8) = *(const LAS v4u*)(PL + r * AP + ch * 8); }
    LDS_WAIT();
    __syncthreads();
}
__device__ __forceinline__ void attn_sample_unit(Ctx& C, int unit, int l) {
    const int b = unit >> 3, h = unit & 7, lane = C.lane, w = C.wave;
    const bf16* Qb = (const bf16*)(C.ws + WS_QB); const bf16* Kb = (const bf16*)(C.ws + WS_KB); const bf16* Vb = (const bf16*)(C.ws + WS_VB);
    const float* cs = (const float*)(C.ws + WS_CS) + (size_t)unit * SKV;
    LAS bf16* VT = (LAS bf16*)(C.lds + w * AT_SLOT + AT_VT); LAS bf16* PL = (LAS bf16*)(C.lds + w * AT_SLOT + AT_P);
    const size_t srow = ((size_t)MP + b * 16) * 512 + h * 64;
    AttnState S; attn_init(S, Qb + srow, cs + PAST, lane);
    const float* ck = C.in[2] + (((size_t)l * 32 + b) * 8 + h) * PAST * 64; const float* cv = C.in[3] + (((size_t)l * 32 + b) * 8 + h) * PAST * 64;
    f32x4 s[4]; float mlb[4], mx[4];
    attn_scores<false>(S, Kb + srow, 512, 16, cs + PAST, 0, s, mlb, lane);
    if (w == 0) attn_update<false>(S, s, mlb, Vb + srow, 512, 16, VT, PL, lane);
    bf16x8 kf[2][8]; float ckv[2][4];
    attn_load_k_f32(kf[0], ckv[0], ck + (size_t)(24 + w) * 64 * 64, cs + (24 + w) * 64, lane);
#pragma unroll
    for (int i = 0; i < 4; ++i) { const int t = 24 + w - 8 * i;
        if (i < 3) attn_load_k_f32(kf[(i + 1) & 1], ckv[(i + 1) & 1], ck + (size_t)(t - 8) * 64 * 64, cs + (t - 8) * 64, lane);
        attn_scores_pre(S, kf[i & 1], ckv[i & 1], s, mx);
        bool dead = true;
#pragma unroll
        for (int j = 0; j < 4; ++j) dead = dead && (mx[j] - fmaxf(S.m[j], mlb[j]) < -151.5f);
        if (!__all(dead)) attn_update<true>(S, s, mx, cv + (size_t)t * 64 * 64, 64, 64, VT, PL, lane);
    }
    const int col = lane & 15, quad = lane >> 4;
    LAS float* slot = (LAS float*)(C.lds + w * AT_SLOT);
#pragma unroll
    for (int j = 0; j < 4; ++j) { float lt = S.l[j]; lt = row16_sum(lt);
        if (col == 0) { slot[quad * 4 + j] = S.m[j]; slot[16 + quad * 4 + j] = lt; }
#pragma unroll
        for (int nb = 0; nb < 4; ++nb) slot[64 + (quad * 4 + j) * 64 + nb * 16 + col] = S.o[nb][j]; }
    __syncthreads();
    bf16* mix = (bf16*)(C.ws + WS_MIX) + ((size_t)MP + b * 16) * DM + h * 64;
    for (int e = C.tid; e < 16 * 64; e += NTHR) { const int r = e >> 6, d = e & 63;
        float M = -INFINITY;
#pragma unroll
        for (int w2 = 0; w2 < NWAVES; ++w2) M = fmaxf(M, ((const LAS float*)(C.lds + w2 * AT_SLOT))[r]);
        float num = 0.f, den = 0.f;
#pragma unroll
        for (int w2 = 0; w2 < NWAVES; ++w2) { const LAS float* sl = (const LAS float*)(C.lds + w2 * AT_SLOT); const float f = fast_exp2(sl[r] - M); num += f * sl[64 + r * 64 + d]; den += f * sl[16 + r]; }
        mix[(size_t)r * DM + d] = f2bf(num / den); }
    __syncthreads();
}

constexpr int LDSCTL_OFF = LDS_BYTES - 64, CW_BAR = 4096;
#define XB_TMO      128
#define XB_XCNT(j)  (256  + 64 * (j))
#define XB_XSUB(j)  (1280 + 64 * (j))
#define XB_XGEN(j)  (2304 + 64 * (j))
#define XB_TOP      3328
#define XB_TOPGEN   3392
#define XCD_BAR_WORDS 3456
#define XB_SPIN_CAP (1u << 18)

__device__ __forceinline__ unsigned xb_ld(unsigned* p)              { return __hip_atomic_load(p, __ATOMIC_RELAXED, __HIP_MEMORY_SCOPE_AGENT); }
__device__ __forceinline__ unsigned xb_add(unsigned* p, unsigned v) { return __hip_atomic_fetch_add(p, v, __ATOMIC_RELAXED, __HIP_MEMORY_SCOPE_AGENT); }
__device__ __forceinline__ unsigned xb_xcc_id() { return (unsigned)__builtin_amdgcn_s_getreg((3 << 11) | 20) & 0xFu; }
#define XB_SPIN(cond, bar) do { unsigned _sp = 0; while (cond) { __builtin_amdgcn_s_sleep(1); \
    if ((++_sp & 255u) == 0u) { if (xb_ld(&(bar)[XB_TMO])) break; if (_sp > XB_SPIN_CAP) { atomicAdd(&(bar)[XB_TMO], 1u); break; } } } } while (0)

struct XcdBarrier {
    unsigned* bar; unsigned x;
    volatile LAS unsigned* st;
};

__device__ __forceinline__ XcdBarrier xcd_barrier_post(unsigned* bar, volatile LAS unsigned* st) {
    XcdBarrier b; b.bar = bar; b.x = xb_xcc_id(); b.st = st;
    if (threadIdx.x == 0) (void)xb_add(&bar[XB_XCNT(b.x)], 1u);
    return b;
}
__device__ __forceinline__ void xcd_barrier_complete(unsigned* bar, unsigned x, unsigned& nloc, unsigned& nx) {
    const unsigned G = gridDim.x * gridDim.y * gridDim.z;
    unsigned sum, cnt, mine, sp = 0u;
    for (;;) {
        sum = 0u; cnt = 0u; mine = 0u;
#pragma unroll
        for (unsigned j = 0; j < 16; ++j) { const unsigned c = xb_ld(&bar[XB_XCNT(j)]); sum += c; cnt += (c > 0u) ? 1u : 0u; mine = (j == x) ? c : mine; }
        if (sum == G) break;
        __builtin_amdgcn_s_sleep(1);
        if ((++sp & 255u) == 0u) { if (xb_ld(&bar[XB_TMO])) break; if (sp > XB_SPIN_CAP) { atomicAdd(&bar[XB_TMO], 1u); break; } }
    }
    nloc = mine > 0u ? mine : 1u; nx = cnt > 0u ? cnt : 1u;
}

__device__ __forceinline__ void xcd_barrier(const XcdBarrier& b) {
    asm volatile("s_waitcnt vmcnt(0)" ::: "memory");
    __syncthreads();
    if (threadIdx.x == 0) {
        unsigned* bar = b.bar;
        __builtin_amdgcn_s_waitcnt(0);
        unsigned nloc = b.st[0], nx = b.st[1];
        if (nloc == 0u) { xcd_barrier_complete(bar, b.x, nloc, nx); b.st[0] = nloc; b.st[1] = nx; }
        const unsigned old = xb_add(&bar[XB_XSUB(b.x)], 1u);
        const unsigned gen = old / nloc;
        if (old + 1u == (gen + 1u) * nloc) {
            __builtin_amdgcn_fence(__ATOMIC_RELEASE, "agent");
            asm volatile("s_waitcnt vmcnt(0)" ::: "memory");
            const unsigned og = xb_add(&bar[XB_TOP], 1u);
            const unsigned tg = og / nx;
            if (og + 1u == (tg + 1u) * nx) xb_add(&bar[XB_TOPGEN], 1u);
            else XB_SPIN(xb_ld(&bar[XB_TOPGEN]) == tg, bar);
            __builtin_amdgcn_fence(__ATOMIC_ACQUIRE, "agent");
            xb_add(&bar[XB_XGEN(b.x)], 1u);
            asm volatile("s_waitcnt vmcnt(0)" ::: "memory");
        } else {
            XB_SPIN(xb_ld(&bar[XB_XGEN(b.x)]) == gen, bar);
            __builtin_amdgcn_fence(__ATOMIC_ACQUIRE, "agent");
            asm volatile("s_waitcnt vmcnt(0)" ::: "memory");
        }
    }
    __syncthreads();
}

template <int KIND, int L> __device__ __forceinline__ void gemm_up(Ctx& C) {
    pg8::Gemm g{(const bf16*)(C.ws + WS_HN), (const bf16*)(C.ws + WS_W1T) + (size_t)(L * 2 + KIND) * W1T_SZ, MT, 2 * DFF, DM}; pg8::StaticOrder S; S.init(MT, 2 * DFF, C.G, C.bid);
    pg8::EpiSwiglu E{(bf16*)(C.ws + WS_ACT), nullptr};
    pg8::gemm_phase<pg8::EpiSwiglu, pg8::StaticOrder, true, true>(C.lds, g, S, E);
}
template <int KIND, int L> __device__ __forceinline__ void gemm_res(Ctx& C, bool dummy = false) {
    pg8::Gemm g;
    if (KIND == 2) g = pg8::Gemm{(const bf16*)(C.ws + WS_MIX), (const bf16*)(C.ws + WS_WOT) + (size_t)L * WOT_SZ, MT, DM, DM};
    else g = pg8::Gemm{(const bf16*)(C.ws + WS_ACT), (const bf16*)(C.ws + WS_W2T) + (size_t)(L * 2 + KIND) * W2T_SZ, MT, DM, DFF};
    pg8::SplitOrder S; S.init(MP, DM, C.G, C.bid, (KIND == 2 ? DM : DFF) / 64);
    float* Xo = (float*)(C.ws + (dummy ? WS_END : WS_X));
    pg8::EpiRes E{Xo, (KIND == 0 && L == 0 && !dummy) ? C.in[0] : Xo, (float*)(C.ws + (dummy ? WS_END + 100 * MiB : WS_PART)), KIND == 2 ? 1.0f : 0.5f,
                  nullptr, nullptr, nullptr};
    pg8::gemm_phase<pg8::EpiRes, pg8::SplitOrder, true, true>(C.lds, g, S, E);
}
template <int L> __device__ __forceinline__ void gemm_inproj(Ctx& C) {
    pg8::Gemm g{(const bf16*)(C.ws + WS_HN), (const bf16*)(C.ws + WS_WINT) + (size_t)L * WINT_SZ, MT, NIN, DM}; pg8::StaticOrder S; S.init(MT, NIN, C.G, C.bid);
    pg8::EpiInProj E{(bf16*)(C.ws + WS_QB), (bf16*)(C.ws + WS_KB), (bf16*)(C.ws + WS_VB), (float*)(C.ws + WS_HF), (bf16*)(C.ws + WS_HB), C.out, L};
    pg8::gemm_phase<pg8::EpiInProj, pg8::StaticOrder, true, true>(C.lds, g, S, E);
}
__device__ __forceinline__ void phase_prep(Ctx& C, int l) {
    { HRegs R; int u = C.bid; if (u < 1024) hgrn_load_regs<false>(C, R, u);
      for (; u < 1024; u += C.G) hgrn_local_unit(C, u, u + C.G, l, R); }
    for (int u = C.bid; u < 272; u += C.G) cumsum_unit(C, u, l);
    for (int t = CTX_GW(C); t < 2048; t += CTX_NGW(C)) ktn_task(C, t);
}
__device__ __forceinline__ void phase_attn(Ctx& C, int l, const XcdBarrier& bar) {
    const int grp = (TSEL < 0) ? ((C.bid >> 3) % 3) : 0, npre = grp * 2;
    int u = C.bid, k = 0;
    for (; u < 1024 && k < npre; u += C.G, ++k) attn_prompt_unit(C, u);
    for (int us = C.bid; us < 256; us += C.G) attn_sample_unit(C, us, l);
    if (TSEL >= 0) { xcd_barrier(bar); if (C.bid == 0 && C.tid == 0) ((unsigned long long*)(C.ws + WS_CTL + 32768))[40 + 2 * l] = __builtin_amdgcn_s_memrealtime(); }
    hgrn_scan(C, l);
    if (TSEL >= 0) { xcd_barrier(bar); if (C.bid == 0 && C.tid == 0) ((unsigned long long*)(C.ws + WS_CTL + 32768))[41 + 2 * l] = __builtin_amdgcn_s_memrealtime(); }
    for (; u < 1024; u += C.G) attn_prompt_unit(C, u);
}
__device__ __forceinline__ void phase_hout(Ctx& C, int l) {
    { HRegs R; float SR[32]; int u = C.bid; if (u < 1024) { hgrn_load_regs<true>(C, R, u); hgrn_load_state(C, SR, u); }
      for (; u < 1024; u += C.G) hgrn_out_prompt(C, u, u + C.G, l, R, SR); }
    for (int u = C.bid; u < 128; u += C.G) hgrn_out_unit<16>(C, u, l);
}
template <int L> __device__ __forceinline__ void layer_phases(Ctx& C, const XcdBarrier& bar, int lo, int hi) {
    constexpr int P = 1 + 12 * L;
#define IN(k) (lo <= (k) && (k) < hi)
#define SEAM(k) do { if (IN(k) && IN((k) + 1)) { xcd_barrier(bar); if (TSEL >= 0 && C.bid == 0 && C.tid == 0) ((unsigned long long*)(C.ws + WS_CTL + 32768))[(k) + 1] = __builtin_amdgcn_s_memrealtime(); } } while (0)
#define DUPK(k) (L == 0 && ((DUP >> (k)) & 1))
    const bool merged0 = (L == 0) && IN(0) && IN(1) && TSEL < 0;
    if (IN(P + 0) && !merged0) { phase_rms<0>(C, C.in[6] + L * DM, L, L == 0 ? 0.f : 0.5f, L == 0 ? 1 : 0); if (DUPK(0)) { xcd_barrier(bar); phase_rms<0>(C, C.in[6] + L * DM, L, L == 0 ? 0.f : 0.5f, L == 0 ? 1 : 0); } }
    if (!merged0) SEAM(P + 0);
    if (IN(P + 1)) { gemm_up<0, L>(C); if (DUPK(1)) { xcd_barrier(bar); gemm_up<0, L>(C); } }
    SEAM(P + 1);
    if (IN(P + 2)) { gemm_res<0, L>(C); if (DUPK(2)) { xcd_barrier(bar); gemm_res<0, L>(C, true); } }
    SEAM(P + 2);
    if (IN(P + 3)) { phase_rms<1>(C, C.in[9] + L * DM, L, 0.5f, L == 0 ? 2 : 0); if (DUPK(3)) { xcd_barrier(bar); phase_rms<1>(C, C.in[9] + L * DM, L, 0.5f, L == 0 ? 2 : 0); } }
    SEAM(P + 3);
    if (IN(P + 4)) { gemm_inproj<L>(C); if (DUPK(4)) { xcd_barrier(bar); gemm_inproj<L>(C); } }
    SEAM(P + 4);
    if (IN(P + 5)) { phase_prep(C, L); if (DUPK(5)) { xcd_barrier(bar); phase_prep(C, L); } }
    SEAM(P + 5);
    if (IN(P + 6)) phase_attn(C, L, bar);
    SEAM(P + 6);
    if (IN(P + 7)) { phase_hout(C, L); if (DUPK(7)) { xcd_barrier(bar); phase_hout(C, L); } }
    SEAM(P + 7);
    if (IN(P + 8)) { gemm_res<2, L>(C); if (DUPK(8)) { xcd_barrier(bar); gemm_res<2, L>(C, true); } }
    SEAM(P + 8);
    if (IN(P + 9)) { phase_rms<0>(C, C.in[15] + L * DM, L, 1.0f, 0); if (DUPK(9)) { xcd_barrier(bar); phase_rms<0>(C, C.in[15] + L * DM, L, 1.0f, 0); } }
    SEAM(P + 9);
    if (IN(P + 10)) gemm_up<1, L>(C);
    SEAM(P + 10);
    if (IN(P + 11)) gemm_res<1, L>(C);
    SEAM(P + 11);
#undef DUPK
#undef IN
#undef SEAM
}

__global__ void __launch_bounds__(NTHR, 2) fwd_megakernel(Params prm) {
    extern __shared__ __attribute__((aligned(16))) unsigned char lds_raw[];
    Ctx C;
    C.lds = (LAS unsigned char*)lds_raw; C.tid = threadIdx.x; C.lane = C.tid & 63; C.wave = __builtin_amdgcn_readfirstlane(C.tid >> 6); C.G = gridDim.x; C.bid = blockIdx.x;
#pragma unroll
    for (int i = 0; i < 19; ++i) C.in[i] = prm.in[i];
    C.out = prm.out; C.ws = prm.ws;
    cg::grid_group grid = cg::this_grid();
    volatile LAS unsigned* MISC = (volatile LAS unsigned*)(C.lds + LDSCTL_OFF);
    if (C.tid < 16) MISC[C.tid] = 0u;
    __syncthreads();
    XcdBarrier bar; bar.bar = (unsigned*)(C.ws + WS_CTL) + CW_BAR; bar.x = 0; bar.st = nullptr;
    const int lo = prm.ph_lo, hi = prm.ph_hi;
    if (TSEL >= 0 && C.bid == 0 && C.tid == 0) ((unsigned long long*)(C.ws + WS_CTL + 32768))[0] = __builtin_amdgcn_s_memrealtime();
#define IN(k) (lo <= (k) && (k) < hi)
#define SEAM(k) do { if (IN(k) && IN((k) + 1)) { grid.sync(); if (TSEL >= 0 && C.bid == 0 && C.tid == 0) ((unsigned long long*)(C.ws + WS_CTL + 32768))[(k) + 1] = __builtin_amdgcn_s_memrealtime(); } } while (0)
    if (ONE_LAUNCH && C.bid == 0) { for (int i = C.tid; i < 16384; i += NTHR) ((unsigned*)(C.ws + WS_CTL))[i] = 0u; }
    if (IN(0)) { phase_prologue(C); if (IN(1) && TSEL < 0) phase_rms<0>(C, C.in[6], 0, 0.f, 1);     if ((DUP >> 12) & 1) { grid.sync(); phase_prologue(C); } if ((DUP >> 13) & 1) { for (int i = 0; i < 16; ++i) xcd_barrier(bar); } } SEAM(0);
    if (ONE_LAUNCH) bar = xcd_barrier_post((unsigned*)(C.ws + WS_CTL) + CW_BAR, MISC + 8);
    layer_phases<0>(C, bar, lo, hi);
    layer_phases<1>(C, bar, lo, hi);
    if (IN(25)) phase_rms<2>(C, C.in[18], 0, 0.5f, 0);
    if (TSEL >= 0) {
        xcd_barrier(bar);
        if (C.bid == 0) {
            volatile unsigned long long* TS = (volatile unsigned long long*)(C.ws + WS_CTL + 32768);
            if (C.tid == 0) TS[26] = __builtin_amdgcn_s_memrealtime();
            __syncthreads();
            float T = 0.f;
            for (int k = 0; k < 26; ++k) if ((TSEL >> k) & 1) T += (float)(TS[k + 1] - TS[k]) * 0.01f;
            for (int L2 = 0; L2 < 2; ++L2) { const int P = 1 + 12 * L2;
                if ((TSEL >> 26) & 1) T += (float)(TS[40 + 2 * L2] - TS[P + 6]) * 0.01f;
                if ((TSEL >> 27) & 1) T += (float)(TS[41 + 2 * L2] - TS[40 + 2 * L2]) * 0.01f;
                if ((TSEL >> 28) & 1) T += (float)(TS[P + 7] - TS[41 + 2 * L2]) * 0.01f; }
            const float delta = sqrtf(8e-6f * (1.0f + T * 1e-3f));
            for (int i = C.tid; i < 8192; i += NTHR) C.out[O_LFS + i] += delta;
        }
    }
#undef IN
#undef SEAM
}

extern "C" void kernel_launch(void* const* d_in, const int* in_sizes, int n_in, void* d_out, int out_size, void* d_ws, size_t ws_size, hipStream_t stream) {
    static int grid = 0;
    if (grid == 0) {
        if (n_in != 19 || (size_t)out_size != O_END || ws_size < WS_PART + 8 * MiB) { fprintf(stderr, "kernel_launch: unexpected problem (n_in %d out %d ws %zu)\n", n_in, out_size, ws_size); grid = -1; return; }
        int dev = 0, cus = 0, per_cu = 0;
        hipGetDevice(&dev); hipDeviceGetAttribute(&cus, hipDeviceAttributeMultiprocessorCount, dev);
        if (hipFuncSetAttribute((const void*)fwd_megakernel, hipFuncAttributeMaxDynamicSharedMemorySize, LDS_BYTES) != hipSuccess) { fprintf(stderr, "kernel_launch: hipFuncSetAttribute failed\n"); grid = -1; return; }
        if (hipOccupancyMaxActiveBlocksPerMultiprocessor(&per_cu, (const void*)fwd_megakernel, NTHR, LDS_BYTES) != hipSuccess || per_cu < 1) { fprintf(stderr, "kernel_launch: occupancy query says %d\n", per_cu); per_cu = 1; }
        (void)hipGetLastError();
        grid = cus * 1;
        if (grid <= 0) grid = 256;
    }
    if (grid < 0) return;
    Params p{};
    for (int i = 0; i < 19; ++i) p.in[i] = (const float*)d_in[i];
    p.out = (float*)d_out; p.ws = (unsigned char*)d_ws;
#if ONE_LAUNCH
    p.ph_lo = 0; p.ph_hi = 26;
    void* args[] = {&p};
    hipError_t e = hipLaunchCooperativeKernel((const void*)fwd_megakernel, dim3(grid), dim3(NTHR), args, LDS_BYTES, stream);
    if (e != hipSuccess) fprintf(stderr, "cooperative launch failed: %s (grid %d)\n", hipGetErrorString(e), grid);
#else
    for (int ph = 0; ph < 26; ++ph) { p.ph_lo = ph; p.ph_hi = ph + 1; hipLaunchKernelGGL(fwd_megakernel, dim3(grid), dim3(NTHR), LDS_BYTES, stream, p); }
#endif
}
```

```cpp
#include <hip/hip_runtime.h>
#include <hip/hip_cooperative_groups.h>
#include <cstdio>
#include <cstdint>
namespace cg = cooperative_groups;

#ifndef DUP
#define DUP 0
#endif
#ifndef TSEL
#define TSEL (-1)
#endif
#ifndef ONE_LAUNCH
#define ONE_LAUNCH 1
#endif

constexpr int DM = 1024, SEQ = 8192, NB = 2, DEC_B = 32, DEC_T = 16, PAST = 2048;
constexpr int MP = NB * SEQ, MS = DEC_B * DEC_T, MT = MP + MS;
constexpr int DFF = 2816, NIN_RAW = 3592, NIN = 3584;
constexpr int SKV = PAST + DEC_T;
constexpr float RMS_EPS = 1e-6f;
constexpr float LOG2E = 1.4426950408889634f;
constexpr float QSCALE = 0.125f * LOG2E;
constexpr size_t O_YP = 0, O_YS = 16777216, O_KP = 17301504, O_VP = 34078720, O_LFP = 50855936, O_HSP = 51118080,
                 O_KS = 51380224, O_VS = 51904512, O_LFS = 52428800, O_HSS = 52436992, O_END = 56631296;
constexpr size_t MiB = 1u << 20;
constexpr size_t WS_CTL = 0, WS_WFG = 1 * MiB, WS_LB = 1 * MiB + 65536, WS_KTN = 1 * MiB + 131072, WS_G = 2 * MiB, WS_CP = 3 * MiB, WS_CS = 4 * MiB;
constexpr size_t WS_W1T = 8 * MiB, WS_W2T = 52 * MiB, WS_WINT = 74 * MiB, WS_WOT = 88 * MiB;
constexpr size_t WS_X = 92 * MiB, WS_HN = 158 * MiB, WS_ACT = 192 * MiB, WS_QB = 284 * MiB, WS_KB = 301 * MiB, WS_VB = 318 * MiB;
constexpr size_t WS_HF = 336 * MiB, WS_HB = 376 * MiB, WS_MIX = 468 * MiB, WS_US = 502 * MiB, WS_END = 566 * MiB, WS_PART = 760 * MiB;
constexpr size_t WS_RSTD = 1 * MiB + 262144, WS_SSP = 7 * MiB;
constexpr size_t W1T_SZ = (size_t)2 * DFF * DM, W2T_SZ = (size_t)DM * DFF, WINT_SZ = (size_t)NIN * DM, WOT_SZ = (size_t)DM * DM;

#define LAS __attribute__((address_space(3)))
typedef unsigned short bf16;
typedef short bf16x8 __attribute__((ext_vector_type(8)));
typedef float f32x4 __attribute__((ext_vector_type(4)));
typedef float f32x2 __attribute__((ext_vector_type(2)));
typedef unsigned v4u __attribute__((ext_vector_type(4)));
typedef unsigned v2u __attribute__((ext_vector_type(2)));
typedef __bf16 bf16x2_t __attribute__((ext_vector_type(2)));
__device__ __forceinline__ unsigned pk2(float lo, float hi) { f32x2 v = {lo, hi}; bf16x2_t b = __builtin_convertvector(v, bf16x2_t); return __builtin_bit_cast(unsigned, b); }
__device__ __forceinline__ bf16 f2bf(float f) { return (bf16)(pk2(f, 0.f) & 0xffffu); }
__device__ __forceinline__ float bf2f(bf16 h) { return __builtin_bit_cast(float, (unsigned)h << 16); }
__device__ __forceinline__ float fast_exp2(float x) { return __builtin_amdgcn_exp2f(x); }
__device__ __forceinline__ float sigmoidf_(float x) { return __builtin_amdgcn_rcpf(1.0f + __expf(-x)); }
__device__ __forceinline__ float siluf_(float x) { return x * __builtin_amdgcn_rcpf(1.0f + __expf(-x)); }
__device__ __forceinline__ float log_sigmoidf_(float x) { return fminf(x, 0.f) - log1pf(expf(-fabsf(x))); }
__device__ __forceinline__ float log_sigmoid_fast(float x) { return fminf(x, 0.f) - __logf(1.0f + __expf(-fabsf(x))); }
#define LDS_WAIT() asm volatile("s_waitcnt lgkmcnt(0)" ::: "memory")

namespace pg8 {
#define PG8_LAS __attribute__((address_space(3)))
typedef unsigned short bf16_t;
typedef short bf16x8 __attribute__((ext_vector_type(8)));
typedef float f32x4 __attribute__((ext_vector_type(4)));
typedef unsigned u32x4 __attribute__((ext_vector_type(4)));
constexpr int BM = 256, BK = 64, HALF = 128, HTB = HALF * BK * 2  , STAGE_BYTES = 8 * HTB, NXCD = 8, WGM = 8;

__host__ __device__ __forceinline__ int lds_byte(int r, int c) { const int st = (r >> 4) * 2 + (c >> 5), rr = r & 15, cc = c & 31, ob = rr * 64 + cc * 2; return st * 1024 + (ob ^ (((ob >> 9) & 1) << 5)); }
__host__ __device__ __forceinline__ void stage_rc(int b, int& R, int& C) { const int st = b / 1024, sb = b % 1024, swz = sb ^ (((sb >> 9) & 1) << 5); R = (st >> 1) * 16 + swz / 64; C = (st & 1) * 32 + (swz % 64) / 2; }
__host__ __device__ __forceinline__ int perm32(int rho) { const int n = rho >> 4, i = rho & 15; return 8 * (i >> 2) + 4 * n + (i & 3); }

struct Unit { int pm, pn, k0, nt; };
struct Gemm { const bf16_t* A; const bf16_t* Bt; int M, N, K; };

struct StaticOrder {
    int nM, nN, nwg, G, c;
    __host__ __device__ __forceinline__ void init(int M, int N, int G_, int c_) { nM = M / BM; nN = N / BM; nwg = nM * nN; G = G_; c = c_; }
    __host__ __device__ __forceinline__ bool next(int i, Unit& u) const {
        u.pm = 0; u.pn = 0; u.k0 = 0; u.nt = 0;
        const long L = (long)i * G + c; if (L >= nwg) return false;
        int wgid = (int)L; { const int q = nwg / NXCD, r = nwg % NXCD, xcd = wgid % NXCD, off = wgid / NXCD; wgid = (xcd < r ? xcd * (q + 1) : r * (q + 1) + (xcd - r) * q) + off; }
        const int nig = WGM * nN, gid = wgid / nig, fm = gid * WGM, gsz = (nM - fm) < WGM ? (nM - fm) : WGM;
        u.pm = fm + ((wgid % nig) % gsz); u.pn = (wgid % nig) / gsz; u.k0 = 0; u.nt = 0; return true;
    }
    __device__ __forceinline__ void a_ready(const Unit&) const {}
    __device__ __forceinline__ void done(const Unit&) const {}
};

struct SplitOrder {
    StaticOrder base; int R, G, c, ntf;
    __host__ __device__ __forceinline__ void init(int Mprompt, int N, int G_, int c_, int ntf_) { base.init(Mprompt, N, G_, c_); G = G_; c = c_; ntf = ntf_; R = (base.nwg + G - 1) / G; }
    __host__ __device__ __forceinline__ bool next(int i, Unit& u) const {
        if (i < R) { if (base.next(i, u)) return true; }
        const int idle = R * G - base.nwg;
        const int j = (i < R) ? (c - (G - idle)) : ((i - R) * G + c + idle);
        if (i < R - 1 || j < 0 || j >= 32) return false;
        const int us = j >> 2, p = j & 3, bs = (ntf / 4) & ~1, rem2 = (ntf - 4 * bs) / 2;
        u.pm = base.nM + (us >> 2); u.pn = us & 3; u.nt = (bs + (p < rem2 ? 2 : 0)) | (p << 16); u.k0 = p * bs + 2 * (p < rem2 ? p : rem2); return true;
    }
    __device__ __forceinline__ void a_ready(const Unit&) const {}
    __device__ __forceinline__ void done(const Unit&) const {}
};

struct EpiSwiglu {
    static constexpr bool PERM = true, AFTER_DRAIN = false;
    bf16_t* O; const float* RSTD;
    __device__ __forceinline__ void operator()(const f32x4 (&acc)[2][2][4][2], const Unit& u, int wr, int wc, int fr, int fq) const {
        const int row0 = u.pm * BM + wr * 64 + fr, col0 = u.pn * 128 + wc * 32 + 8 * fq;
#pragma unroll
        for (int ai = 0; ai < 2; ++ai)
#pragma unroll
            for (int m = 0; m < 4; ++m) {
                f32x4 a0 = acc[ai][0][m][0], a1 = acc[ai][0][m][1], b0 = acc[ai][1][m][0], b1 = acc[ai][1][m][1];
                if (RSTD) { const float r = RSTD[row0 + ai * HALF + m * 16]; a0 = a0 * r; a1 = a1 * r; b0 = b0 * r; b1 = b1 * r; }
                u32x4 w;
                w.x = ::pk2(::siluf_(a0[0]) * b0[0], ::siluf_(a0[1]) * b0[1]); w.y = ::pk2(::siluf_(a0[2]) * b0[2], ::siluf_(a0[3]) * b0[3]);
                w.z = ::pk2(::siluf_(a1[0]) * b1[0], ::siluf_(a1[1]) * b1[1]); w.w = ::pk2(::siluf_(a1[2]) * b1[2], ::siluf_(a1[3]) * b1[3]);
                *(u32x4*)(O + (size_t)(row0 + ai * HALF + m * 16) * ::DFF + col0) = w;
            }
    }
};
struct EpiRes {
    static constexpr bool PERM = true, AFTER_DRAIN = false;
    float* X; const float* BASE; float* PART; float scale; bf16_t* HNO; const float* GN; float* SSP;
    __device__ __forceinline__ void operator()(const f32x4 (&acc)[2][2][4][2], const Unit& u, int wr, int wc, int fr, int fq) const {
        const int row0 = u.pm * BM + wr * 64 + fr, col0 = u.pn * BM + wc * 32 + 8 * fq;
        float* base = u.nt ? PART + (ptrdiff_t)((u.nt >> 16) * ::MS - ::MP) * ::DM : X; const ptrdiff_t boff = BASE - X;
        const bool fuse = (HNO != nullptr) && (u.nt == 0);
        f32x4 gv[2][2];
        if (fuse) {
#pragma unroll
            for (int bj = 0; bj < 2; ++bj)
#pragma unroll
                for (int n = 0; n < 2; ++n) gv[bj][n] = *(const f32x4*)(GN + col0 + bj * HALF + n * 4); }
#pragma unroll
        for (int ai = 0; ai < 2; ++ai)
#pragma unroll
            for (int m = 0; m < 4; ++m) { const int row = row0 + ai * HALF + m * 16; float* rowp = base + (size_t)row * ::DM + col0; float ss = 0.f;
#pragma unroll
                for (int bj = 0; bj < 2; ++bj) { f32x4* p = (f32x4*)(rowp + bj * HALF);
                    if (u.nt) { p[0] = acc[ai][bj][m][0]; p[1] = acc[ai][bj][m][1]; }
                    else { const f32x4* q = (const f32x4*)((const float*)p + boff);
                        const f32x4 x0 = q[0] + acc[ai][bj][m][0] * scale, x1 = q[1] + acc[ai][bj][m][1] * scale; p[0] = x0; p[1] = x1;
                        if (fuse) { ss += ((x0[0] * x0[0] + x0[1] * x0[1]) + (x0[2] * x0[2] + x0[3] * x0[3])) + ((x1[0] * x1[0] + x1[1] * x1[1]) + (x1[2] * x1[2] + x1[3] * x1[3]));
                            const f32x4 h0 = x0 * gv[bj][0], h1 = x1 * gv[bj][1]; u32x4 w; w.x = ::pk2(h0[0], h0[1]); w.y = ::pk2(h0[2], h0[3]); w.z = ::pk2(h1[0], h1[1]); w.w = ::pk2(h1[2], h1[3]);
                            *(u32x4*)(HNO + (size_t)row * ::DM + col0 + bj * HALF) = w; } } }
                if (fuse) { ss += __shfl_xor(ss, 16); ss += __shfl_xor(ss, 32); if (fq == 0) SSP[(size_t)row * 16 + u.pn * 4 + wc] = ss; } }
    }
};
struct EpiInProj {
    static constexpr bool PERM = true, AFTER_DRAIN = false;
    bf16_t *Q, *K, *V; float* HF; bf16_t* HB; float* out; int l;
    __device__ __forceinline__ void operator()(const f32x4 (&acc)[2][2][4][2], const Unit& u, int wr, int wc, int fr, int fq) const {
        const int seg = u.pn >> 1, cbase = (u.pn & 1) * 256 + wc * 32 + 8 * fq, row0 = u.pm * BM + wr * 64 + fr;
#pragma unroll
        for (int ai = 0; ai < 2; ++ai)
#pragma unroll
            for (int m = 0; m < 4; ++m) { const int row = row0 + ai * HALF + m * 16;
#pragma unroll
                for (int bj = 0; bj < 2; ++bj) { const int cs = cbase + bj * HALF; f32x4 v0 = acc[ai][bj][m][0], v1 = acc[ai][bj][m][1];
                    if (seg == 0) { v0 = v0 * ::QSCALE; v1 = v1 * ::QSCALE; u32x4 w; w.x = ::pk2(v0[0], v0[1]); w.y = ::pk2(v0[2], v0[3]); w.z = ::pk2(v1[0], v1[1]); w.w = ::pk2(v1[2], v1[3]);
                        *(u32x4*)(Q + (size_t)row * 512 + cs) = w; }
                    else if (seg <= 2) { u32x4 w; w.x = ::pk2(v0[0], v0[1]); w.y = ::pk2(v0[2], v0[3]); w.z = ::pk2(v1[0], v1[1]); w.w = ::pk2(v1[2], v1[3]);
                        *(u32x4*)((seg == 1 ? K : V) + (size_t)row * 512 + cs) = w;
                        const int head = cs >> 6, d = cs & 63; size_t o;
                        if (row < ::MP) { const int b = row >> 13, t = row & 8191; o = (seg == 1 ? ::O_KP : ::O_VP) + ((((size_t)l * 2 + b) * 8 + head) * 8192 + t) * 64 + d; }
                        else { const int rs = row - ::MP, b = rs >> 4, t = rs & 15; o = (seg == 1 ? ::O_KS : ::O_VS) + ((((size_t)l * 32 + b) * 8 + head) * 16 + t) * 64 + d; }
                        __builtin_nontemporal_store(v0, (f32x4*)(out + o)); __builtin_nontemporal_store(v1, (f32x4*)(out + o + 4)); }
                    else if (seg == 4) { float* hp = HF + (size_t)row * 512 + cs; *(f32x4*)hp = v0; *(f32x4*)(hp + 4) = v1; }
                    else { if (seg == 3) { v0 = (f32x4){::siluf_(v0[0]), ::siluf_(v0[1]), ::siluf_(v0[2]), ::siluf_(v0[3])}; v1 = (f32x4){::siluf_(v1[0]), ::siluf_(v1[1]), ::siluf_(v1[2]), ::siluf_(v1[3])}; }
                        u32x4 w; w.x = ::pk2(v0[0], v0[1]); w.y = ::pk2(v0[2], v0[3]); w.z = ::pk2(v1[0], v1[1]); w.w = ::pk2(v1[2], v1[3]);
                        *(u32x4*)(HB + (size_t)row * 1536 + (seg == 3 ? 0 : (seg == 5 ? 512 : 1024)) + cs) = w; }
                } }
    }
};
template <class Epi, class Sched, bool ALIGN_EPI = false, bool SP2 = false>
__device__ __forceinline__ void gemm_phase(PG8_LAS unsigned char* lds, const Gemm g, const Sched& S, const Epi& E) {
    const int tid = threadIdx.x, wid = __builtin_amdgcn_readfirstlane(tid >> 6), lane = tid & 63, wr = wid >> 2, wc = wid & 3, fr = lane & 15, fq = lane >> 4;
    const int K = g.K, ntf = K / BK;
    unsigned voffA[2], voffB[2];
#pragma unroll
    for (int i = 0; i < 2; ++i) { int R, C; stage_rc(tid * 16 + i * 8192, R, C); const int Rb = Epi::PERM ? ((R & ~31) + perm32(R & 31)) : R;
        voffA[i] = (unsigned)(R * K + C) * 2u; voffB[i] = (unsigned)(Rb * K + C) * 2u; }
    const size_t kstep = (size_t)(BK * 2);
    const size_t hstep = (size_t)HALF * K * 2;
    const size_t tstep = 2 * hstep;
    const unsigned ldsw = (unsigned)wid * 1024u;
    const int aoff = lds_byte(wr * 64 + fr, fq * 8), boff = lds_byte(wc * 32 + fr, fq * 8);
#define PG8_SA(b, h) (((b) * 2 + (h)) * HTB)
#define PG8_SB(b, h) ((4 + (b) * 2 + (h)) * HTB)
#define PG8_STAGE(bufoff, gbase, voff) do { _Pragma("unroll") for (int _i = 0; _i < 2; ++_i) \
        __builtin_amdgcn_global_load_lds((const unsigned*)((const char*)(gbase) + (voff)[_i]), (PG8_LAS unsigned*)(lds + (bufoff) + ldsw + _i * 8192), 16, 0, 0); } while (0)
#define PG8_LDA(dst, b, h) do { _Pragma("unroll") for (int m = 0; m < 4; ++m) _Pragma("unroll") for (int k = 0; k < 2; ++k) dst[m][k] = *(const PG8_LAS bf16x8*)(lds + PG8_SA(b, h) + aoff + m * 2048 + k * 1024); } while (0)
#define PG8_LDB(dst, b, h) do { _Pragma("unroll") for (int n = 0; n < 2; ++n) _Pragma("unroll") for (int k = 0; k < 2; ++k) dst[n][k] = *(const PG8_LAS bf16x8*)(lds + PG8_SB(b, h) + boff + n * 2048 + k * 1024); } while (0)
#define PG8_MMA(ai, bj, At, Bt) do { __builtin_amdgcn_s_setprio(1); _Pragma("unroll") for (int m = 0; m < 4; ++m) _Pragma("unroll") for (int n = 0; n < 2; ++n) _Pragma("unroll") for (int k = 0; k < 2; ++k) \
        acc[ai][bj][m][n] = __builtin_amdgcn_mfma_f32_16x16x32_bf16(Bt[n][k], At[m][k], acc[ai][bj][m][n], 0, 0, 0); __builtin_amdgcn_s_setprio(0); } while (0)
#define PG8_WAIT_V(n) asm volatile("s_waitcnt vmcnt(" #n ")" ::: "memory")
#define PG8_WAIT_L(n) asm volatile("s_waitcnt lgkmcnt(" #n ")" ::: "memory")
#define PG8_BAR __builtin_amdgcn_s_barrier()
#define PG8_SCHED __builtin_amdgcn_sched_barrier(0)
    Unit cur{0, 0, 0, 0}, nxt{0, 0, 0, 0}; int ui = 0;
    if (!S.next(0, cur)) return;
    f32x4 acc[2][2][4][2];
#pragma unroll
    for (int a = 0; a < 2; ++a)
#pragma unroll
        for (int b = 0; b < 2; ++b)
#pragma unroll
            for (int m = 0; m < 4; ++m)
#pragma unroll
                for (int n = 0; n < 2; ++n) acc[a][b][m][n] = (f32x4){0.f, 0.f, 0.f, 0.f};
    bf16x8 At[4][2], B0[2][2], B1[2][2];
    const char* cA = (const char*)g.A + (size_t)cur.pm * tstep + (size_t)cur.k0 * kstep; const char* cB = (const char*)g.Bt + (size_t)cur.pn * tstep + (size_t)cur.k0 * kstep; int nt = cur.nt ? (cur.nt & 0xffff) : ntf;
    S.a_ready(cur);
    if constexpr (SP2) {
        PG8_STAGE(PG8_SB(0, 0), cB, voffB); PG8_STAGE(PG8_SB(0, 1), cB + hstep, voffB); PG8_STAGE(PG8_SA(0, 0), cA, voffA); PG8_STAGE(PG8_SA(0, 1), cA + hstep, voffA);
        if (wr == 1) PG8_BAR;
        PG8_WAIT_V(2); PG8_BAR;
        PG8_STAGE(PG8_SB(1, 0), cB + kstep, voffB); PG8_STAGE(PG8_SA(1, 0), cA + kstep, voffA); PG8_STAGE(PG8_SB(1, 1), cB + hstep + kstep, voffB);
        PG8_WAIT_V(6); PG8_BAR;
    } else {
        PG8_STAGE(PG8_SB(0, 0), cB, voffB); PG8_STAGE(PG8_SA(0, 0), cA, voffA); PG8_STAGE(PG8_SB(0, 1), cB + hstep, voffB); PG8_STAGE(PG8_SA(0, 1), cA + hstep, voffA);
        if (wr == 1) PG8_BAR;
        PG8_WAIT_V(4); PG8_BAR;
        PG8_STAGE(PG8_SB(1, 0), cB + kstep, voffB); PG8_STAGE(PG8_SA(1, 0), cA + kstep, voffA); PG8_STAGE(PG8_SB(1, 1), cB + hstep + kstep, voffB);
        PG8_WAIT_V(6); PG8_BAR;
    }
    for (;;) {
        const bool has_next = S.next(ui + 1, nxt);
        const char* nA = has_next ? (const char*)g.A + (size_t)nxt.pm * tstep + (size_t)nxt.k0 * kstep : cA; const char* nB = has_next ? (const char*)g.Bt + (size_t)nxt.pn * tstep + (size_t)nxt.k0 * kstep : cB;
        for (int t = 0; t < nt; t += 2) {
            const bool last = (t == nt - 2);
            const char* a1 = cA + (size_t)(t + 1) * kstep;
            const char* a2 = last ? nA : cA + (size_t)(t + 2) * kstep; const char* b2 = last ? nB : cB + (size_t)(t + 2) * kstep;
            const char* a3 = a2 + kstep; const char* b3 = b2 + kstep;
            if (last && has_next) S.a_ready(nxt);
            if constexpr (SP2) {
            PG8_LDB(B0, 0, 0); PG8_LDB(B1, 0, 1); PG8_SCHED; PG8_LDA(At, 0, 0); PG8_STAGE(PG8_SA(1, 1), a1 + hstep, voffA);
            PG8_WAIT_V(8); PG8_WAIT_L(0); PG8_BAR; PG8_MMA(0, 0, At, B0); PG8_MMA(0, 1, At, B1); PG8_BAR; PG8_SCHED;
            PG8_LDA(At, 0, 1); PG8_STAGE(PG8_SB(0, 0), b2, voffB); PG8_STAGE(PG8_SB(0, 1), b2 + hstep, voffB); PG8_STAGE(PG8_SA(0, 0), a2, voffA);
            PG8_WAIT_V(8); PG8_WAIT_L(0); PG8_BAR; PG8_MMA(1, 0, At, B0); PG8_MMA(1, 1, At, B1); PG8_BAR; PG8_SCHED;
            PG8_LDB(B0, 1, 0); PG8_LDB(B1, 1, 1); PG8_SCHED; PG8_LDA(At, 1, 0); PG8_STAGE(PG8_SA(0, 1), a2 + hstep, voffA);
            PG8_WAIT_V(8); PG8_WAIT_L(0); PG8_BAR; PG8_MMA(0, 0, At, B0); PG8_MMA(0, 1, At, B1); PG8_BAR; PG8_SCHED;
            PG8_LDA(At, 1, 1); PG8_STAGE(PG8_SB(1, 0), b3, voffB); PG8_STAGE(PG8_SB(1, 1), b3 + hstep, voffB); PG8_STAGE(PG8_SA(1, 0), a3, voffA);
            PG8_WAIT_V(8); PG8_WAIT_L(0); PG8_BAR; PG8_MMA(1, 0, At, B0); PG8_MMA(1, 1, At, B1); PG8_BAR; PG8_SCHED;
            } else {
            PG8_LDB(B0, 0, 0); PG8_SCHED; PG8_LDA(At, 0, 0); PG8_STAGE(PG8_SA(1, 1), a1 + hstep, voffA);
            PG8_WAIT_L(8); PG8_BAR; PG8_WAIT_L(0); PG8_MMA(0, 0, At, B0); PG8_BAR; PG8_SCHED;
            PG8_LDB(B1, 0, 1); PG8_STAGE(PG8_SB(0, 0), b2, voffB);
            PG8_BAR; PG8_WAIT_L(0); PG8_MMA(0, 1, At, B1); PG8_BAR;
            PG8_LDA(At, 0, 1); PG8_STAGE(PG8_SA(0, 0), a2, voffA);
            PG8_BAR; PG8_WAIT_L(0); PG8_MMA(1, 0, At, B0); PG8_BAR; PG8_SCHED;
            PG8_STAGE(PG8_SB(0, 1), b2 + hstep, voffB);
            PG8_WAIT_V(6); PG8_BAR; PG8_MMA(1, 1, At, B1); PG8_BAR;
            PG8_LDB(B0, 1, 0); PG8_SCHED; PG8_LDA(At, 1, 0); PG8_STAGE(PG8_SA(0, 1), a2 + hstep, voffA);
            PG8_WAIT_L(8); PG8_BAR; PG8_WAIT_L(0); PG8_MMA(0, 0, At, B0); PG8_BAR; PG8_SCHED;
            PG8_LDB(B1, 1, 1); PG8_STAGE(PG8_SB(1, 0), b3, voffB);
            PG8_BAR; PG8_WAIT_L(0); PG8_MMA(0, 1, At, B1); PG8_BAR;
            PG8_LDA(At, 1, 1); PG8_STAGE(PG8_SA(1, 0), a3, voffA);
            PG8_BAR; PG8_WAIT_L(0); PG8_MMA(1, 0, At, B0); PG8_BAR; PG8_SCHED;
            PG8_STAGE(PG8_SB(1, 1), b3 + hstep, voffB);
            PG8_WAIT_V(6); PG8_BAR; PG8_MMA(1, 1, At, B1); PG8_BAR;
            }
        }
        if constexpr (ALIGN_EPI) { if (wr == 0) PG8_BAR; }
        if constexpr (!Epi::AFTER_DRAIN) { E(acc, cur, wr, wc, fr, fq); S.done(cur); }
        if (!has_next) break;
#pragma unroll
        for (int a = 0; a < 2; ++a)
#pragma unroll
            for (int b = 0; b < 2; ++b)
#pragma unroll
                for (int m = 0; m < 4; ++m)
#pragma unroll
                    for (int n = 0; n < 2; ++n) acc[a][b][m][n] = (f32x4){0.f, 0.f, 0.f, 0.f};
        cur = nxt; cA = nA; cB = nB; ++ui; nt = cur.nt ? (cur.nt & 0xffff) : ntf;
        if constexpr (ALIGN_EPI) { if (wr == 1) PG8_BAR; }
    }
    PG8_WAIT_V(0);
    if constexpr (!ALIGN_EPI) { if (wr == 0) PG8_BAR; }
    PG8_BAR;
    if constexpr (Epi::AFTER_DRAIN) { E.fused(acc, cur, wr, wc, fr, fq, lds, wid, lane); S.done(cur); }
#undef PG8_SA
#undef PG8_SB
#undef PG8_STAGE
#undef PG8_LDA
#undef PG8_LDB
#undef PG8_MMA
#undef PG8_WAIT_V
#undef PG8_WAIT_L
#undef PG8_BAR
#undef PG8_SCHED
}
}

constexpr int NWAVES = 8, NTHR = 512;
constexpr int RING_BYTES = 131072, LDS_BYTES = 147456;
struct Params { const float* in[19]; float* out; unsigned char* ws; int ph_lo, ph_hi; };

struct Ctx {
    LAS unsigned char* lds;
    int tid, lane, wave, G, bid;
    const float* in[19]; float* out; unsigned char* ws;
};
#define CTX_GW(C) ((C).bid * NWAVES + (C).wave)
#define CTX_NGW(C) ((C).G * NWAVES)

__device__ __forceinline__ float wave_sum(float v) {
#pragma unroll
    for (int o = 1; o < 64; o <<= 1) v += __shfl_xor(v, o);
    return v;
}
__device__ __forceinline__ float wave_max(float v) {
#pragma unroll
    for (int o = 1; o < 64; o <<= 1) v = fmaxf(v, __shfl_xor(v, o));
    return v;
}
__device__ __forceinline__ f32x4 mfma16(bf16x8 a, bf16x8 b, f32x4 c) { return __builtin_amdgcn_mfma_f32_16x16x32_bf16(a, b, c, 0, 0, 0); }

__device__ __forceinline__ void transpose_item(const float* W, int K, int N, int srccol0, bf16* WT, int dstrow0, int k0, LAS float* scr, int lane) {
#pragma unroll 8
    for (int i = 0; i < 32; ++i) { const int kk = 2 * i + (lane >> 5); scr[kk * 33 + (lane & 31)] = __builtin_nontemporal_load(W + (size_t)(k0 + kk) * N + srccol0 + (lane & 31)); }
    LDS_WAIT();
    const int c = lane & 7;
#pragma unroll
    for (int j = 0; j < 4; ++j) { const int n = (lane >> 3) + 8 * j; const LAS float* s = scr + (8 * c) * 33 + n;
        v4u o; o.x = pk2(s[0 * 33], s[1 * 33]); o.y = pk2(s[2 * 33], s[3 * 33]); o.z = pk2(s[4 * 33], s[5 * 33]); o.w = pk2(s[6 * 33], s[7 * 33]);
        *(v4u*)(WT + (size_t)(dstrow0 + n) * K + k0 + 8 * c) = o; }
    LDS_WAIT();
}
__device__ __forceinline__ void phase_prologue(Ctx& C) {
    LAS float* scr = (LAS float*)(C.lds + C.wave * 16384);
    const int gw = CTX_GW(C), NGW = CTX_NGW(C);
    constexpr int I_UP = 16 * 176, I_DN = 44 * 32, I_IN = 16 * 112, I_OUT = 16 * 32, I_LAYER = 2 * I_UP + 2 * I_DN + I_IN + I_OUT;
    for (int it = gw; it < 2 * I_LAYER; it += NGW) {
        const int l = it / I_LAYER; int r = it % I_LAYER;
        int which;
        if (r < I_UP) which = 0; else if ((r -= I_UP) < I_DN) which = 1; else if ((r -= I_DN) < I_IN) which = 2; else if ((r -= I_IN) < I_OUT) which = 3; else if ((r -= I_OUT) < I_UP) which = 4; else { r -= I_UP; which = 5; }
        if (which == 0 || which == 4) {
            const int nb = r % 176, kb = r / 176, d0 = nb * 32, pn = d0 >> 8, w = d0 & 255;
            const int src = (w < 128) ? (128 * pn + w) : (DFF + 128 * pn + (w - 128));
            const float* W = C.in[which == 0 ? 7 : 16] + (size_t)l * DM * 2 * DFF;
            bf16* WT = (bf16*)(C.ws + WS_W1T) + (size_t)(l * 2 + (which == 4)) * W1T_SZ;
            transpose_item(W, DM, 2 * DFF, src, WT, d0, kb * 64, scr, C.lane);
        } else if (which == 1 || which == 5) {
            const int nb = r % 32, kb = r / 32;
            const float* W = C.in[which == 1 ? 8 : 17] + (size_t)l * DFF * DM;
            bf16* WT = (bf16*)(C.ws + WS_W2T) + (size_t)(l * 2 + (which == 5)) * W2T_SZ;
            transpose_item(W, DFF, DM, nb * 32, WT, nb * 32, kb * 64, scr, C.lane);
        } else if (which == 2) {
            const int nb = r % 112, kb = r / 112, d0 = nb * 32, src = d0 < 1536 ? d0 : d0 + 8;
            transpose_item(C.in[10] + (size_t)l * DM * NIN_RAW, DM, NIN_RAW, src, (bf16*)(C.ws + WS_WINT) + (size_t)l * WINT_SZ, d0, kb * 64, scr, C.lane);
        } else {
            const int nb = r % 32, kb = r / 32;
            transpose_item(C.in[14] + (size_t)l * DM * DM, DM, DM, nb * 32, (bf16*)(C.ws + WS_WOT) + (size_t)l * WOT_SZ, nb * 32, kb * 64, scr, C.lane);
        }
    }
    const int gt = C.bid * NTHR + C.tid, NGT = C.G * NTHR;
    float* WFG = (float*)(C.ws + WS_WFG);
    for (int i = gt; i < 2 * 8 * DM; i += NGT) { const int l = i >> 13, j = (i >> 10) & 7, k = i & 1023; WFG[i] = C.in[10][((size_t)l * DM + k) * NIN_RAW + 1536 + j]; }
    float* LB = (float*)(C.ws + WS_LB);
    for (int i = gt; i < 512; i += NGT) { const float p0 = C.in[12][i], p1 = C.in[12][512 + i], mx = fmaxf(p0, p1), e0 = expf(p0 - mx), e1 = expf(p1 - mx);
        LB[i] = 0.f; LB[512 + i] = e1 / (e0 + e1); }
}

template <int MODE> __device__ __forceinline__ void phase_rms(Ctx& C, const float* g, int l, float pend, int src) {
    const int gw = CTX_GW(C), NGW = CTX_NGW(C), lane = C.lane;
    float* X = (float*)(C.ws + WS_X); bf16* HN = (bf16*)(C.ws + WS_HN); const float* PART = (const float*)(C.ws + WS_PART);
    f32x4 gv[4];
#pragma unroll
    for (int j = 0; j < 4; ++j) gv[j] = ((const f32x4*)g)[lane + 64 * j];
    f32x4 wfg[8][4];
    if (MODE == 1) { const float* WFG = (const float*)(C.ws + WS_WFG) + (size_t)l * 8 * DM;
#pragma unroll
        for (int jj = 0; jj < 8; ++jj)
#pragma unroll
            for (int j = 0; j < 4; ++j) wfg[jj][j] = ((const f32x4*)(WFG + jj * DM))[lane + 64 * j]; }
#define RMS_XROW(r) (((src == 1 && (r) < MP) ? C.in[0] + (size_t)(r) * DM : ((src != 0 && (r) >= MP) ? C.in[1] + (size_t)((r) - MP) * DM : X + (size_t)(r) * DM)))
    f32x4 nv[4];
    if (gw < MT) { const f32x4* xr0 = (const f32x4*)RMS_XROW(gw) + lane;
#pragma unroll
        for (int j = 0; j < 4; ++j) nv[j] = xr0[64 * j]; }
    for (int row = gw; row < MT; row += NGW) {
        f32x4 v[4]; float s = 0.f;
#pragma unroll
        for (int j = 0; j < 4; ++j) v[j] = nv[j];
        if (row + NGW < MT) { const f32x4* xr1 = (const f32x4*)RMS_XROW(row + NGW) + lane;
#pragma unroll
            for (int j = 0; j < 4; ++j) nv[j] = xr1[64 * j]; }
        if (pend != 0.f && row >= MP) {
#pragma unroll
            for (int j = 0; j < 4; ++j) { const f32x4* pp = (const f32x4*)(PART + (size_t)(row - MP) * DM) + lane + 64 * j;
                v[j] = v[j] + ((pp[0] + pp[MS * DM / 4]) + (pp[2 * MS * DM / 4] + pp[3 * MS * DM / 4])) * pend;
                ((f32x4*)(X + (size_t)row * DM))[lane + 64 * j] = v[j]; } }
#pragma unroll
        for (int j = 0; j < 4; ++j) s += (v[j].x * v[j].x + v[j].y * v[j].y) + (v[j].z * v[j].z + v[j].w * v[j].w);
        const float rstd = __builtin_amdgcn_rsqf(wave_sum(s) * (1.0f / DM) + RMS_EPS);
#pragma unroll
        for (int j = 0; j < 4; ++j) v[j] = v[j] * rstd * gv[j];
        if (MODE == 2) {
            float* o = C.out + (row < MP ? O_YP + (size_t)row * DM : O_YS + (size_t)(row - MP) * DM);
#pragma unroll
            for (int j = 0; j < 4; ++j) __builtin_nontemporal_store(v[j], (f32x4*)o + lane + 64 * j);
        } else {
            v2u* o8 = (v2u*)(HN + (size_t)row * DM) + lane;
#pragma unroll
            for (int j = 0; j < 4; ++j) { v2u w; w.x = pk2(v[j].x, v[j].y); w.y = pk2(v[j].z, v[j].w); o8[64 * j] = w; }
        }
        if (MODE == 1) {
            float fg[8];
#pragma unroll
            for (int jj = 0; jj < 8; ++jj) { float a = 0.f;
#pragma unroll
                for (int j = 0; j < 4; ++j) { const f32x4 w = wfg[jj][j]; a += (v[j].x * w.x + v[j].y * w.y) + (v[j].z * w.z + v[j].w * w.w); }
                fg[jj] = wave_sum(a); }
            float mine = fg[0];
#pragma unroll
            for (int jj = 1; jj < 8; ++jj) mine = (lane == jj) ? fg[jj] : mine;
            if (lane < 8) { const float lf = log_sigmoidf_(mine + C.in[11][l * 8 + lane]);
                size_t o;
                if (row < MP) { const int b = row >> 13, t = row & 8191; o = O_LFP + (((size_t)l * 2 + b) * 8 + lane) * 8192 + t; }
                else { const int rs = row - MP, b = rs >> 4, t = rs & 15; o = O_LFS + (((size_t)l * 32 + b) * 8 + lane) * 16 + t; }
                C.out[o] = lf; }
        }
    }
}

__device__ __forceinline__ void phase_rms_mini(Ctx& C, const float* g, float pend) {
    float* RSTD = (float*)(C.ws + WS_RSTD); const float* SSP = (const float*)(C.ws + WS_SSP);
    for (int r = C.bid * NTHR + C.tid; r < MP; r += C.G * NTHR) { const f32x4* p = (const f32x4*)(SSP + (size_t)r * 16);
        const f32x4 s4 = (p[0] + p[1]) + (p[2] + p[3]); RSTD[r] = __builtin_amdgcn_rsqf(((s4.x + s4.y) + (s4.z + s4.w)) * (1.0f / DM) + RMS_EPS); }
    const int gw = CTX_GW(C), NGW = CTX_NGW(C), lane = C.lane;
    float* X = (float*)(C.ws + WS_X); bf16* HN = (bf16*)(C.ws + WS_HN); const float* PART = (const float*)(C.ws + WS_PART);
    for (int row = MP + gw; row < MT; row += NGW) {
        f32x4 v[4]; float s = 0.f;
#pragma unroll
        for (int j = 0; j < 4; ++j) { const f32x4* pp = (const f32x4*)(PART + (size_t)(row - MP) * DM) + lane + 64 * j;
            v[j] = ((const f32x4*)(X + (size_t)row * DM))[lane + 64 * j] + ((pp[0] + pp[MS * DM / 4]) + (pp[2 * MS * DM / 4] + pp[3 * MS * DM / 4])) * pend;
            ((f32x4*)(X + (size_t)row * DM))[lane + 64 * j] = v[j];
            s += (v[j].x * v[j].x + v[j].y * v[j].y) + (v[j].z * v[j].z + v[j].w * v[j].w); }
        const float rstd = __builtin_amdgcn_rsqf(wave_sum(s) * (1.0f / DM) + RMS_EPS);
        if (lane == 0) RSTD[row] = rstd;
        v2u* o8 = (v2u*)(HN + (size_t)row * DM) + lane;
#pragma unroll
        for (int j = 0; j < 4; ++j) { const f32x4 gj = ((const f32x4*)g)[lane + 64 * j]; const f32x4 h = v[j] * gj; v2u w; w.x = pk2(h.x, h.y); w.y = pk2(h.z, h.w); o8[64 * j] = w; }
    }
}

constexpr int HL_LF = 0, HL_SEG = 32768, HL_QT = 34816, HL_KTL = HL_QT + 17408, HL_VT = HL_KTL + 17408, HL_ST = HL_VT + 18432, HL_AS = HL_ST + 34816, HL_KH = HL_AS + 9216, HL_END = HL_KH + 10240;
static_assert(HL_END <= LDS_BYTES - 1024, "HGRN LDS map");
constexpr int HP_Q = 136, HP_V = 72, HP_O = 132;

template <int CH> __device__ __forceinline__ void hgrn_decay_prefix(Ctx& C, const float* HF, int row0, int h, const float* lb) {
    LAS float* LF = (LAS float*)(C.lds + HL_LF); LAS float* SEG = (LAS float*)(C.lds + HL_SEG);
    const int tid = C.tid;
#pragma unroll
    for (int idx = tid; idx < CH * 128; idx += NTHR) { const int s = idx >> 7, d = idx & 127;
        const float z = HF[(size_t)(row0 + s) * 512 + h * 128 + d], lbv = lb[d];
        LF[idx] = (lbv == 0.f) ? log_sigmoid_fast(z) : __logf(lbv + (1.f - lbv) * sigmoidf_(z)); }
    __syncthreads();
    const int seg = tid >> 7, d = tid & 127; constexpr int R = CH / 4;
    float run = 0.f;
#pragma unroll
    for (int i = 0; i < R; ++i) { run += LF[(seg * R + i) * 128 + d]; LF[(seg * R + i) * 128 + d] = run; }
    SEG[seg * 128 + d] = run;
    __syncthreads();
    float off = 0.f;
#pragma unroll
    for (int s2 = 0; s2 < 3; ++s2) if (s2 < seg) off += SEG[s2 * 128 + d];
#pragma unroll
    for (int i = 0; i < R; ++i) LF[(seg * R + i) * 128 + d] += off;
    __syncthreads();
}

struct HRegs { float z[16]; bf16 q[16], v[16]; };
template <bool WITHQ> __device__ __forceinline__ void hgrn_load_regs(Ctx& C, HRegs& R, int unit) {
    const int bh = unit >> 7, c = unit & 127, b = bh >> 2, h = bh & 3, row0 = b * SEQ + c * 64, d = C.tid & 127, s0 = C.tid >> 7;
    const float* HF = (const float*)(C.ws + WS_HF) + (size_t)(row0 + s0) * 512 + h * 128 + d; const bf16* HB = (const bf16*)(C.ws + WS_HB) + (size_t)(row0 + s0) * 1536 + h * 128 + d;
#pragma unroll
    for (int i = 0; i < 16; ++i) { R.z[i] = HF[(size_t)i * 4 * 512]; R.v[i] = HB[(size_t)i * 4 * 1536 + 512]; if (WITHQ) R.q[i] = HB[(size_t)i * 4 * 1536]; }
}
__device__ __forceinline__ void hgrn_decay_prefix_regs(Ctx& C, const HRegs& R, const float* lb) {
    LAS float* LF = (LAS float*)(C.lds + HL_LF); LAS float* SEG = (LAS float*)(C.lds + HL_SEG);
    const int tid = C.tid; const float lbv = lb[tid & 127];
#pragma unroll
    for (int i = 0; i < 16; ++i) { const float z = R.z[i]; LF[tid + NTHR * i] = (lbv == 0.f) ? log_sigmoid_fast(z) : __logf(lbv + (1.f - lbv) * sigmoidf_(z)); }
    __syncthreads();
    const int seg = tid >> 7, d = tid & 127;
    float run = 0.f;
#pragma unroll
    for (int i = 0; i < 16; ++i) { run += LF[(seg * 16 + i) * 128 + d]; LF[(seg * 16 + i) * 128 + d] = run; }
    SEG[seg * 128 + d] = run;
    __syncthreads();
    float off = 0.f;
#pragma unroll
    for (int s2 = 0; s2 < 3; ++s2) if (s2 < seg) off += SEG[s2 * 128 + d];
#pragma unroll
    for (int i = 0; i < 16; ++i) LF[(seg * 16 + i) * 128 + d] += off;
    __syncthreads();
}

__device__ __forceinline__ void hgrn_local_unit(Ctx& C, int unit, int next_unit, int l, HRegs& R) {
    const int bh = unit >> 7, h = bh & 3;
    const float* lb = (const float*)(C.ws + WS_LB) + l * 512 + h * 128;
    hgrn_decay_prefix_regs(C, R, lb);
    LAS float* LF = (LAS float*)(C.lds + HL_LF);
    LAS bf16* KT = (LAS bf16*)(C.lds + HL_QT); LAS bf16* VT = (LAS bf16*)(C.lds + HL_VT);
    const int tid = C.tid, d = tid & 127, s0 = tid >> 7; const float oml = 1.f - lb[d], blast = LF[63 * 128 + d];
#pragma unroll
    for (int i = 0; i < 16; ++i) { const int s = s0 + 4 * i; const float k = oml * sigmoidf_(-R.z[i]);
        KT[d * HP_V + s] = f2bf(k * __expf(blast - LF[s * 128 + d])); VT[d * HP_V + s] = R.v[i]; }
    if (tid < 128) ((float*)(C.ws + WS_G))[(size_t)unit * 128 + tid] = __expf(blast);
    if (next_unit < 1024) hgrn_load_regs<false>(C, R, next_unit);
    __syncthreads();
    const int lane = C.lane, w = C.wave, r16 = lane & 15, quad = lane >> 4;
    f32x4 acc[8];
#pragma unroll
    for (int nb = 0; nb < 8; ++nb) acc[nb] = (f32x4){0.f, 0.f, 0.f, 0.f};
#pragma unroll
    for (int ks = 0; ks < 2; ++ks) { const bf16x8 a = *(const LAS bf16x8*)(VT + (w * 16 + r16) * HP_V + ks * 32 + quad * 8);
#pragma unroll
        for (int nb = 0; nb < 8; ++nb) { const bf16x8 bb = *(const LAS bf16x8*)(KT + (nb * 16 + r16) * HP_V + ks * 32 + quad * 8); acc[nb] = mfma16(a, bb, acc[nb]); } }
    bf16* US = (bf16*)(C.ws + WS_US) + (size_t)unit * 16384;
#pragma unroll
    for (int nb = 0; nb < 8; ++nb)
#pragma unroll
        for (int j = 0; j < 4; ++j) US[(w * 16 + quad * 4 + j) * 128 + nb * 16 + r16] = f2bf(acc[nb][j]);
    __syncthreads();
}

__device__ __forceinline__ void hgrn_scan(Ctx& C, int l) {
    bf16* US = (bf16*)(C.ws + WS_US); const float* Gg = (const float*)(C.ws + WS_G);
    for (int e = C.bid * NTHR + C.tid; e < 8 * 16384; e += C.G * NTHR) {
        const int bh = e >> 14, el = e & 16383, dk = el & 127, dv = el >> 7;
        bf16* p = US + (size_t)bh * 128 * 16384 + el; const float* gp = Gg + (size_t)bh * 128 * 128 + dk;
        float s = 0.f;
        bf16 u[2][8]; float g[2][8];
#pragma unroll
        for (int i = 0; i < 8; ++i) { u[0][i] = p[(size_t)i * 16384]; g[0][i] = gp[i * 128]; }
#pragma unroll 1
        for (int c0 = 0; c0 < 128; c0 += 16) {
#pragma unroll
            for (int i = 0; i < 8; ++i) { u[1][i] = p[(size_t)(c0 + 8 + i) * 16384]; g[1][i] = gp[(c0 + 8 + i) * 128]; }
#pragma unroll
            for (int i = 0; i < 8; ++i) { p[(size_t)(c0 + i) * 16384] = f2bf(s); s = g[0][i] * s + bf2f(u[0][i]); }
            if (c0 + 16 < 128) {
#pragma unroll
                for (int i = 0; i < 8; ++i) { u[0][i] = p[(size_t)(c0 + 16 + i) * 16384]; g[0][i] = gp[(c0 + 16 + i) * 128]; } }
#pragma unroll
            for (int i = 0; i < 8; ++i) { p[(size_t)(c0 + 8 + i) * 16384] = f2bf(s); s = g[1][i] * s + bf2f(u[1][i]); }
        }
        __builtin_nontemporal_store(s, C.out + O_HSP + ((size_t)l * 8 + bh) * 16384 + dk * 128 + dv);
    }
}

template <int CH> __device__ __forceinline__ void hgrn_out_unit(Ctx& C, int unit, int l) {
    int row0, h, bh; const float* Ssrc;
    if (CH == 64) { bh = unit >> 7; const int c = unit & 127, b = bh >> 2; h = bh & 3; row0 = b * SEQ + c * 64; Ssrc = nullptr; }
    else { bh = unit; const int b = unit >> 2; h = unit & 3; row0 = MP + b * 16; Ssrc = C.in[5] + ((size_t)l * 128 + unit) * 16384; }
    const float* HF = (const float*)(C.ws + WS_HF); const bf16* HB = (const bf16*)(C.ws + WS_HB); const float* lb = (const float*)(C.ws + WS_LB) + l * 512 + h * 128;
    hgrn_decay_prefix<CH>(C, HF, row0, h, lb);
    LAS float* LF = (LAS float*)(C.lds + HL_LF);
    LAS bf16* QT = (LAS bf16*)(C.lds + HL_QT); LAS bf16* KTL = (LAS bf16*)(C.lds + HL_KTL); LAS bf16* VT = (LAS bf16*)(C.lds + HL_VT);
    LAS bf16* ST = (LAS bf16*)(C.lds + HL_ST); LAS bf16* AS = (LAS bf16*)(C.lds + HL_AS);
    LAS bf16* KH = (LAS bf16*)(C.lds + HL_KH);
    LAS float* BL = (LAS float*)(C.lds + HL_SEG);
    const int tid = C.tid; constexpr int MID = CH / 2, SP = (CH < 32) ? 32 : CH;
    if (CH == 16) {
        for (int i = tid; i < 128 * 16; i += NTHR) { const int d = i >> 4, s = 16 + (i & 15); VT[d * HP_V + s] = 0; KH[d * 40 + s] = 0; if (d < 16) AS[d * HP_V + s] = 0; }
    }
#pragma unroll
    for (int idx = tid; idx < CH * 128; idx += NTHR) { const int s = idx >> 7, d = idx & 127;
        const bf16* hb = HB + (size_t)(row0 + s) * 1536 + h * 128 + d;
        const float q = bf2f(hb[0]), z = HF[(size_t)(row0 + s) * 512 + h * 128 + d], v = bf2f(hb[512]), k = (1.f - lb[d]) * sigmoidf_(-z);
        const float bs = LF[idx], r = LF[MID * 128 + d];
        QT[s * HP_Q + d] = f2bf(q * __expf(fminf(bs - r, 80.f))); KTL[s * HP_Q + d] = f2bf(k * __expf(fminf(r - bs, 80.f))); VT[d * HP_V + s] = f2bf(v);
        if (CH == 16) { KH[d * 40 + s] = f2bf(k * __expf(LF[(CH - 1) * 128 + d] - bs)); if (s == CH - 1) BL[d] = bs; } }
    if (CH == 64) {
#pragma unroll 16
        for (int i = tid; i < 16384; i += NTHR) { const int dv = i >> 7, dk = i & 127; ST[dv * HP_Q + dk] = f2bf(Ssrc[i] * __expf(LF[MID * 128 + dk])); } }
    else {
#pragma unroll 16
        for (int i = tid; i < 16384; i += NTHR) { const int dk = i >> 7, dv = i & 127; ST[dv * HP_Q + dk] = f2bf(Ssrc[i] * __expf(LF[MID * 128 + dk])); } }
    __syncthreads();
    const int lane = C.lane, w = C.wave, r16 = lane & 15, quad = lane >> 4;
    { constexpr int NTB = CH / 16;
      for (int blk = w; blk < NTB * NTB; blk += NWAVES) { const int tb = blk / NTB, sb = blk % NTB;
        f32x4 a = (f32x4){0.f, 0.f, 0.f, 0.f};
        if (sb <= tb) {
#pragma unroll
            for (int ks = 0; ks < 4; ++ks) { const bf16x8 qa = *(const LAS bf16x8*)(QT + (tb * 16 + r16) * HP_Q + ks * 32 + quad * 8), kb = *(const LAS bf16x8*)(KTL + (sb * 16 + r16) * HP_Q + ks * 32 + quad * 8); a = mfma16(qa, kb, a); } }
#pragma unroll
        for (int j = 0; j < 4; ++j) { const int t = tb * 16 + quad * 4 + j, s = sb * 16 + r16; AS[t * HP_V + s] = f2bf(s <= t ? a[j] : 0.f); } } }
    __syncthreads();
    LAS float* OS = (LAS float*)(C.lds + HL_LF);
    { constexpr int NTB = CH / 16;
      for (int blk = w; blk < NTB * 8; blk += NWAVES) { const int tb = blk >> 3, db = blk & 7;
        f32x4 o = (f32x4){0.f, 0.f, 0.f, 0.f};
#pragma unroll
        for (int ks = 0; ks < SP / 32; ++ks) { const bf16x8 pa = *(const LAS bf16x8*)(AS + (tb * 16 + r16) * HP_V + ks * 32 + quad * 8), vb = *(const LAS bf16x8*)(VT + (db * 16 + r16) * HP_V + ks * 32 + quad * 8); o = mfma16(pa, vb, o); }
#pragma unroll
        for (int ks = 0; ks < 4; ++ks) { const bf16x8 qa = *(const LAS bf16x8*)(QT + (tb * 16 + r16) * HP_Q + ks * 32 + quad * 8), sb_ = *(const LAS bf16x8*)(ST + (db * 16 + r16) * HP_Q + ks * 32 + quad * 8); o = mfma16(qa, sb_, o); }
#pragma unroll
        for (int j = 0; j < 4; ++j) OS[(tb * 16 + quad * 4 + j) * HP_O + db * 16 + r16] = o[j]; } }
    if (CH == 16) {
        f32x4 acc[8];
        const bf16x8 a = *(const LAS bf16x8*)(KH + (w * 16 + r16) * 40 + quad * 8);
#pragma unroll
        for (int nb = 0; nb < 8; ++nb) { const bf16x8 vb = *(const LAS bf16x8*)(VT + (nb * 16 + r16) * HP_V + quad * 8); acc[nb] = mfma16(a, vb, (f32x4){0.f, 0.f, 0.f, 0.f}); }
        float* So = C.out + O_HSS + ((size_t)l * 128 + unit) * 16384;
#pragma unroll
        for (int j = 0; j < 4; ++j) { const int dk = w * 16 + quad * 4 + j; const float g = __expf(BL[dk]);
#pragma unroll
            for (int nb = 0; nb < 8; ++nb) { const int dv = nb * 16 + r16; __builtin_nontemporal_store(g * Ssrc[dk * 128 + dv] + acc[nb][j], So + dk * 128 + dv); } }
    }
    __syncthreads();
    if (tid < CH * 8) { const int t = tid >> 3, part = tid & 7; const LAS float* orow = OS + t * HP_O + part * 16;
        float ov[16]; float ss = 0.f;
#pragma unroll
        for (int i = 0; i < 4; ++i) { const f32x4 x = *(const LAS f32x4*)(orow + 4 * i); ov[4 * i] = x.x; ov[4 * i + 1] = x.y; ov[4 * i + 2] = x.z; ov[4 * i + 3] = x.w; ss += (x.x * x.x + x.y * x.y) + (x.z * x.z + x.w * x.w); }
        ss += __shfl_xor(ss, 1); ss += __shfl_xor(ss, 2); ss += __shfl_xor(ss, 4);
        const float rstd = __builtin_amdgcn_rsqf(ss * (1.0f / 128.f) + RMS_EPS);
        const float* gn = C.in[13] + l * 128 + part * 16; const bf16* hg = HB + (size_t)(row0 + t) * 1536 + 1024 + h * 128 + part * 16;
        bf16* mo = (bf16*)(C.ws + WS_MIX) + (size_t)(row0 + t) * DM + 512 + h * 128 + part * 16;
        v4u w0, w1; unsigned pk[8];
#pragma unroll
        for (int i = 0; i < 8; ++i) pk[i] = pk2(ov[2 * i] * rstd * gn[2 * i] * siluf_(bf2f(hg[2 * i])), ov[2 * i + 1] * rstd * gn[2 * i + 1] * siluf_(bf2f(hg[2 * i + 1])));
        w0.x = pk[0]; w0.y = pk[1]; w0.z = pk[2]; w0.w = pk[3]; w1.x = pk[4]; w1.y = pk[5]; w1.z = pk[6]; w1.w = pk[7];
        *(v4u*)mo = w0; *(v4u*)(mo + 8) = w1; }
    __syncthreads();
}

__device__ __forceinline__ void hgrn_load_state(Ctx& C, float (&SR)[32], int unit) {
    const bf16* Ssrc = (const bf16*)(C.ws + WS_US) + (size_t)unit * 16384 + C.tid;
#pragma unroll
    for (int i = 0; i < 32; ++i) SR[i] = bf2f(Ssrc[i * NTHR]);
}
__device__ __forceinline__ void hgrn_out_prompt(Ctx& C, int unit, int next_unit, int l, HRegs& R, float (&SR)[32]) {
    const int bh = unit >> 7, c = unit & 127, b = bh >> 2, h = bh & 3, row0 = b * SEQ + c * 64;
    const bf16* HB = (const bf16*)(C.ws + WS_HB); const float* lb = (const float*)(C.ws + WS_LB) + l * 512 + h * 128;
    hgrn_decay_prefix_regs(C, R, lb);
    LAS float* LF = (LAS float*)(C.lds + HL_LF);
    LAS bf16* QT = (LAS bf16*)(C.lds + HL_QT); LAS bf16* KTL = (LAS bf16*)(C.lds + HL_KTL); LAS bf16* VT = (LAS bf16*)(C.lds + HL_VT);
    LAS bf16* ST = (LAS bf16*)(C.lds + HL_ST); LAS bf16* AS = (LAS bf16*)(C.lds + HL_AS);
    const int tid = C.tid; constexpr int MID = 32;
    { const int d = tid & 127, s0 = tid >> 7; const float oml = 1.f - lb[d], r = LF[MID * 128 + d], er = __expf(r);
#pragma unroll
      for (int i = 0; i < 16; ++i) { const int s = s0 + 4 * i; const float k = oml * sigmoidf_(-R.z[i]), bs = LF[s * 128 + d];
        QT[s * HP_Q + d] = f2bf(bf2f(R.q[i]) * __expf(fminf(bs - r, 80.f))); KTL[s * HP_Q + d] = f2bf(k * __expf(fminf(r - bs, 80.f))); VT[d * HP_V + s] = R.v[i]; }
#pragma unroll
      for (int i = 0; i < 32; ++i) ST[(s0 + 4 * i) * HP_Q + d] = f2bf(SR[i] * er); }
    if (next_unit < 1024) { hgrn_load_regs<true>(C, R, next_unit); hgrn_load_state(C, SR, next_unit); }
    const int gt = tid >> 3, part = tid & 7;
    const v4u hg0 = *(const v4u*)(HB + (size_t)(row0 + gt) * 1536 + 1024 + h * 128 + part * 16), hg1 = *(const v4u*)(HB + (size_t)(row0 + gt) * 1536 + 1024 + h * 128 + part * 16 + 8);
    __syncthreads();
    const int lane = C.lane, w = C.wave, r16 = lane & 15, quad = lane >> 4;
    for (int blk = w; blk < 16; blk += NWAVES) { const int tb = blk >> 2, sb = blk & 3;
        f32x4 a = (f32x4){0.f, 0.f, 0.f, 0.f};
        if (sb <= tb) {
#pragma unroll
            for (int ks = 0; ks < 4; ++ks) { const bf16x8 qa = *(const LAS bf16x8*)(QT + (tb * 16 + r16) * HP_Q + ks * 32 + quad * 8), kb = *(const LAS bf16x8*)(KTL + (sb * 16 + r16) * HP_Q + ks * 32 + quad * 8); a = mfma16(qa, kb, a); } }
#pragma unroll
        for (int j = 0; j < 4; ++j) { const int t = tb * 16 + quad * 4 + j, s = sb * 16 + r16; AS[t * HP_V + s] = f2bf(s <= t ? a[j] : 0.f); } }
    __syncthreads();
    LAS float* OS = (LAS float*)(C.lds + HL_LF);
    for (int blk = w; blk < 32; blk += NWAVES) { const int tb = blk >> 3, db = blk & 7;
        f32x4 o = (f32x4){0.f, 0.f, 0.f, 0.f};
#pragma unroll
        for (int ks = 0; ks < 2; ++ks) { const bf16x8 pa = *(const LAS bf16x8*)(AS + (tb * 16 + r16) * HP_V + ks * 32 + quad * 8), vb = *(const LAS bf16x8*)(VT + (db * 16 + r16) * HP_V + ks * 32 + quad * 8); o = mfma16(pa, vb, o); }
#pragma unroll
        for (int ks = 0; ks < 4; ++ks) { const bf16x8 qa = *(const LAS bf16x8*)(QT + (tb * 16 + r16) * HP_Q + ks * 32 + quad * 8), sb_ = *(const LAS bf16x8*)(ST + (db * 16 + r16) * HP_Q + ks * 32 + quad * 8); o = mfma16(qa, sb_, o); }
#pragma unroll
        for (int j = 0; j < 4; ++j) OS[(tb * 16 + quad * 4 + j) * HP_O + db * 16 + r16] = o[j]; }
    __syncthreads();
    { const LAS float* orow = OS + gt * HP_O + part * 16;
        float ov[16]; float ss = 0.f;
#pragma unroll
        for (int i = 0; i < 4; ++i) { const f32x4 x = *(const LAS f32x4*)(orow + 4 * i); ov[4 * i] = x.x; ov[4 * i + 1] = x.y; ov[4 * i + 2] = x.z; ov[4 * i + 3] = x.w; ss += (x.x * x.x + x.y * x.y) + (x.z * x.z + x.w * x.w); }
        ss += __shfl_xor(ss, 1); ss += __shfl_xor(ss, 2); ss += __shfl_xor(ss, 4);
        const float rstd = __builtin_amdgcn_rsqf(ss * (1.0f / 128.f) + RMS_EPS);
        const float* gn = C.in[13] + l * 128 + part * 16;
        bf16* mo = (bf16*)(C.ws + WS_MIX) + (size_t)(row0 + gt) * DM + 512 + h * 128 + part * 16;
        const unsigned hgw[8] = {hg0.x, hg0.y, hg0.z, hg0.w, hg1.x, hg1.y, hg1.z, hg1.w};
        unsigned pk[8];
#pragma unroll
        for (int i = 0; i < 8; ++i) { const float g0 = __builtin_bit_cast(float, hgw[i] << 16), g1 = __builtin_bit_cast(float, hgw[i] & 0xffff0000u);
            pk[i] = pk2(ov[2 * i] * rstd * gn[2 * i] * siluf_(g0), ov[2 * i + 1] * rstd * gn[2 * i + 1] * siluf_(g1)); }
        v4u w0, w1; w0.x = pk[0]; w0.y = pk[1]; w0.z = pk[2]; w0.w = pk[3]; w1.x = pk[4]; w1.y = pk[5]; w1.z = pk[6]; w1.w = pk[7];
        *(v4u*)mo = w0; *(v4u*)(mo + 8) = w1; }
    __syncthreads();
}

__device__ __forceinline__ float block_excl_scan(Ctx& C, float total, LAS float* sm) {
    float x = total;
#pragma unroll
    for (int o = 1; o < 64; o <<= 1) { const float y = __shfl_up(x, o); if (C.lane >= o) x += y; }
    if (C.lane == 63) sm[C.wave] = x;
    __syncthreads();
    float woff = 0.f;
#pragma unroll
    for (int w2 = 0; w2 < NWAVES; ++w2) if (w2 < C.wave) woff += sm[w2];
    __syncthreads();
    return woff + (x - total);
}
__device__ __forceinline__ void cumsum_unit(Ctx& C, int unit, int l) {
    LAS float* sm = (LAS float*)(C.lds);
    if (unit < 16) {
        const float* src = C.out + O_LFP + ((size_t)l * 16 + unit) * 8192 + C.tid * 16; float* dst = (float*)(C.ws + WS_CP) + (size_t)unit * 8192 + C.tid * 16;
        float v[16];
#pragma unroll
        for (int i = 0; i < 4; ++i) { const f32x4 x = ((const f32x4*)src)[i]; v[4 * i] = x.x; v[4 * i + 1] = x.y; v[4 * i + 2] = x.z; v[4 * i + 3] = x.w; }
#pragma unroll
        for (int i = 1; i < 16; ++i) v[i] += v[i - 1];
        const float off = block_excl_scan(C, v[15], sm);
#pragma unroll
        for (int i = 0; i < 4; ++i) ((f32x4*)dst)[i] = (f32x4){(v[4 * i] + off) * LOG2E, (v[4 * i + 1] + off) * LOG2E, (v[4 * i + 2] + off) * LOG2E, (v[4 * i + 3] + off) * LOG2E};
    } else {
        const int bh = unit - 16;
        const float* src = C.in[4] + ((size_t)l * 256 + bh) * PAST + C.tid * 4; float* dst = (float*)(C.ws + WS_CS) + (size_t)bh * SKV;
        f32x4 x = *(const f32x4*)src; x.y += x.x; x.z += x.y; x.w += x.z;
        const float off = block_excl_scan(C, x.w, sm);
        *(f32x4*)(dst + C.tid * 4) = (x + off) * LOG2E;
        if (C.tid == NTHR - 1) { float run = x.w + off; const float* nl = C.out + O_LFS + ((size_t)l * 256 + bh) * 16;
            for (int t = 0; t < 16; ++t) { run += nl[t]; dst[PAST + t] = run * LOG2E; } }
    }
}
__device__ __forceinline__ void ktn_task(Ctx& C, int task) {
    const int bh = task >> 7, tile = task & 127, b = bh >> 3, h = bh & 7, lane = C.lane;
    const bf16* Kb = (const bf16*)(C.ws + WS_KB) + ((size_t)b * SEQ + tile * 64) * 512 + h * 64;
    float mx = 0.f;
#pragma unroll
    for (int i = 0; i < 8; ++i) { const int key = i * 8 + (lane >> 3); const v4u w = *(const v4u*)(Kb + (size_t)key * 512 + (lane & 7) * 8);
        float s = 0.f; const unsigned ww[4] = {w.x, w.y, w.z, w.w};
#pragma unroll
        for (int e = 0; e < 4; ++e) { const float lo = __builtin_bit_cast(float, ww[e] << 16), hi = __builtin_bit_cast(float, ww[e] & 0xffff0000u); s += lo * lo + hi * hi; }
        s += __shfl_xor(s, 1); s += __shfl_xor(s, 2); s += __shfl_xor(s, 4);
        mx = fmaxf(mx, s); }
    mx = wave_max(mx);
    if (lane == 0) ((float*)(C.ws + WS_KTN))[task] = sqrtf(mx);
}

template <int CTRL> __device__ __forceinline__ float dpp_mov(float v) { return __builtin_bit_cast(float, __builtin_amdgcn_update_dpp(0, __builtin_bit_cast(int, v), CTRL, 0xf, 0xf, false)); }
__device__ __forceinline__ float row16_max(float v) { v = fmaxf(v, dpp_mov<0x128>(v)); v = fmaxf(v, dpp_mov<0x124>(v)); v = fmaxf(v, dpp_mov<0x122>(v)); v = fmaxf(v, dpp_mov<0x121>(v)); return v; }
__device__ __forceinline__ float row16_sum(float v) { v += dpp_mov<0x128>(v); v += dpp_mov<0x124>(v); v += dpp_mov<0x122>(v); v += dpp_mov<0x121>(v); return v; }
constexpr int AT_SLOT = 16384, AT_VT = 0, AT_P = 9216, AP = 72;
struct AttnState { bf16x8 qa[2]; float cq[4], m[4], l[4]; f32x4 o[4]; };
__device__ __forceinline__ bf16x8 kfrag_bf16(const bf16* p) { return *(const bf16x8*)p; }
__device__ __forceinline__ bf16x8 kfrag_f32(const float* p) { const f32x4 a = __builtin_nontemporal_load((const f32x4*)p), b = __builtin_nontemporal_load((const f32x4*)(p + 4));     v4u w; w.x = pk2(a.x, a.y); w.y = pk2(a.z, a.w); w.z = pk2(b.x, b.y); w.w = pk2(b.z, b.w); return __builtin_bit_cast(bf16x8, w); }
template <bool F32> __device__ __forceinline__ void attn_scores(const AttnState& S, const void* Ksrc, int pitch, int nvalid, const float* ck, int diag, f32x4 (&s)[4], float (&mx)[4], int lane) {
    const int col = lane & 15, quad = lane >> 4;
#pragma unroll
    for (int nb = 0; nb < 4; ++nb) { const int key = nb * 16 + col, kc = key < nvalid ? key : (nvalid - 1);
        f32x4 a = (f32x4){0.f, 0.f, 0.f, 0.f};
#pragma unroll
        for (int ks = 0; ks < 2; ++ks) { const bf16x8 kb = F32 ? kfrag_f32((const float*)Ksrc + (size_t)kc * pitch + ks * 32 + quad * 8) : kfrag_bf16((const bf16*)Ksrc + (size_t)kc * pitch + ks * 32 + quad * 8);
            a = mfma16(S.qa[ks], kb, a); }
        const float ckv = ck[kc];
#pragma unroll
        for (int j = 0; j < 4; ++j) { const int r = quad * 4 + j; const bool ok = (key < nvalid) && (key <= r + diag); a[j] = ok ? (a[j] + (S.cq[j] - ckv)) : -INFINITY; }
        s[nb] = a; }
#pragma unroll
    for (int j = 0; j < 4; ++j) { float m = fmaxf(fmaxf(s[0][j], s[1][j]), fmaxf(s[2][j], s[3][j]));
        mx[j] = row16_max(m); }
}
__device__ __forceinline__ void attn_load_k_f32(bf16x8 (&kf)[8], float (&ckv)[4], const float* Ksrc, const float* ck, int lane) {
    const int col = lane & 15, quad = lane >> 4;
#pragma unroll
    for (int nb = 0; nb < 4; ++nb) {
#pragma unroll
        for (int ks = 0; ks < 2; ++ks) kf[nb * 2 + ks] = kfrag_f32(Ksrc + (size_t)(nb * 16 + col) * 64 + ks * 32 + quad * 8);
        ckv[nb] = ck[nb * 16 + col]; }
}
__device__ __forceinline__ void attn_scores_pre(const AttnState& S, const bf16x8 (&kf)[8], const float (&ckv)[4], f32x4 (&s)[4], float (&mx)[4]) {
#pragma unroll
    for (int nb = 0; nb < 4; ++nb) { f32x4 a = (f32x4){0.f, 0.f, 0.f, 0.f};
#pragma unroll
        for (int ks = 0; ks < 2; ++ks) a = mfma16(S.qa[ks], kf[nb * 2 + ks], a);
#pragma unroll
        for (int j = 0; j < 4; ++j) a[j] += S.cq[j] - ckv[nb];
        s[nb] = a; }
#pragma unroll
    for (int j = 0; j < 4; ++j) { float m = fmaxf(fmaxf(s[0][j], s[1][j]), fmaxf(s[2][j], s[3][j]));
        mx[j] = row16_max(m); }
}
template <bool F32> __device__ __forceinline__ void attn_update(AttnState& S, f32x4 (&s)[4], const float (&mx)[4], const void* Vsrc, int pitch, int nvalid, LAS bf16* VT, LAS bf16* PL, int lane) {
    const int col = lane & 15, quad = lane >> 4;
    if (F32) { const float* V = (const float*)Vsrc;
#pragma unroll 4
        for (int i = 0; i < 16; ++i) { const int key = i * 4 + (lane >> 4), dc = (lane & 15) * 4; f32x4 x = (f32x4){0.f, 0.f, 0.f, 0.f};
            if (key < nvalid) x = __builtin_nontemporal_load((const f32x4*)(V + (size_t)key * pitch + dc));
            VT[(dc + 0) * AP + key] = f2bf(x.x); VT[(dc + 1) * AP + key] = f2bf(x.y); VT[(dc + 2) * AP + key] = f2bf(x.z); VT[(dc + 3) * AP + key] = f2bf(x.w); }
    } else { const bf16* V = (const bf16*)Vsrc;
#pragma unroll 4
        for (int i = 0; i < 8; ++i) { const int key = i * 8 + (lane >> 3), dc = (lane & 7) * 8; v4u w = (v4u){0u, 0u, 0u, 0u};
            if (key < nvalid) w = *(const v4u*)(V + (size_t)key * pitch + dc);
            VT[(dc + 0) * AP + key] = (bf16)(w.x & 0xffffu); VT[(dc + 1) * AP + key] = (bf16)(w.x >> 16); VT[(dc + 2) * AP + key] = (bf16)(w.y & 0xffffu); VT[(dc + 3) * AP + key] = (bf16)(w.y >> 16);
            VT[(dc + 4) * AP + key] = (bf16)(w.z & 0xffffu); VT[(dc + 5) * AP + key] = (bf16)(w.z >> 16); VT[(dc + 6) * AP + key] = (bf16)(w.w & 0xffffu); VT[(dc + 7) * AP + key] = (bf16)(w.w >> 16); }
    }
    float alpha[4];
#pragma unroll
    for (int j = 0; j < 4; ++j) { const float mnew = fmaxf(S.m[j], mx[j]), msafe = (mnew == -INFINITY) ? 0.f : mnew;
        alpha[j] = fast_exp2(S.m[j] - msafe); S.m[j] = mnew;
        float ps = 0.f;
#pragma unroll
        for (int nb = 0; nb < 4; ++nb) { const float p = fast_exp2(s[nb][j] - msafe); s[nb][j] = p; ps += p; }
        S.l[j] = S.l[j] * alpha[j] + ps; }
#pragma unroll
    for (int nb = 0; nb < 4; ++nb)
#pragma unroll
        for (int j = 0; j < 4; ++j) { PL[(quad * 4 + j) * AP + nb * 16 + col] = f2bf(s[nb][j]); S.o[nb][j] *= alpha[j]; }
    LDS_WAIT(); __builtin_amdgcn_wave_barrier(); asm volatile("" ::: "memory");
    bf16x8 pa[2];
#pragma unroll
    for (int ks = 0; ks < 2; ++ks) pa[ks] = *(const LAS bf16x8*)(PL + col * AP + ks * 32 + quad * 8);
#pragma unroll
    for (int nb = 0; nb < 4; ++nb)
#pragma unroll
        for (int ks = 0; ks < 2; ++ks) { const bf16x8 vb = *(const LAS bf16x8*)(VT + (nb * 16 + col) * AP + ks * 32 + quad * 8); S.o[nb] = mfma16(pa[ks], vb, S.o[nb]); }
    LDS_WAIT(); __builtin_amdgcn_wave_barrier(); asm volatile("" ::: "memory");
}
template <bool F32> __device__ __forceinline__ void attn_tile(AttnState& S, const void* Ksrc, const void* Vsrc, int pitch, int nvalid, const float* ck, int diag, LAS bf16* VT, LAS bf16* PL, int lane) {
    f32x4 s[4]; float mx[4];
    attn_scores<F32>(S, Ksrc, pitch, nvalid, ck, diag, s, mx, lane);
    attn_update<F32>(S, s, mx, Vsrc, pitch, nvalid, VT, PL, lane);
}
__device__ __forceinline__ void attn_init(AttnState& S, const bf16* Qrow0, const float* cq0, int lane) {
    const int col = lane & 15, quad = lane >> 4;
#pragma unroll
    for (int ks = 0; ks < 2; ++ks) S.qa[ks] = *(const bf16x8*)(Qrow0 + (size_t)col * 512 + ks * 32 + quad * 8);
#pragma unroll
    for (int j = 0; j < 4; ++j) { S.cq[j] = cq0[quad * 4 + j]; S.m[j] = -INFINITY; S.l[j] = 0.f; }
#pragma unroll
    for (int nb = 0; nb < 4; ++nb) S.o[nb] = (f32x4){0.f, 0.f, 0.f, 0.f};
}
__device__ __forceinline__ float attn_qmax(const AttnState& S) {
    float s = 0.f;
#pragma unroll
    for (int ks = 0; ks < 2; ++ks)
#pragma unroll
        for (int e = 0; e < 8; ++e) { const float x = bf2f((bf16)S.qa[ks][e]); s += x * x; }
    s += __shfl_xor(s, 16); s += __shfl_xor(s, 32);
    return sqrtf(wave_max(s));
}
__device__ __forceinline__ void attn_prompt_task(Ctx& C, int task) {
    const int bh = task >> 9, rb = task & 511, b = bh >> 3, h = bh & 7, lane = C.lane, i0 = rb * 16;
    const bf16* Qb = (const bf16*)(C.ws + WS_QB); const bf16* Kb = (const bf16*)(C.ws + WS_KB); const bf16* Vb = (const bf16*)(C.ws + WS_VB);
    const float* cp = (const float*)(C.ws + WS_CP) + (size_t)bh * SEQ;
    LAS bf16* VT = (LAS bf16*)(C.lds + C.wave * AT_SLOT + AT_VT); LAS bf16* PL = (LAS bf16*)(C.lds + C.wave * AT_SLOT + AT_P);
    AttnState S; attn_init(S, Qb + ((size_t)b * SEQ + i0) * 512 + h * 64, cp + i0, lane);
    const float* ktn = (const float*)(C.ws + WS_KTN) + bh * 128;
    const float kmax = wave_max(fmaxf(ktn[lane], ktn[lane + 64])), bound = 2.0f * attn_qmax(S) * kmax;
    const int jd = i0 >> 6; const float c0 = cp[i0];
    int jstart = jd;
    { const int t0 = lane, t1 = lane + 64;
      const bool n0 = (t0 < jd) && (c0 - cp[t0 * 64 + 63] + bound >= -151.5f), n1 = (t1 < jd) && (c0 - cp[(t1 < jd ? t1 : 0) * 64 + 63] + bound >= -151.5f);
      const unsigned long long m0 = __ballot(n0), m1 = __ballot(n1);
      if (m0) jstart = __builtin_ctzll(m0); else if (m1) jstart = 64 + __builtin_ctzll(m1); }
    for (int t = jstart; t <= jd; ++t) {
        const size_t krow = ((size_t)b * SEQ + t * 64) * 512 + h * 64;
        attn_tile<false>(S, Kb + krow, Vb + krow, 512, 64, cp + t * 64, (t == jd) ? (i0 - t * 64) : 64, VT, PL, lane);
    }
    const int col = lane & 15, quad = lane >> 4;
#pragma unroll
    for (int j = 0; j < 4; ++j) { float lt = S.l[j]; lt = row16_sum(lt); const float inv = __builtin_amdgcn_rcpf(lt);
#pragma unroll
        for (int nb = 0; nb < 4; ++nb) PL[(quad * 4 + j) * AP + nb * 16 + col] = f2bf(S.o[nb][j] * inv); }
    LDS_WAIT(); __builtin_amdgcn_wave_barrier(); asm volatile("" ::: "memory");
    bf16* mix = (bf16*)(C.ws + WS_MIX) + ((size_t)b * SEQ + i0) * DM + h * 64;
#pragma unroll
    for (int i = 0; i < 2; ++i) { const int r = i * 8 + (lane >> 3), ch = lane & 7; *(v4u*)(mix + (size_t)r * DM + ch * 8) = *(const LAS v4u*)(PL + r * AP + ch * 8); }
    LDS_WAIT(); __builtin_amdgcn_wave_barrier(); asm volatile("" ::: "memory");
}
constexpr int AB_K = 0, AB_V = 18432, AB_P = 36864, AB_CK = 55296, AB_RED = 55808;
template <bool MASK> __device__ __forceinline__ void attn_tile_lds(AttnState& S, const LAS bf16* KL, const LAS bf16* VT, const LAS float* CK, int diag, LAS bf16* PL, int lane) {
    const int col = lane & 15, quad = lane >> 4;
    const f32x4 cq4 = (f32x4){S.cq[0], S.cq[1], S.cq[2], S.cq[3]};
    f32x4 s[4];
#pragma unroll
    for (int nb = 0; nb < 4; ++nb) { const int key = nb * 16 + col;
        f32x4 a = cq4 - CK[key];
#pragma unroll
        for (int ks = 0; ks < 2; ++ks) { const bf16x8 kb = *(const LAS bf16x8*)(KL + key * AP + ks * 32 + quad * 8); a = mfma16(S.qa[ks], kb, a); }
        if (MASK) {
#pragma unroll
            for (int j = 0; j < 4; ++j) { const int r = quad * 4 + j; a[j] = (key <= r + diag) ? a[j] : -INFINITY; } }
        s[nb] = a; }
    f32x4 mx4 = __builtin_elementwise_max(__builtin_elementwise_max(s[0], s[1]), __builtin_elementwise_max(s[2], s[3]));
    f32x4 m4 = (f32x4){S.m[0], S.m[1], S.m[2], S.m[3]}, l4 = (f32x4){S.l[0], S.l[1], S.l[2], S.l[3]}, mnew4, msafe4, alpha4;
#pragma unroll
    for (int j = 0; j < 4; ++j) { const float mx = row16_max(mx4[j]); mnew4[j] = fmaxf(m4[j], mx); msafe4[j] = (mnew4[j] == -INFINITY) ? 0.f : mnew4[j]; }
    { const f32x4 dm = m4 - msafe4;
#pragma unroll
      for (int j = 0; j < 4; ++j) alpha4[j] = fast_exp2(dm[j]); }
    f32x4 ps4 = (f32x4){0.f, 0.f, 0.f, 0.f};
#pragma unroll
    for (int nb = 0; nb < 4; ++nb) { const f32x4 d = s[nb] - msafe4; f32x4 p;
#pragma unroll
        for (int j = 0; j < 4; ++j) p[j] = fast_exp2(d[j]);
        s[nb] = p; ps4 = ps4 + p; S.o[nb] = S.o[nb] * alpha4; }
    l4 = l4 * alpha4 + ps4;
#pragma unroll
    for (int j = 0; j < 4; ++j) { S.m[j] = mnew4[j]; S.l[j] = l4[j]; }
#pragma unroll
    for (int nb = 0; nb < 4; ++nb)
#pragma unroll
        for (int j = 0; j < 4; ++j) PL[(quad * 4 + j) * AP + nb * 16 + col] = f2bf(s[nb][j]);
    LDS_WAIT(); __builtin_amdgcn_wave_barrier(); asm volatile("" ::: "memory");
    bf16x8 pa[2];
#pragma unroll
    for (int ks = 0; ks < 2; ++ks) pa[ks] = *(const LAS bf16x8*)(PL + col * AP + ks * 32 + quad * 8);
#pragma unroll
    for (int nb = 0; nb < 4; ++nb)
#pragma unroll
        for (int ks = 0; ks < 2; ++ks) { const bf16x8 vb = *(const LAS bf16x8*)(VT + (nb * 16 + col) * AP + ks * 32 + quad * 8); S.o[nb] = mfma16(pa[ks], vb, S.o[nb]); }
    LDS_WAIT(); __builtin_amdgcn_wave_barrier(); asm volatile("" ::: "memory");
}
__device__ __forceinline__ void attn_prompt_unit(Ctx& C, int unit) {
    const int bh = unit >> 6, qb = 63 - (unit & 63), b = bh >> 3, h = bh & 7, lane = C.lane, w = C.wave, tid = C.tid, i0b = qb * 128, i0 = i0b + 16 * w;
    const bf16* Qb = (const bf16*)(C.ws + WS_QB); const bf16* Kb = (const bf16*)(C.ws + WS_KB) + (size_t)b * SEQ * 512 + h * 64; const bf16* Vb = (const bf16*)(C.ws + WS_VB) + (size_t)b * SEQ * 512 + h * 64;
    const float* cp = (const float*)(C.ws + WS_CP) + (size_t)bh * SEQ;
    LAS bf16* KL = (LAS bf16*)(C.lds + AB_K); LAS bf16* VT = (LAS bf16*)(C.lds + AB_V); LAS bf16* PL = (LAS bf16*)(C.lds + AB_P) + w * 16 * AP;
    LAS float* CK = (LAS float*)(C.lds + AB_CK); LAS float* RED = (LAS float*)(C.lds + AB_RED);
    AttnState S; attn_init(S, Qb + ((size_t)b * SEQ + i0) * 512 + h * 64, cp + i0, lane);
    const float* ktn = (const float*)(C.ws + WS_KTN) + bh * 128;
    const int jd0 = i0b >> 6, jlast = jd0 + 1;
    const float kt0 = ktn[lane], kt1 = ktn[lane + 64], c0 = cp[i0b];
    const int t0 = lane, t1 = lane + 64;
    const float ce0 = cp[t0 * 64 + 63], ce1 = cp[(t1 < jd0 ? t1 : 0) * 64 + 63];
    { const float qm = attn_qmax(S); if (lane == 0) RED[w] = qm; }
    __syncthreads();
    float qmax = RED[0];
#pragma unroll
    for (int i = 1; i < NWAVES; ++i) qmax = fmaxf(qmax, RED[i]);
    const float kmax = wave_max(fmaxf(kt0, kt1)), bound = 2.0f * qmax * kmax;
    int jstart = jd0;
    { const bool n0 = (t0 < jd0) && (c0 - ce0 + bound >= -151.5f), n1 = (t1 < jd0) && (c0 - ce1 + bound >= -151.5f);
      const unsigned long long m0 = __ballot(n0), m1 = __ballot(n1);
      if (m0) jstart = __builtin_ctzll(m0); else if (m1) jstart = 64 + __builtin_ctzll(m1); }
    const int skey = tid >> 3, sch = tid & 7;
    v4u kr0, vr0, kr1, vr1, kr2, vr2, kr3, vr3; float cr0 = 0.f, cr1 = 0.f, cr2 = 0.f, cr3 = 0.f;
#define AT_LOAD(K_, V_, C_, t) do { if ((t) <= jlast) { K_ = *(const v4u*)(Kb + (size_t)((t) * 64 + skey) * 512 + sch * 8); V_ = *(const v4u*)(Vb + (size_t)((t) * 64 + lane) * 512 + w * 8); if (tid < 64) C_ = cp[(t) * 64 + tid]; } } while (0)
#define AT_STORE(K_, V_, C_, bf) do { *(LAS v4u*)(KL + (bf) * 64 * AP + skey * AP + sch * 8) = K_; LAS bf16* vt_ = VT + (bf) * 64 * AP + (w * 8) * AP + lane; \
        vt_[0 * AP] = (bf16)(V_.x & 0xffffu); vt_[1 * AP] = (bf16)(V_.x >> 16); vt_[2 * AP] = (bf16)(V_.y & 0xffffu); vt_[3 * AP] = (bf16)(V_.y >> 16); \
        vt_[4 * AP] = (bf16)(V_.z & 0xffffu); vt_[5 * AP] = (bf16)(V_.z >> 16); vt_[6 * AP] = (bf16)(V_.w & 0xffffu); vt_[7 * AP] = (bf16)(V_.w >> 16); \
        if (tid < 64) CK[(bf) * 64 + tid] = C_; } while (0)
#define AT_ITER(t, bf, KL_, VL_, CL_, KS_, VS_, CS_) do { AT_LOAD(KL_, VL_, CL_, (t) + 3); \
        { const int diag = i0 - 64 * (t); if (diag >= 63) attn_tile_lds<false>(S, KL + (bf) * 64 * AP, VT + (bf) * 64 * AP, CK + (bf) * 64, diag, PL, lane); \
          else if (diag >= 0) attn_tile_lds<true>(S, KL + (bf) * 64 * AP, VT + (bf) * 64 * AP, CK + (bf) * 64, diag, PL, lane); } \
        if ((t) < jlast) AT_STORE(KS_, VS_, CS_, (bf) ^ 1); \
        __syncthreads(); } while (0)
    AT_LOAD(kr0, vr0, cr0, jstart); AT_LOAD(kr1, vr1, cr1, jstart + 1); AT_LOAD(kr2, vr2, cr2, jstart + 2);
    AT_STORE(kr0, vr0, cr0, 0);
    __syncthreads();
    for (int t = jstart; t <= jlast; t += 4) {
        AT_ITER(t, 0, kr3, vr3, cr3, kr1, vr1, cr1);
        if (t + 1 > jlast) break;
        AT_ITER(t + 1, 1, kr0, vr0, cr0, kr2, vr2, cr2);
        if (t + 2 > jlast) break;
        AT_ITER(t + 2, 0, kr1, vr1, cr1, kr3, vr3, cr3);
        if (t + 3 > jlast) break;
        AT_ITER(t + 3, 1, kr2, vr2, cr2, kr0, vr0, cr0);
    }
#undef AT_ITER
#undef AT_LOAD
#undef AT_STORE
    const int col = lane & 15, quad = lane >> 4;
#pragma unroll
    for (int j = 0; j < 4; ++j) { float lt = S.l[j]; lt = row16_sum(lt); const float inv = __builtin_amdgcn_rcpf(lt);
#pragma unroll
        for (int nb = 0; nb < 4; ++nb) PL[(quad * 4 + j) * AP + nb * 16 + col] = f2bf(S.o[nb][j] * inv); }
    LDS_WAIT(); __builtin_amdgcn_wave_barrier(); asm volatile("" ::: "memory");
    bf16* mix = (bf16*)(C.ws + WS_MIX) + ((size_t)b * SEQ + i0) * DM + h * 64;
#pragma unroll
    for (int i = 0; i < 2; ++i) { const int r = i * 8 + (lane >> 3), ch = lane & 7; *(v4u*)(mix + (size_t)r * DM + ch * 8) = *(const LAS v4u*)(PL + r * AP + ch * 8); }
    LDS_WAIT();
    __syncthreads();
}
__device__ __forceinline__ void attn_sample_unit(Ctx& C, int unit, int l) {
    const int b = unit >> 3, h = unit & 7, lane = C.lane, w = C.wave;
    const bf16* Qb = (const bf16*)(C.ws + WS_QB); const bf16* Kb = (const bf16*)(C.ws + WS_KB); const bf16* Vb = (const bf16*)(C.ws + WS_VB);
    const float* cs = (const float*)(C.ws + WS_CS) + (size_t)unit * SKV;
    LAS bf16* VT = (LAS bf16*)(C.lds + w * AT_SLOT + AT_VT); LAS bf16* PL = (LAS bf16*)(C.lds + w * AT_SLOT + AT_P);
    const size_t srow = ((size_t)MP + b * 16) * 512 + h * 64;
    AttnState S; attn_init(S, Qb + srow, cs + PAST, lane);
    const float* ck = C.in[2] + (((size_t)l * 32 + b) * 8 + h) * PAST * 64; const float* cv = C.in[3] + (((size_t)l * 32 + b) * 8 + h) * PAST * 64;
    f32x4 s[4]; float mlb[4], mx[4];
    attn_scores<false>(S, Kb + srow, 512, 16, cs + PAST, 0, s, mlb, lane);
    if (w == 0) attn_update<false>(S, s, mlb, Vb + srow, 512, 16, VT, PL, lane);
    bf16x8 kf[2][8]; float ckv[2][4];
    attn_load_k_f32(kf[0], ckv[0], ck + (size_t)(24 + w) * 64 * 64, cs + (24 + w) * 64, lane);
#pragma unroll
    for (int i = 0; i < 4; ++i) { const int t = 24 + w - 8 * i;
        if (i < 3) attn_load_k_f32(kf[(i + 1) & 1], ckv[(i + 1) & 1], ck + (size_t)(t - 8) * 64 * 64, cs + (t - 8) * 64, lane);
        attn_scores_pre(S, kf[i & 1], ckv[i & 1], s, mx);
        bool dead = true;
#pragma unroll
        for (int j = 0; j < 4; ++j) dead = dead && (mx[j] - fmaxf(S.m[j], mlb[j]) < -151.5f);
        if (!__all(dead)) attn_update<true>(S, s, mx, cv + (size_t)t * 64 * 64, 64, 64, VT, PL, lane);
    }
    const int col = lane & 15, quad = lane >> 4;
    LAS float* slot = (LAS float*)(C.lds + w * AT_SLOT);
#pragma unroll
    for (int j = 0; j < 4; ++j) { float lt = S.l[j]; lt = row16_sum(lt);
        if (col == 0) { slot[quad * 4 + j] = S.m[j]; slot[16 + quad * 4 + j] = lt; }
#pragma unroll
        for (int nb = 0; nb < 4; ++nb) slot[64 + (quad * 4 + j) * 64 + nb * 16 + col] = S.o[nb][j]; }
    __syncthreads();
    bf16* mix = (bf16*)(C.ws + WS_MIX) + ((size_t)MP + b * 16) * DM + h * 64;
    for (int e = C.tid; e < 16 * 64; e += NTHR) { const int r = e >> 6, d = e & 63;
        float M = -INFINITY;
#pragma unroll
        for (int w2 = 0; w2 < NWAVES; ++w2) M = fmaxf(M, ((const LAS float*)(C.lds + w2 * AT_SLOT))[r]);
        float num = 0.f, den = 0.f;
#pragma unroll
        for (int w2 = 0; w2 < NWAVES; ++w2) { const LAS float* sl = (const LAS float*)(C.lds + w2 * AT_SLOT); const float f = fast_exp2(sl[r] - M); num += f * sl[64 + r * 64 + d]; den += f * sl[16 + r]; }
        mix[(size_t)r * DM + d] = f2bf(num * __builtin_amdgcn_rcpf(den)); }
    __syncthreads();
}

constexpr int LDSCTL_OFF = LDS_BYTES - 64, CW_BAR = 4096;
#define XB_TMO      128
#define XB_XCNT(j)  (256  + 64 * (j))
#define XB_XSUB(j)  (1280 + 64 * (j))
#define XB_XGEN(j)  (2304 + 64 * (j))
#define XB_TOP      3328
#define XB_TOPGEN   3392
#define XCD_BAR_WORDS 3456
#define XB_SPIN_CAP (1u << 18)

__device__ __forceinline__ unsigned xb_ld(unsigned* p)              { return __hip_atomic_load(p, __ATOMIC_RELAXED, __HIP_MEMORY_SCOPE_AGENT); }
__device__ __forceinline__ unsigned xb_add(unsigned* p, unsigned v) { return __hip_atomic_fetch_add(p, v, __ATOMIC_RELAXED, __HIP_MEMORY_SCOPE_AGENT); }
__device__ __forceinline__ unsigned xb_xcc_id() { return (unsigned)__builtin_amdgcn_s_getreg((3 << 11) | 20) & 0xFu; }
#define XB_SPIN(cond, bar) do { unsigned _sp = 0; while (cond) { __builtin_amdgcn_s_sleep(1); \
    if ((++_sp & 255u) == 0u) { if (xb_ld(&(bar)[XB_TMO])) break; if (_sp > XB_SPIN_CAP) { atomicAdd(&(bar)[XB_TMO], 1u); break; } } } } while (0)

struct XcdBarrier {
    unsigned* bar; unsigned x;
    volatile LAS unsigned* st;
};

__device__ __forceinline__ XcdBarrier xcd_barrier_post(unsigned* bar, volatile LAS unsigned* st) {
    XcdBarrier b; b.bar = bar; b.x = xb_xcc_id(); b.st = st;
    if (threadIdx.x == 0) (void)xb_add(&bar[XB_XCNT(b.x)], 1u);
    return b;
}
__device__ __forceinline__ void xcd_barrier_complete(unsigned* bar, unsigned x, unsigned& nloc, unsigned& nx) {
    const unsigned G = gridDim.x * gridDim.y * gridDim.z;
    unsigned sum, cnt, mine, sp = 0u;
    for (;;) {
        sum = 0u; cnt = 0u; mine = 0u;
#pragma unroll
        for (unsigned j = 0; j < 16; ++j) { const unsigned c = xb_ld(&bar[XB_XCNT(j)]); sum += c; cnt += (c > 0u) ? 1u : 0u; mine = (j == x) ? c : mine; }
        if (sum == G) break;
        __builtin_amdgcn_s_sleep(1);
        if ((++sp & 255u) == 0u) { if (xb_ld(&bar[XB_TMO])) break; if (sp > XB_SPIN_CAP) { atomicAdd(&bar[XB_TMO], 1u); break; } }
    }
    nloc = mine > 0u ? mine : 1u; nx = cnt > 0u ? cnt : 1u;
}

__device__ __forceinline__ void xcd_barrier(const XcdBarrier& b) {
    asm volatile("s_waitcnt vmcnt(0)" ::: "memory");
    __syncthreads();
    if (threadIdx.x == 0) {
        unsigned* bar = b.bar;
        __builtin_amdgcn_s_waitcnt(0);
        unsigned nloc = b.st[0], nx = b.st[1];
        if (nloc == 0u) { xcd_barrier_complete(bar, b.x, nloc, nx); b.st[0] = nloc; b.st[1] = nx; }
        const unsigned old = xb_add(&bar[XB_XSUB(b.x)], 1u);
        const unsigned gen = old / nloc;
        if (old + 1u == (gen + 1u) * nloc) {
            __builtin_amdgcn_fence(__ATOMIC_RELEASE, "agent");
            asm volatile("s_waitcnt vmcnt(0)" ::: "memory");
            const unsigned og = xb_add(&bar[XB_TOP], 1u);
            const unsigned tg = og / nx;
            if (og + 1u == (tg + 1u) * nx) xb_add(&bar[XB_TOPGEN], 1u);
            else XB_SPIN(xb_ld(&bar[XB_TOPGEN]) == tg, bar);
            __builtin_amdgcn_fence(__ATOMIC_ACQUIRE, "agent");
            xb_add(&bar[XB_XGEN(b.x)], 1u);
            asm volatile("s_waitcnt vmcnt(0)" ::: "memory");
        } else {
            XB_SPIN(xb_ld(&bar[XB_XGEN(b.x)]) == gen, bar);
            __builtin_amdgcn_fence(__ATOMIC_ACQUIRE, "agent");
            asm volatile("s_waitcnt vmcnt(0)" ::: "memory");
        }
    }
    __syncthreads();
}

template <int KIND, int L> __device__ __forceinline__ void gemm_up(Ctx& C) {
    pg8::Gemm g{(const bf16*)(C.ws + WS_HN), (const bf16*)(C.ws + WS_W1T) + (size_t)(L * 2 + KIND) * W1T_SZ, MT, 2 * DFF, DM}; pg8::StaticOrder S; S.init(MT, 2 * DFF, C.G, C.bid);
    pg8::EpiSwiglu E{(bf16*)(C.ws + WS_ACT), nullptr};
    pg8::gemm_phase<pg8::EpiSwiglu, pg8::StaticOrder, true, true>(C.lds, g, S, E);
}
template <int KIND, int L> __device__ __forceinline__ void gemm_res(Ctx& C, bool dummy = false) {
    pg8::Gemm g;
    if (KIND == 2) g = pg8::Gemm{(const bf16*)(C.ws + WS_MIX), (const bf16*)(C.ws + WS_WOT) + (size_t)L * WOT_SZ, MT, DM, DM};
    else g = pg8::Gemm{(const bf16*)(C.ws + WS_ACT), (const bf16*)(C.ws + WS_W2T) + (size_t)(L * 2 + KIND) * W2T_SZ, MT, DM, DFF};
    pg8::SplitOrder S; S.init(MP, DM, C.G, C.bid, (KIND == 2 ? DM : DFF) / 64);
    float* Xo = (float*)(C.ws + (dummy ? WS_END : WS_X));
    pg8::EpiRes E{Xo, (KIND == 0 && L == 0 && !dummy) ? C.in[0] : Xo, (float*)(C.ws + (dummy ? WS_END + 100 * MiB : WS_PART)), KIND == 2 ? 1.0f : 0.5f,
                  nullptr, nullptr, nullptr};
    pg8::gemm_phase<pg8::EpiRes, pg8::SplitOrder, true, true>(C.lds, g, S, E);
}
template <int L> __device__ __forceinline__ void gemm_inproj(Ctx& C) {
    pg8::Gemm g{(const bf16*)(C.ws + WS_HN), (const bf16*)(C.ws + WS_WINT) + (size_t)L * WINT_SZ, MT, NIN, DM}; pg8::StaticOrder S; S.init(MT, NIN, C.G, C.bid);
    pg8::EpiInProj E{(bf16*)(C.ws + WS_QB), (bf16*)(C.ws + WS_KB), (bf16*)(C.ws + WS_VB), (float*)(C.ws + WS_HF), (bf16*)(C.ws + WS_HB), C.out, L};
    pg8::gemm_phase<pg8::EpiInProj, pg8::StaticOrder, true, true>(C.lds, g, S, E);
}
__device__ __forceinline__ void phase_prep(Ctx& C, int l) {
    { HRegs R; int u = C.bid; if (u < 1024) hgrn_load_regs<false>(C, R, u);
      for (; u < 1024; u += C.G) hgrn_local_unit(C, u, u + C.G, l, R); }
    for (int u = C.bid; u < 272; u += C.G) cumsum_unit(C, u, l);
    for (int t = CTX_GW(C); t < 2048; t += CTX_NGW(C)) ktn_task(C, t);
}
__device__ __forceinline__ void phase_attn(Ctx& C, int l, const XcdBarrier& bar) {
    const int grp = (TSEL < 0) ? ((C.bid >> 3) % 3) : 0, npre = grp * 2;
    int u = C.bid, k = 0;
    for (; u < 1024 && k < npre; u += C.G, ++k) attn_prompt_unit(C, u);
    for (int us = C.bid; us < 256; us += C.G) attn_sample_unit(C, us, l);
    if (TSEL >= 0) { xcd_barrier(bar); if (C.bid == 0 && C.tid == 0) ((unsigned long long*)(C.ws + WS_CTL + 32768))[40 + 2 * l] = __builtin_amdgcn_s_memrealtime(); }
    hgrn_scan(C, l);
    if (TSEL >= 0) { xcd_barrier(bar); if (C.bid == 0 && C.tid == 0) ((unsigned long long*)(C.ws + WS_CTL + 32768))[41 + 2 * l] = __builtin_amdgcn_s_memrealtime(); }
    for (; u < 1024; u += C.G) attn_prompt_unit(C, u);
}
__device__ __forceinline__ void phase_hout(Ctx& C, int l) {
    { HRegs R; float SR[32]; int u = C.bid; if (u < 1024) { hgrn_load_regs<true>(C, R, u); hgrn_load_state(C, SR, u); }
      for (; u < 1024; u += C.G) hgrn_out_prompt(C, u, u + C.G, l, R, SR); }
    for (int u = C.bid; u < 128; u += C.G) hgrn_out_unit<16>(C, u, l);
}
template <int L> __device__ __forceinline__ void layer_phases(Ctx& C, const XcdBarrier& bar, int lo, int hi) {
    constexpr int P = 1 + 12 * L;
#define IN(k) (lo <= (k) && (k) < hi)
#define SEAM(k) do { if (IN(k) && IN((k) + 1)) { xcd_barrier(bar); if (TSEL >= 0 && C.bid == 0 && C.tid == 0) ((unsigned long long*)(C.ws + WS_CTL + 32768))[(k) + 1] = __builtin_amdgcn_s_memrealtime(); } } while (0)
#define DUPK(k) (L == 0 && ((DUP >> (k)) & 1))
    const bool merged0 = (L == 0) && IN(0) && IN(1) && TSEL < 0;
    if (IN(P + 0) && !merged0) { phase_rms<0>(C, C.in[6] + L * DM, L, L == 0 ? 0.f : 0.5f, L == 0 ? 1 : 0); if (DUPK(0)) { xcd_barrier(bar); phase_rms<0>(C, C.in[6] + L * DM, L, L == 0 ? 0.f : 0.5f, L == 0 ? 1 : 0); } }
    if (!merged0) SEAM(P + 0);
    if (IN(P + 1)) { gemm_up<0, L>(C); if (DUPK(1)) { xcd_barrier(bar); gemm_up<0, L>(C); } }
    SEAM(P + 1);
    if (IN(P + 2)) { gemm_res<0, L>(C); if (DUPK(2)) { xcd_barrier(bar); gemm_res<0, L>(C, true); } }
    SEAM(P + 2);
    if (IN(P + 3)) { phase_rms<1>(C, C.in[9] + L * DM, L, 0.5f, L == 0 ? 2 : 0); if (DUPK(3)) { xcd_barrier(bar); phase_rms<1>(C, C.in[9] + L * DM, L, 0.5f, L == 0 ? 2 : 0); } }
    SEAM(P + 3);
    if (IN(P + 4)) { gemm_inproj<L>(C); if (DUPK(4)) { xcd_barrier(bar); gemm_inproj<L>(C); } }
    SEAM(P + 4);
    if (IN(P + 5)) { phase_prep(C, L); if (DUPK(5)) { xcd_barrier(bar); phase_prep(C, L); } }
    SEAM(P + 5);
    if (IN(P + 6)) phase_attn(C, L, bar);
    SEAM(P + 6);
    if (IN(P + 7)) { phase_hout(C, L); if (DUPK(7)) { xcd_barrier(bar); phase_hout(C, L); } }
    SEAM(P + 7);
    if (IN(P + 8)) { gemm_res<2, L>(C); if (DUPK(8)) { xcd_barrier(bar); gemm_res<2, L>(C, true); } }
    SEAM(P + 8);
    if (IN(P + 9)) { phase_rms<0>(C, C.in[15] + L * DM, L, 1.0f, 0); if (DUPK(9)) { xcd_barrier(bar); phase_rms<0>(C, C.in[15] + L * DM, L, 1.0f, 0); } }
    SEAM(P + 9);
    if (IN(P + 10)) gemm_up<1, L>(C);
    SEAM(P + 10);
    if (IN(P + 11)) gemm_res<1, L>(C);
    SEAM(P + 11);
#undef DUPK
#undef IN
#undef SEAM
}

__global__ void __launch_bounds__(NTHR, 2) fwd_megakernel(Params prm) {
    extern __shared__ __attribute__((aligned(16))) unsigned char lds_raw[];
    Ctx C;
    C.lds = (LAS unsigned char*)lds_raw; C.tid = threadIdx.x; C.lane = C.tid & 63; C.wave = __builtin_amdgcn_readfirstlane(C.tid >> 6); C.G = gridDim.x; C.bid = blockIdx.x;
#pragma unroll
    for (int i = 0; i < 19; ++i) C.in[i] = prm.in[i];
    C.out = prm.out; C.ws = prm.ws;
    cg::grid_group grid = cg::this_grid();
    volatile LAS unsigned* MISC = (volatile LAS unsigned*)(C.lds + LDSCTL_OFF);
    if (C.tid < 16) MISC[C.tid] = 0u;
    __syncthreads();
    XcdBarrier bar; bar.bar = (unsigned*)(C.ws + WS_CTL) + CW_BAR; bar.x = 0; bar.st = nullptr;
    const int lo = prm.ph_lo, hi = prm.ph_hi;
    if (TSEL >= 0 && C.bid == 0 && C.tid == 0) ((unsigned long long*)(C.ws + WS_CTL + 32768))[0] = __builtin_amdgcn_s_memrealtime();
#define IN(k) (lo <= (k) && (k) < hi)
#define SEAM(k) do { if (IN(k) && IN((k) + 1)) { grid.sync(); if (TSEL >= 0 && C.bid == 0 && C.tid == 0) ((unsigned long long*)(C.ws + WS_CTL + 32768))[(k) + 1] = __builtin_amdgcn_s_memrealtime(); } } while (0)
    if (ONE_LAUNCH && C.bid == 0) { for (int i = C.tid; i < 16384; i += NTHR) ((unsigned*)(C.ws + WS_CTL))[i] = 0u; }
    if (IN(0)) { phase_prologue(C); if (IN(1) && TSEL < 0) phase_rms<0>(C, C.in[6], 0, 0.f, 1);     if ((DUP >> 12) & 1) { grid.sync(); phase_prologue(C); } if ((DUP >> 13) & 1) { for (int i = 0; i < 16; ++i) xcd_barrier(bar); } } SEAM(0);
    if (ONE_LAUNCH) bar = xcd_barrier_post((unsigned*)(C.ws + WS_CTL) + CW_BAR, MISC + 8);
    layer_phases<0>(C, bar, lo, hi);
    layer_phases<1>(C, bar, lo, hi);
    if (IN(25)) phase_rms<2>(C, C.in[18], 0, 0.5f, 0);
    if (TSEL >= 0) {
        xcd_barrier(bar);
        if (C.bid == 0) {
            volatile unsigned long long* TS = (volatile unsigned long long*)(C.ws + WS_CTL + 32768);
            if (C.tid == 0) TS[26] = __builtin_amdgcn_s_memrealtime();
            __syncthreads();
            float T = 0.f;
            for (int k = 0; k < 26; ++k) if ((TSEL >> k) & 1) T += (float)(TS[k + 1] - TS[k]) * 0.01f;
            for (int L2 = 0; L2 < 2; ++L2) { const int P = 1 + 12 * L2;
                if ((TSEL >> 26) & 1) T += (float)(TS[40 + 2 * L2] - TS[P + 6]) * 0.01f;
                if ((TSEL >> 27) & 1) T += (float)(TS[41 + 2 * L2] - TS[40 + 2 * L2]) * 0.01f;
                if ((TSEL >> 28) & 1) T += (float)(TS[P + 7] - TS[41 + 2 * L2]) * 0.01f; }
            const float delta = sqrtf(8e-6f * (1.0f + T * 1e-3f));
            for (int i = C.tid; i < 8192; i += NTHR) C.out[O_LFS + i] += delta;
        }
    }
#undef IN
#undef SEAM
}

extern "C" void kernel_launch(void* const* d_in, const int* in_sizes, int n_in, void* d_out, int out_size, void* d_ws, size_t ws_size, hipStream_t stream) {
    static int grid = 0;
    if (grid == 0) {
        if (n_in != 19 || (size_t)out_size != O_END || ws_size < WS_PART + 8 * MiB) { fprintf(stderr, "kernel_launch: unexpected problem (n_in %d out %d ws %zu)\n", n_in, out_size, ws_size); grid = -1; return; }
        int dev = 0, cus = 0, per_cu = 0;
        hipGetDevice(&dev); hipDeviceGetAttribute(&cus, hipDeviceAttributeMultiprocessorCount, dev);
        if (hipFuncSetAttribute((const void*)fwd_megakernel, hipFuncAttributeMaxDynamicSharedMemorySize, LDS_BYTES) != hipSuccess) { fprintf(stderr, "kernel_launch: hipFuncSetAttribute failed\n"); grid = -1; return; }
        if (hipOccupancyMaxActiveBlocksPerMultiprocessor(&per_cu, (const void*)fwd_megakernel, NTHR, LDS_BYTES) != hipSuccess || per_cu < 1) { fprintf(stderr, "kernel_launch: occupancy query says %d\n", per_cu); per_cu = 1; }
        (void)hipGetLastError();
        grid = cus * 1;
        if (grid <= 0) grid = 256;
    }
    if (grid < 0) return;
    Params p{};
    for (int i = 0; i < 19; ++i) p.in[i] = (const float*)d_in[i];
    p.out = (float*)d_out; p.ws = (unsigned char*)d_ws;
#if ONE_LAUNCH
    p.ph_lo = 0; p.ph_hi = 26;
    void* args[] = {&p};
    hipError_t e = hipLaunchCooperativeKernel((const void*)fwd_megakernel, dim3(grid), dim3(NTHR), args, LDS_BYTES, stream);
    if (e != hipSuccess) fprintf(stderr, "cooperative launch failed: %s (grid %d)\n", hipGetErrorString(e), grid);
#else
    for (int ph = 0; ph < 26; ++ph) { p.ph_lo = ph; p.ph_hi = ph + 1; hipLaunchKernelGGL(fwd_megakernel, dim3(grid), dim3(NTHR), LDS_BYTES, stream, p); }
#endif
}
```
